# Optimizing an MI355X kernel written in HIP

```python
import jax, jax.numpy as jnp
from jax import lax
import numpy as np

D_MODEL = 1024
BATCH = 8
SEQ = 2048
DEPTH = 4

CONV_WIDTH = D_MODEL // 2
LRU_WIDTH = D_MODEL // 2
LRU_HEADS = 8
LRU_HEAD_DIM = LRU_WIDTH // LRU_HEADS
LRU_C = 8.0
SHORT_CONV_W = 3
REC_CONV_W = 4
IN_AB = 3 * CONV_WIDTH + 2 * LRU_WIDTH
MIX_AB = CONV_WIDTH + LRU_WIDTH
N_HEADS = 16
HEAD_DIM = D_MODEL // N_HEADS
ATTN_WIDTH = N_HEADS * HEAD_DIM
ROT_DIM = HEAD_DIM // 4
ROPE_THETA = 500000.0
DILATED_PATTERNS = ((128, 1), (512, 4), (2048, 16))
QUERY_BLOCK = 64
N_EXPERTS = 16
N_GROUPS = 4
EXPERTS_PER_GROUP = N_EXPERTS // N_GROUPS
TOP_K = 2
EXPERT_FF = D_MODEL // 2
DISPATCH_BLOCK = 128
N_EVEN = (DEPTH + 1) // 2
N_ODD = DEPTH // 2
EPS = 1e-6
NEG_INF = -1e30

kernel_name = "hybrid_conv_lru_dilated_attn_grouped_moe_encoder"


def rmsnorm(x, g):
    xf = x.astype(jnp.float32)
    y = xf * lax.rsqrt(jnp.mean(xf * xf, axis=-1, keepdims=True) + EPS)
    return (y * g.astype(jnp.float32)).astype(x.dtype)


def modulate(h, shift, scale):
    return h * (1 + scale[:, None, :]) + shift[:, None, :]


def depthwise_conv(u, w, left):
    K = w.shape[0]
    S = u.shape[1]
    up = jnp.pad(u, ((0, 0), (left, K - 1 - left), (0, 0)))
    out = up[:, 0:S] * w[0]
    for k in range(1, K):
        out = out + up[:, k:k + S] * w[k]
    return out


def _linear_recurrence_combine(e1, e2):
    a1, b1 = e1
    a2, b2 = e2
    return a1 * a2, a2 * b1 + b2


def rglru(xr, wa, ba, wx, bx, lam, reverse):
    Bz, S, C = xr.shape
    xh = xr.reshape(Bz, S, LRU_HEADS, LRU_HEAD_DIM)
    r = jax.nn.sigmoid(jnp.einsum('bshi,hij->bshj', xh, wa).reshape(Bz, S, C) + ba).astype(jnp.float32)
    i = jax.nn.sigmoid(jnp.einsum('bshi,hij->bshj', xh, wx).reshape(Bz, S, C) + bx).astype(jnp.float32)
    log_a = -LRU_C * r * jax.nn.softplus(-lam.astype(jnp.float32))
    a = jnp.exp(log_a)
    mult = jnp.sqrt(-jnp.expm1(2.0 * log_a))
    b = xr.astype(jnp.float32) * i * mult
    _, h = lax.associative_scan(_linear_recurrence_combine, (a, b), axis=1, reverse=reverse)
    return h


def conv_lru_mixer(h, w_in, conv_a_w, conv_b_w, conv_b_b, lru_wa, lru_ba, lru_wx, lru_bx, lru_lambda, w_out):
    z = h @ w_in
    cw, lw = CONV_WIDTH, LRU_WIDTH
    a_val = z[..., 0:cw]
    a_gb = z[..., cw:2 * cw]
    a_gc = z[..., 2 * cw:3 * cw]
    b_gate = z[..., 3 * cw:3 * cw + lw]
    b_in = z[..., 3 * cw + lw:3 * cw + 2 * lw]
    y_a = a_gb * depthwise_conv(a_gc * a_val, conv_a_w, 1)
    xr = depthwise_conv(b_in, conv_b_w, 1) + conv_b_b
    h_rec = (rglru(xr, lru_wa[0], lru_ba[0], lru_wx[0], lru_bx[0], lru_lambda[0], False)
             + rglru(xr, lru_wa[1], lru_ba[1], lru_wx[1], lru_bx[1], lru_lambda[1], True))
    y_b = jax.nn.gelu(b_gate) * h_rec.astype(h.dtype)
    return jnp.concatenate([y_a, y_b], axis=-1) @ w_out


def partial_rotary(t, positions):
    inv_freq = ROPE_THETA ** (-jnp.arange(0, ROT_DIM, 2, dtype=jnp.float32) / ROT_DIM)
    ang = positions.astype(jnp.float32)[..., None] * inv_freq
    cos = jnp.cos(ang)[:, :, None, :]
    sin = jnp.sin(ang)[:, :, None, :]
    tr = t[..., :ROT_DIM].astype(jnp.float32)
    t1, t2 = tr[..., :ROT_DIM // 2], tr[..., ROT_DIM // 2:]
    rot = jnp.concatenate([t1 * cos - t2 * sin, t2 * cos + t1 * sin], axis=-1)
    return jnp.concatenate([rot.astype(t.dtype), t[..., ROT_DIM:]], axis=-1)


def band_attention(q, k, v, radius):
    Bz, G, L, H, hd = q.shape
    qb = QUERY_BLOCK
    nb = -(-L // qb)
    Lp = nb * qb
    span = qb + 2 * radius
    qp = jnp.pad(q, ((0, 0), (0, 0), (0, Lp - L), (0, 0), (0, 0)))
    kp = jnp.pad(k, ((0, 0), (0, 0), (radius, radius + Lp - L), (0, 0), (0, 0)))
    vp = jnp.pad(v, ((0, 0), (0, 0), (radius, radius + Lp - L), (0, 0), (0, 0)))
    kidx = jnp.arange(nb)[:, None] * qb + jnp.arange(span)[None, :]
    kb = kp[:, :, kidx]
    vb = vp[:, :, kidx]
    qblk = qp.reshape(Bz, G, nb, qb, H, hd)
    qpos = jnp.arange(nb)[:, None] * qb + jnp.arange(qb)[None, :]
    kpos = kidx - radius
    valid = ((jnp.abs(qpos[:, :, None] - kpos[:, None, :]) <= radius)
             & (kpos[:, None, :] >= 0) & (kpos[:, None, :] < L))
    s = jnp.einsum('bgnqhd,bgnkhd->bgnhqk', qblk, kb).astype(jnp.float32) * (hd ** -0.5)
    s = jnp.where(valid[:, None], s, NEG_INF)
    m = jnp.max(s, axis=-1, keepdims=True)
    p = jnp.exp(s - m)
    den = jnp.sum(p, axis=-1, keepdims=True)
    o = jnp.einsum('bgnhqk,bgnkhd->bgnqhd', p, vb.astype(jnp.float32)) / jnp.swapaxes(den, 3, 4)
    lse = jnp.swapaxes((m + jnp.log(den))[..., 0], 3, 4)
    o = o.reshape(Bz, G, Lp, H, hd)[:, :, :L]
    lse = lse.reshape(Bz, G, Lp, H)[:, :, :L]
    return o, lse


def dilated_attention(q, k, v):
    Bz, S, H, hd = q.shape
    outs, lses = [], []
    for (w, d) in DILATED_PATTERNS:
        radius = w // (2 * d)
        def to_sub(t):
            return t.reshape(Bz, S // d, d, H, hd).transpose(0, 2, 1, 3, 4)
        o, lse = band_attention(to_sub(q), to_sub(k), to_sub(v), radius)
        outs.append(o.transpose(0, 2, 1, 3, 4).reshape(Bz, S, H, hd))
        lses.append(lse.transpose(0, 2, 1, 3).reshape(Bz, S, H))
    wts = jax.nn.softmax(jnp.stack(lses, axis=-1), axis=-1)
    return jnp.einsum('bshp,pbshd->bshd', wts, jnp.stack(outs, axis=0))


def dilated_attn_mixer(h, positions, w_qkv, w_o):
    Bz, S, _ = h.shape
    qkv = (h @ w_qkv).reshape(Bz, S, 3, N_HEADS, HEAD_DIM)
    q = partial_rotary(qkv[:, :, 0], positions)
    k = partial_rotary(qkv[:, :, 1], positions)
    v = qkv[:, :, 2]
    o = dilated_attention(q, k, v).astype(h.dtype)
    return o.reshape(Bz, S, ATTN_WIDTH) @ w_o


def grouped_moe(h, router_w, router_bias, w_gate, w_up, w_down):
    Bz, S, D = h.shape
    T = Bz * S
    hf = h.reshape(T, D)
    scores = jax.nn.sigmoid((hf @ router_w).astype(jnp.float32))
    biased = scores + router_bias.astype(jnp.float32)
    grouped = biased.reshape(T, N_GROUPS, EXPERTS_PER_GROUP)
    group_score = jnp.sum(lax.top_k(grouped, 2)[0], axis=-1)
    best_group = jnp.argmax(group_score, axis=-1)
    in_group = (jnp.arange(N_EXPERTS) // EXPERTS_PER_GROUP)[None, :] == best_group[:, None]
    _, top_idx = lax.top_k(jnp.where(in_group, biased, -jnp.inf), TOP_K)
    top_s = jnp.take_along_axis(scores, top_idx, axis=-1)
    top_w = top_s / jnp.sum(top_s, axis=-1, keepdims=True)
    n_assign = T * TOP_K
    e_flat = top_idx.reshape(-1)
    w_flat = top_w.reshape(-1)
    tok_flat = jnp.arange(n_assign, dtype=jnp.int32) // TOP_K
    order = jnp.argsort(e_flat)
    e_sorted = e_flat[order]
    counts = jnp.zeros((N_EXPERTS,), jnp.int32).at[e_flat].add(1)
    padded = ((counts + DISPATCH_BLOCK - 1) // DISPATCH_BLOCK) * DISPATCH_BLOCK
    start = jnp.cumsum(counts) - counts
    pend = jnp.cumsum(padded)
    pstart = pend - padded
    dest = pstart[e_sorted] + (jnp.arange(n_assign, dtype=jnp.int32) - start[e_sorted])
    cap = n_assign + N_EXPERTS * DISPATCH_BLOCK
    n_blocks = cap // DISPATCH_BLOCK
    slot_tok = jnp.full((cap,), T, jnp.int32).at[dest].set(tok_flat[order])
    slot_w = jnp.zeros((cap,), jnp.float32).at[dest].set(w_flat[order])
    block_start = jnp.arange(n_blocks, dtype=jnp.int32) * DISPATCH_BLOCK
    block_expert = jnp.minimum(jnp.searchsorted(pend, block_start, side='right'), N_EXPERTS - 1)
    hpad = jnp.concatenate([hf, jnp.zeros((1, D), hf.dtype)], axis=0)
    xs = hpad[slot_tok].reshape(n_blocks, DISPATCH_BLOCK, D)

    def expert_block(args):
        xb, e = args
        return (jax.nn.silu(xb @ w_gate[e]) * (xb @ w_up[e])) @ w_down[e]

    yb = lax.map(expert_block, (xs, block_expert)).reshape(cap, D)
    out = jnp.zeros((T + 1, D), jnp.float32).at[slot_tok].add(yb.astype(jnp.float32) * slot_w[:, None])
    return out[:T].reshape(Bz, S, D).astype(h.dtype)


def setup_inputs(seed: int = 0) -> dict:
    key = jax.random.key(seed)
    ks = iter(jax.random.split(key, 32))
    nrm = lambda shape, scale: jax.random.normal(next(ks), shape, jnp.float32) * scale
    x = nrm((BATCH, SEQ, D_MODEL), 1.0)
    c = nrm((BATCH, D_MODEL), 1.0)
    offset = jax.random.randint(next(ks), (BATCH, 1), 0, 1024, dtype=jnp.int32)
    positions = (jnp.arange(SEQ, dtype=jnp.int32)[None, :] + offset).astype(jnp.int32)
    mod_w = nrm((DEPTH, D_MODEL, 6 * D_MODEL), 0.5 * D_MODEL ** -0.5)
    mod_b = nrm((DEPTH, 6 * D_MODEL), 0.02)
    norm_mix_g = 1.0 + nrm((DEPTH, D_MODEL), 0.02)
    norm_ffn_g = 1.0 + nrm((DEPTH, D_MODEL), 0.02)
    final_norm_g = 1.0 + nrm((D_MODEL,), 0.02)
    w_in_ab = nrm((N_EVEN, D_MODEL, IN_AB), D_MODEL ** -0.5)
    conv_a_w = nrm((N_EVEN, SHORT_CONV_W, CONV_WIDTH), SHORT_CONV_W ** -0.5)
    conv_b_w = nrm((N_EVEN, REC_CONV_W, LRU_WIDTH), REC_CONV_W ** -0.5)
    conv_b_b = nrm((N_EVEN, LRU_WIDTH), 0.02)
    lru_wa = nrm((N_EVEN, 2, LRU_HEADS, LRU_HEAD_DIM, LRU_HEAD_DIM), LRU_HEAD_DIM ** -0.5)
    lru_ba = nrm((N_EVEN, 2, LRU_WIDTH), 0.02)
    lru_wx = nrm((N_EVEN, 2, LRU_HEADS, LRU_HEAD_DIM, LRU_HEAD_DIM), LRU_HEAD_DIM ** -0.5)
    lru_bx = nrm((N_EVEN, 2, LRU_WIDTH), 0.02)
    u = jax.random.uniform(next(ks), (N_EVEN, 2, LRU_WIDTH), jnp.float32, 0.9, 0.999)
    s_lam = u ** (1.0 / LRU_C)
    lru_lambda = jnp.log(s_lam) - jnp.log1p(-s_lam)
    w_out_ab = nrm((N_EVEN, MIX_AB, D_MODEL), MIX_AB ** -0.5)
    w_qkv = nrm((N_ODD, D_MODEL, 3 * ATTN_WIDTH), D_MODEL ** -0.5)
    w_o = nrm((N_ODD, ATTN_WIDTH, D_MODEL), ATTN_WIDTH ** -0.5)
    router_w = nrm((D_MODEL, N_EXPERTS), D_MODEL ** -0.5)
    router_bias = nrm((N_EXPERTS,), 0.01)
    expert_w_gate = nrm((DEPTH, N_EXPERTS, D_MODEL, EXPERT_FF), D_MODEL ** -0.5)
    expert_w_up = nrm((DEPTH, N_EXPERTS, D_MODEL, EXPERT_FF), D_MODEL ** -0.5)
    expert_w_down = nrm((DEPTH, N_EXPERTS, EXPERT_FF, D_MODEL), EXPERT_FF ** -0.5)
    return {"x": x, "c": c, "positions": positions, "mod_w": mod_w, "mod_b": mod_b,
            "norm_mix_g": norm_mix_g, "norm_ffn_g": norm_ffn_g, "final_norm_g": final_norm_g,
            "w_in_ab": w_in_ab, "conv_a_w": conv_a_w, "conv_b_w": conv_b_w, "conv_b_b": conv_b_b,
            "lru_wa": lru_wa, "lru_ba": lru_ba, "lru_wx": lru_wx, "lru_bx": lru_bx,
            "lru_lambda": lru_lambda, "w_out_ab": w_out_ab, "w_qkv": w_qkv, "w_o": w_o,
            "router_w": router_w, "router_bias": router_bias, "expert_w_gate": expert_w_gate,
            "expert_w_up": expert_w_up, "expert_w_down": expert_w_down}


def reference(x, c, positions, mod_w, mod_b, norm_mix_g, norm_ffn_g, final_norm_g,
              w_in_ab, conv_a_w, conv_b_w, conv_b_b, lru_wa, lru_ba, lru_wx, lru_bx,
              lru_lambda, w_out_ab, w_qkv, w_o, router_w, router_bias,
              expert_w_gate, expert_w_up, expert_w_down):
    cs = jax.nn.silu(c)
    for l in range(DEPTH):
        mod = cs @ mod_w[l] + mod_b[l]
        sh1, sc1, g1, sh2, sc2, g2 = jnp.split(mod, 6, axis=-1)
        h = modulate(rmsnorm(x, norm_mix_g[l]), sh1, sc1)
        if l % 2 == 0:
            j = l // 2
            y = conv_lru_mixer(h, w_in_ab[j], conv_a_w[j], conv_b_w[j], conv_b_b[j], lru_wa[j], lru_ba[j],
                               lru_wx[j], lru_bx[j], lru_lambda[j], w_out_ab[j])
        else:
            j = l // 2
            y = dilated_attn_mixer(h, positions, w_qkv[j], w_o[j])
        x = x + g1[:, None, :] * y
        h = modulate(rmsnorm(x, norm_ffn_g[l]), sh2, sc2)
        x = x + g2[:, None, :] * grouped_moe(h, router_w, router_bias,
                                             expert_w_gate[l], expert_w_up[l], expert_w_down[l])
    return rmsnorm(x, final_norm_g)
```

```cpp
#include <hip/hip_runtime.h>
#include <cstdio>
#include <cstdint>

#ifndef MK_ONE_LAUNCH
#define MK_ONE_LAUNCH 1
#endif

namespace pg8 {
#define PG8_LAS __attribute__((address_space(3)))
typedef unsigned short bf16_t;
typedef short bf16x8 __attribute__((ext_vector_type(8)));
typedef float f32x4 __attribute__((ext_vector_type(4)));
typedef unsigned u32x4 __attribute__((ext_vector_type(4)));
constexpr int BM = 256, BK = 64, HALF = 128, HTB = HALF * BK * 2  , STAGE_BYTES = 8 * HTB, NXCD = 8, WGM = 8;

__host__ __device__ __forceinline__ int lds_byte(int r, int c) { const int st = (r >> 4) * 2 + (c >> 5), rr = r & 15, cc = c & 31, ob = rr * 64 + cc * 2; return st * 1024 + (ob ^ (((ob >> 9) & 1) << 5)); }
__host__ __device__ __forceinline__ void stage_rc(int b, int& R, int& C) { const int st = b / 1024, sb = b % 1024, swz = sb ^ (((sb >> 9) & 1) << 5); R = (st >> 1) * 16 + swz / 64; C = (st & 1) * 32 + (swz % 64) / 2; }
__host__ __device__ __forceinline__ int perm32(int rho) { const int n = rho >> 4, i = rho & 15; return 8 * (i >> 2) + 4 * n + (i & 3); }

struct Unit { int pm, pn, e; };

struct StaticOrder {
    const char* A; const char* Bt; size_t tstep;
    int nM, nN, nwg, G, c;
    __device__ void init(const void* A_, const void* Bt_, int M, int N, int K, int G_, int c_) { A = (const char*)A_; Bt = (const char*)Bt_; tstep = (size_t)256 * K * 2; nM = M / BM; nN = N / BM; nwg = nM * nN; G = G_; c = c_; }
    __device__ bool next(int i, Unit& u) const {
        const long L = (long)i * G + c; if (L >= nwg) return false;
        int wgid = (int)L; { const int q = nwg / NXCD, r = nwg % NXCD, xcd = wgid % NXCD, off = wgid / NXCD; wgid = (xcd < r ? xcd * (q + 1) : r * (q + 1) + (xcd - r) * q) + off; }
        const int nig = WGM * nN, gid = wgid / nig, fm = gid * WGM, gsz = (nM - fm) < WGM ? (nM - fm) : WGM;
        u.pm = fm + ((wgid % nig) % gsz); u.pn = (wgid % nig) / gsz; u.e = 0; return true;
    }
    __device__ __forceinline__ const char* a_base(const Unit& u) const { return A + (size_t)u.pm * tstep; }
    __device__ __forceinline__ const char* b_base(const Unit& u) const { return Bt + (size_t)u.pn * tstep; }
    __device__ __forceinline__ void a_ready(const Unit&) const {}
    __device__ __forceinline__ void done(const Unit&) const {}
};
struct MoeOrder {
    const char* A; const char* Bt; size_t tstep, estride;
    const volatile PG8_LAS unsigned* tp; int G, c;
    __device__ bool next(int i, Unit& u) const {
        const int L = i * G + c; if (L >= (int)tp[16] * 4) return false;
        const int pt = L >> 2; int e = 0;
#pragma unroll
        for (int j = 1; j < 16; ++j) e += (pt >= (int)tp[j]) ? 1 : 0;
        e = __builtin_amdgcn_readfirstlane(e);
        u.pm = pt; u.pn = L & 3; u.e = e; return true;
    }
    __device__ __forceinline__ const char* a_base(const Unit& u) const { return A + (size_t)u.pm * tstep; }
    __device__ __forceinline__ const char* b_base(const Unit& u) const { return Bt + (size_t)u.e * estride + (size_t)u.pn * tstep; }
    __device__ __forceinline__ void a_ready(const Unit&) const {}
    __device__ __forceinline__ void done(const Unit&) const {}
};

__device__ __forceinline__ unsigned cvt_pk_bf16(float lo, float hi) { unsigned r; asm volatile("v_cvt_pk_bf16_f32 %0, %1, %2" : "=v"(r) : "v"(lo), "v"(hi)); return r; }
__device__ __forceinline__ u32x4 pack8(const f32x4 v0, const f32x4 v1) { u32x4 w; w.x = cvt_pk_bf16(v0[0], v0[1]); w.y = cvt_pk_bf16(v0[2], v0[3]); w.z = cvt_pk_bf16(v1[0], v1[1]); w.w = cvt_pk_bf16(v1[2], v1[3]); return w; }

struct EpiStore {
    static constexpr bool PERM = true, AFTER_DRAIN = false;
    bf16_t* O; int ldc;
    __device__ __forceinline__ void operator()(const f32x4 (&acc)[2][2][4][2], const Unit& u, int wr, int wc, int fr, int fq) const {
        const int row0 = u.pm * BM + wr * 64 + fr, col0 = u.pn * BM + wc * 32 + 8 * fq;
#pragma unroll
        for (int ai = 0; ai < 2; ++ai)
#pragma unroll
            for (int m = 0; m < 4; ++m) { bf16_t* rowp = O + (size_t)(row0 + ai * HALF + m * 16) * ldc + col0;
#pragma unroll
                for (int bj = 0; bj < 2; ++bj) *(u32x4*)(rowp + bj * HALF) = pack8(acc[ai][bj][m][0], acc[ai][bj][m][1]); }
    }
};
struct EpiQKV {
    static constexpr bool PERM = true, AFTER_DRAIN = false;
    bf16_t* O; const float* rot;
    __device__ __forceinline__ void operator()(const f32x4 (&acc)[2][2][4][2], const Unit& u, int wr, int wc, int fr, int fq) const {
        const int row0 = u.pm * BM + wr * 64 + fr, col0 = u.pn * BM + wc * 32 + 8 * fq;
        const bool rotw = (u.pn < 8) && ((wc & 1) == 0);
#pragma unroll
        for (int ai = 0; ai < 2; ++ai)
#pragma unroll
            for (int m = 0; m < 4; ++m) { const int row = row0 + ai * HALF + m * 16; bf16_t* rowp = O + (size_t)row * 3072 + col0;
                f32x4 cs[4];
                if (rotw) {
#pragma unroll
                    for (int q = 0; q < 4; ++q) cs[q] = *(const f32x4*)(rot + (size_t)row * 16 + q * 4); }
#pragma unroll
                for (int bj = 0; bj < 2; ++bj) { f32x4 v0 = acc[ai][bj][m][0], v1 = acc[ai][bj][m][1];
                    if (rotw) {
                        f32x4 p0, p1;
#pragma unroll
                        for (int j = 0; j < 4; ++j) { p0[j] = __shfl_xor(v0[j], 16); p1[j] = __shfl_xor(v1[j], 16); }
                        if (fq < 2) { const float sg = (fq == 0) ? -1.f : 1.f;
                            v0[0] = v0[0] * cs[0][0] + sg * p0[0] * cs[0][1]; v0[1] = v0[1] * cs[0][2] + sg * p0[1] * cs[0][3];
                            v0[2] = v0[2] * cs[1][0] + sg * p0[2] * cs[1][1]; v0[3] = v0[3] * cs[1][2] + sg * p0[3] * cs[1][3];
                            v1[0] = v1[0] * cs[2][0] + sg * p1[0] * cs[2][1]; v1[1] = v1[1] * cs[2][2] + sg * p1[1] * cs[2][3];
                            v1[2] = v1[2] * cs[3][0] + sg * p1[2] * cs[3][1]; v1[3] = v1[3] * cs[3][2] + sg * p1[3] * cs[3][3]; }
                    }
                    *(u32x4*)(rowp + bj * HALF) = pack8(v0, v1); } }
    }
};
struct EpiGU {
    static constexpr bool PERM = true, AFTER_DRAIN = false;
    bf16_t* O;
    __device__ __forceinline__ void operator()(const f32x4 (&acc)[2][2][4][2], const Unit& u, int wr, int wc, int fr, int fq) const {
        const int row0 = u.pm * BM + wr * 64 + fr, col0 = u.pn * 128 + wc * 32 + 8 * fq;
#pragma unroll
        for (int ai = 0; ai < 2; ++ai)
#pragma unroll
            for (int m = 0; m < 4; ++m) { bf16_t* rowp = O + (size_t)(row0 + ai * HALF + m * 16) * 512 + col0;
                f32x4 o[2];
#pragma unroll
                for (int n = 0; n < 2; ++n)
#pragma unroll
                    for (int j = 0; j < 4; ++j) { const float g = acc[ai][0][m][n][j], up = acc[ai][1][m][n][j]; o[n][j] = g / (1.f + __expf(-g)) * up; }
                *(u32x4*)rowp = pack8(o[0], o[1]); }
    }
};
struct EpiDN {
    static constexpr bool PERM = true, AFTER_DRAIN = false;
    bf16_t* O; const int* sloti; const float* slotw;
    __device__ __forceinline__ void operator()(const f32x4 (&acc)[2][2][4][2], const Unit& u, int wr, int wc, int fr, int fq) const {
        const int row0 = u.pm * BM + wr * 64 + fr, col0 = u.pn * BM + wc * 32 + 8 * fq;
#pragma unroll
        for (int ai = 0; ai < 2; ++ai)
#pragma unroll
            for (int m = 0; m < 4; ++m) { const int row = row0 + ai * HALF + m * 16; const int info = sloti[row]; const float w = slotw[row];
                if (info >= 0) { bf16_t* rowp = O + (size_t)info * 1024 + col0;
#pragma unroll
                    for (int bj = 0; bj < 2; ++bj) *(u32x4*)(rowp + bj * HALF) = pack8(acc[ai][bj][m][0] * w, acc[ai][bj][m][1] * w); } }
    }
};

template <class Epi, class Sched, bool ALIGN_EPI = false, bool SP2 = false>
__device__ __forceinline__ void gemm_phase(PG8_LAS unsigned char* lds, const int K, const Sched& S, const Epi& E, const int tid) {
    const int wid = __builtin_amdgcn_readfirstlane(tid >> 6), lane = tid & 63, wr = wid >> 2, wc = wid & 3, fr = lane & 15, fq = lane >> 4;
    const int nt = K / BK;
    unsigned voffA[2], voffB[2];
#pragma unroll
    for (int i = 0; i < 2; ++i) { int R, C; stage_rc(tid * 16 + i * 8192, R, C); const int Rb = Epi::PERM ? ((R & ~31) + perm32(R & 31)) : R;
        voffA[i] = (unsigned)(R * K + C) * 2u; voffB[i] = (unsigned)(Rb * K + C) * 2u; }
    const size_t kstep = (size_t)(BK * 2);
    const size_t hstep = (size_t)HALF * K * 2;
    const unsigned ldsw = (unsigned)wid * 1024u;
    const int aoff = lds_byte(wr * 64 + fr, fq * 8), boff = lds_byte(wc * 32 + fr, fq * 8);
#define PG8_SA(b, h) (((b) * 2 + (h)) * HTB)
#define PG8_SB(b, h) ((4 + (b) * 2 + (h)) * HTB)
#define PG8_STAGE(bufoff, gbase, voff) do { _Pragma("unroll") for (int _i = 0; _i < 2; ++_i) \
        __builtin_amdgcn_global_load_lds((const unsigned*)((const char*)(gbase) + (voff)[_i]), (PG8_LAS unsigned*)(lds + (bufoff) + ldsw + _i * 8192), 16, 0, 0); } while (0)
#define PG8_LDA(dst, b, h) do { _Pragma("unroll") for (int m = 0; m < 4; ++m) _Pragma("unroll") for (int k = 0; k < 2; ++k) dst[m][k] = *(const PG8_LAS bf16x8*)(lds + PG8_SA(b, h) + aoff + m * 2048 + k * 1024); } while (0)
#define PG8_LDB(dst, b, h) do { _Pragma("unroll") for (int n = 0; n < 2; ++n) _Pragma("unroll") for (int k = 0; k < 2; ++k) dst[n][k] = *(const PG8_LAS bf16x8*)(lds + PG8_SB(b, h) + boff + n * 2048 + k * 1024); } while (0)
#define PG8_MMA(ai, bj, At, Bt) do { __builtin_amdgcn_s_setprio(1); _Pragma("unroll") for (int m = 0; m < 4; ++m) _Pragma("unroll") for (int n = 0; n < 2; ++n) _Pragma("unroll") for (int k = 0; k < 2; ++k) \
        acc[ai][bj][m][n] = __builtin_amdgcn_mfma_f32_16x16x32_bf16(Bt[n][k], At[m][k], acc[ai][bj][m][n], 0, 0, 0); __builtin_amdgcn_s_setprio(0); } while (0)
#define PG8_WAIT_V(n) asm volatile("s_waitcnt vmcnt(" #n ")" ::: "memory")
#define PG8_WAIT_L(n) asm volatile("s_waitcnt lgkmcnt(" #n ")" ::: "memory")
#define PG8_BAR __builtin_amdgcn_s_barrier()
#define PG8_SCHED __builtin_amdgcn_sched_barrier(0)
    Unit cur, nxt; int ui = 0;
    if (!S.next(0, cur)) return;
    f32x4 acc[2][2][4][2];
#pragma unroll
    for (int a = 0; a < 2; ++a)
#pragma unroll
        for (int b = 0; b < 2; ++b)
#pragma unroll
            for (int m = 0; m < 4; ++m)
#pragma unroll
                for (int n = 0; n < 2; ++n) acc[a][b][m][n] = (f32x4){0.f, 0.f, 0.f, 0.f};
    bf16x8 At[4][2], B0[2][2], B1[2][2];
    const char* cA = S.a_base(cur); const char* cB = S.b_base(cur);
    S.a_ready(cur);
    if constexpr (SP2) {
        PG8_STAGE(PG8_SB(0, 0), cB, voffB); PG8_STAGE(PG8_SB(0, 1), cB + hstep, voffB); PG8_STAGE(PG8_SA(0, 0), cA, voffA); PG8_STAGE(PG8_SA(0, 1), cA + hstep, voffA);
        if (wr == 1) PG8_BAR;
        PG8_WAIT_V(2); PG8_BAR;
        PG8_STAGE(PG8_SB(1, 0), cB + kstep, voffB); PG8_STAGE(PG8_SA(1, 0), cA + kstep, voffA); PG8_STAGE(PG8_SB(1, 1), cB + hstep + kstep, voffB);
        PG8_WAIT_V(6); PG8_BAR;
    } else {
        PG8_STAGE(PG8_SB(0, 0), cB, voffB); PG8_STAGE(PG8_SA(0, 0), cA, voffA); PG8_STAGE(PG8_SB(0, 1), cB + hstep, voffB); PG8_STAGE(PG8_SA(0, 1), cA + hstep, voffA);
        if (wr == 1) PG8_BAR;
        PG8_WAIT_V(4); PG8_BAR;
        PG8_STAGE(PG8_SB(1, 0), cB + kstep, voffB); PG8_STAGE(PG8_SA(1, 0), cA + kstep, voffA); PG8_STAGE(PG8_SB(1, 1), cB + hstep + kstep, voffB);
        PG8_WAIT_V(6); PG8_BAR;
    }
    for (;;) {
        const bool has_next = S.next(ui + 1, nxt);
        const char* nA = has_next ? S.a_base(nxt) : cA; const char* nB = has_next ? S.b_base(nxt) : cB;
        for (int t = 0; t < nt; t += 2) {
            const bool last = (t == nt - 2);
            const char* a1 = cA + (size_t)(t + 1) * kstep;
            const char* a2 = last ? nA : cA + (size_t)(t + 2) * kstep; const char* b2 = last ? nB : cB + (size_t)(t + 2) * kstep;
            const char* a3 = a2 + kstep; const char* b3 = b2 + kstep;
            if (last && has_next) S.a_ready(nxt);
            if constexpr (SP2) {
            PG8_LDB(B0, 0, 0); PG8_LDB(B1, 0, 1); PG8_SCHED; PG8_LDA(At, 0, 0); PG8_STAGE(PG8_SA(1, 1), a1 + hstep, voffA);
            PG8_WAIT_V(8); PG8_WAIT_L(0); PG8_BAR; PG8_MMA(0, 0, At, B0); PG8_MMA(0, 1, At, B1); PG8_BAR; PG8_SCHED;
            PG8_LDA(At, 0, 1); PG8_STAGE(PG8_SB(0, 0), b2, voffB); PG8_STAGE(PG8_SB(0, 1), b2 + hstep, voffB); PG8_STAGE(PG8_SA(0, 0), a2, voffA);
            PG8_WAIT_V(8); PG8_WAIT_L(0); PG8_BAR; PG8_MMA(1, 0, At, B0); PG8_MMA(1, 1, At, B1); PG8_BAR; PG8_SCHED;
            PG8_LDB(B0, 1, 0); PG8_LDB(B1, 1, 1); PG8_SCHED; PG8_LDA(At, 1, 0); PG8_STAGE(PG8_SA(0, 1), a2 + hstep, voffA);
            PG8_WAIT_V(8); PG8_WAIT_L(0); PG8_BAR; PG8_MMA(0, 0, At, B0); PG8_MMA(0, 1, At, B1); PG8_BAR; PG8_SCHED;
            PG8_LDA(At, 1, 1); PG8_STAGE(PG8_SB(1, 0), b3, voffB); PG8_STAGE(PG8_SB(1, 1), b3 + hstep, voffB); PG8_STAGE(PG8_SA(1, 0), a3, voffA);
            PG8_WAIT_V(8); PG8_WAIT_L(0); PG8_BAR; PG8_MMA(1, 0, At, B0); PG8_MMA(1, 1, At, B1); PG8_BAR; PG8_SCHED;
            } else {
            PG8_LDB(B0, 0, 0); PG8_SCHED; PG8_LDA(At, 0, 0); PG8_STAGE(PG8_SA(1, 1), a1 + hstep, voffA);
            PG8_WAIT_L(8); PG8_BAR; PG8_WAIT_L(0); PG8_MMA(0, 0, At, B0); PG8_BAR; PG8_SCHED;
            PG8_LDB(B1, 0, 1); PG8_STAGE(PG8_SB(0, 0), b2, voffB);
            PG8_BAR; PG8_WAIT_L(0); PG8_MMA(0, 1, At, B1); PG8_BAR;
            PG8_LDA(At, 0, 1); PG8_STAGE(PG8_SA(0, 0), a2, voffA);
            PG8_BAR; PG8_WAIT_L(0); PG8_MMA(1, 0, At, B0); PG8_BAR; PG8_SCHED;
            PG8_STAGE(PG8_SB(0, 1), b2 + hstep, voffB);
            PG8_WAIT_V(6); PG8_BAR; PG8_MMA(1, 1, At, B1); PG8_BAR;
            PG8_LDB(B0, 1, 0); PG8_SCHED; PG8_LDA(At, 1, 0); PG8_STAGE(PG8_SA(0, 1), a2 + hstep, voffA);
            PG8_WAIT_L(8); PG8_BAR; PG8_WAIT_L(0); PG8_MMA(0, 0, At, B0); PG8_BAR; PG8_SCHED;
            PG8_LDB(B1, 1, 1); PG8_STAGE(PG8_SB(1, 0), b3, voffB);
            PG8_BAR; PG8_WAIT_L(0); PG8_MMA(0, 1, At, B1); PG8_BAR;
            PG8_LDA(At, 1, 1); PG8_STAGE(PG8_SA(1, 0), a3, voffA);
            PG8_BAR; PG8_WAIT_L(0); PG8_MMA(1, 0, At, B0); PG8_BAR; PG8_SCHED;
            PG8_STAGE(PG8_SB(1, 1), b3 + hstep, voffB);
            PG8_WAIT_V(6); PG8_BAR; PG8_MMA(1, 1, At, B1); PG8_BAR;
            }
        }
        if constexpr (ALIGN_EPI) { if (wr == 0) PG8_BAR; }
        if constexpr (!Epi::AFTER_DRAIN) { E(acc, cur, wr, wc, fr, fq); S.done(cur); }
        if (!has_next) break;
#pragma unroll
        for (int a = 0; a < 2; ++a)
#pragma unroll
            for (int b = 0; b < 2; ++b)
#pragma unroll
                for (int m = 0; m < 4; ++m)
#pragma unroll
                    for (int n = 0; n < 2; ++n) acc[a][b][m][n] = (f32x4){0.f, 0.f, 0.f, 0.f};
        cur = nxt; cA = nA; cB = nB; ++ui;
        if constexpr (ALIGN_EPI) { if (wr == 1) PG8_BAR; }
    }
    PG8_WAIT_V(0);
    if constexpr (!ALIGN_EPI) { if (wr == 0) PG8_BAR; }
    PG8_BAR;
    if constexpr (Epi::AFTER_DRAIN) { E.fused(acc, cur, wr, wc, fr, fq, lds, wid, lane); S.done(cur); }
#undef PG8_SA
#undef PG8_SB
#undef PG8_STAGE
#undef PG8_LDA
#undef PG8_LDB
#undef PG8_MMA
#undef PG8_WAIT_V
#undef PG8_WAIT_L
#undef PG8_BAR
#undef PG8_SCHED
}
}

constexpr int NB = 8, SEQ = 2048, T = NB * SEQ, D = 1024, DEPTH = 4;
constexpr int IN_AB = 2560, NQKV = 3072, NE = 16, FF = 512;
constexpr int MAXTILES = 144, MPAD = MAXTILES * 256;
constexpr int NWAVES = 8, NTHR = 512;

constexpr size_t MiB = 1u << 20;
constexpr size_t WS_CTL = 0, CTL_ZERO_BYTES = 1 * MiB;
constexpr int CW_TMO = 0, CW_BAR = 64, CW_CNT = 8192;
constexpr size_t WS_MOD = 1 * MiB;
constexpr size_t WS_ROT = 2 * MiB;
constexpr size_t WS_AGG = 3 * MiB;
constexpr size_t WS_LIST = 5 * MiB;
constexpr size_t WS_TOPW = 6 * MiB;
constexpr size_t WS_SLOTI = 6 * MiB + 512 * 1024;
constexpr size_t WS_SLOTW = 7 * MiB;
constexpr size_t WS_LRUW = 7 * MiB + 512 * 1024;
constexpr size_t WS_WIN = 8 * MiB;
constexpr size_t WS_WOUT = 18 * MiB;
constexpr size_t WS_WQKV = 22 * MiB;
constexpr size_t WS_WO = 34 * MiB;
constexpr size_t WS_WGU = 38 * MiB;
constexpr size_t WS_WDN = 166 * MiB;
constexpr size_t WS_X = 230 * MiB;
constexpr size_t WS_HB = 294 * MiB;
constexpr size_t WS_R1 = 326 * MiB;
constexpr size_t R1_Z = 0;
constexpr size_t R1_DELTA = 0;
constexpr size_t R1_XS = 0;
constexpr size_t R1_ACT = 72 * MiB;
constexpr size_t R1_YW = 108 * MiB;
constexpr size_t WS_END = 526 * MiB;

constexpr int RING_BYTES = 131072;
constexpr int MISC_OFF = RING_BYTES;
constexpr int ENT_OFF = RING_BYTES + 1024;
constexpr int LDS_BYTES = 147456 + 4096;

#define GAS __attribute__((address_space(1)))
#define LAS __attribute__((address_space(3)))
typedef unsigned short bf16;
typedef unsigned v4u __attribute__((ext_vector_type(4)));
typedef unsigned v2u __attribute__((ext_vector_type(2)));
typedef float f32x4 __attribute__((ext_vector_type(4)));
typedef float f32x2 __attribute__((ext_vector_type(2)));
#define RLX_AGENT __ATOMIC_RELAXED, __HIP_MEMORY_SCOPE_AGENT
#define LDS_WAIT() asm volatile("s_waitcnt lgkmcnt(0)" ::: "memory")
#define VM_WAIT() asm volatile("s_waitcnt vmcnt(0)" ::: "memory")
__device__ __forceinline__ unsigned f2bf(float f) { unsigned u = __builtin_bit_cast(unsigned, f); return (u + 0x7fffu + ((u >> 16) & 1u)) >> 16; }
__device__ __forceinline__ unsigned pk2(float lo, float hi) { return f2bf(lo) | (f2bf(hi) << 16); }
__device__ __forceinline__ float bf2f(unsigned short b) { return __builtin_bit_cast(float, (unsigned)b << 16); }
__device__ __forceinline__ float bflo(unsigned w) { return __builtin_bit_cast(float, w << 16); }
__device__ __forceinline__ float bfhi(unsigned w) { return __builtin_bit_cast(float, w & 0xffff0000u); }

#define XB_TMO      128
#define XB_XCNT(j)  (256  + 64 * (j))
#define XB_XSUB(j)  (1280 + 64 * (j))
#define XB_XGEN(j)  (2304 + 64 * (j))
#define XB_TOP      3328
#define XB_TOPGEN   3392
#define XCD_BAR_WORDS 3456
#define XB_SPIN_CAP (1u << 18)

__device__ __forceinline__ unsigned xb_ld(unsigned* p)              { return __hip_atomic_load(p, __ATOMIC_RELAXED, __HIP_MEMORY_SCOPE_AGENT); }
__device__ __forceinline__ unsigned xb_add(unsigned* p, unsigned v) { return __hip_atomic_fetch_add(p, v, __ATOMIC_RELAXED, __HIP_MEMORY_SCOPE_AGENT); }
__device__ __forceinline__ unsigned xb_xcc_id() { return (unsigned)__builtin_amdgcn_s_getreg((3 << 11) | 20) & 0xFu; }
#define XB_SPIN(cond, bar) do { unsigned _sp = 0; while (cond) { __builtin_amdgcn_s_sleep(1); \
    if ((++_sp & 255u) == 0u) { if (xb_ld(&(bar)[XB_TMO])) break; if (_sp > XB_SPIN_CAP) { atomicAdd(&(bar)[XB_TMO], 1u); break; } } } } while (0)

struct XcdBarrier {
    unsigned* bar; unsigned x;
    volatile LAS unsigned* st;
};

__device__ __forceinline__ XcdBarrier xcd_barrier_post(unsigned* bar, volatile LAS unsigned* st) {
    XcdBarrier b; b.bar = bar; b.x = xb_xcc_id(); b.st = st;
    if (threadIdx.x == 0) (void)xb_add(&bar[XB_XCNT(b.x)], 1u);
    return b;
}
__device__ __forceinline__ void xcd_barrier_complete(unsigned* bar, unsigned x, unsigned& nloc, unsigned& nx) {
    const unsigned G = gridDim.x * gridDim.y * gridDim.z;
    unsigned sum, cnt, mine, sp = 0u;
    for (;;) {
        sum = 0u; cnt = 0u; mine = 0u;
#pragma unroll
        for (unsigned j = 0; j < 16; ++j) { const unsigned c = xb_ld(&bar[XB_XCNT(j)]); sum += c; cnt += (c > 0u) ? 1u : 0u; mine = (j == x) ? c : mine; }
        if (sum == G) break;
        __builtin_amdgcn_s_sleep(1);
        if ((++sp & 255u) == 0u) { if (xb_ld(&bar[XB_TMO])) break; if (sp > XB_SPIN_CAP) { atomicAdd(&bar[XB_TMO], 1u); break; } }
    }
    nloc = mine > 0u ? mine : 1u; nx = cnt > 0u ? cnt : 1u;
}

__device__ __forceinline__ void xcd_barrier(const XcdBarrier& b) {
    asm volatile("s_waitcnt vmcnt(0)" ::: "memory");
    __syncthreads();
    if (threadIdx.x == 0) {
        unsigned* bar = b.bar;
        __builtin_amdgcn_s_waitcnt(0);
        unsigned nloc = b.st[0], nx = b.st[1];
        if (nloc == 0u) { xcd_barrier_complete(bar, b.x, nloc, nx); b.st[0] = nloc; b.st[1] = nx; }
        const unsigned old = xb_add(&bar[XB_XSUB(b.x)], 1u);
        const unsigned gen = old / nloc;
        if (old + 1u == (gen + 1u) * nloc) {
            __builtin_amdgcn_fence(__ATOMIC_RELEASE, "agent");
            asm volatile("s_waitcnt vmcnt(0)" ::: "memory");
            const unsigned og = xb_add(&bar[XB_TOP], 1u);
            const unsigned tg = og / nx;
            if (og + 1u == (tg + 1u) * nx) xb_add(&bar[XB_TOPGEN], 1u);
            else XB_SPIN(xb_ld(&bar[XB_TOPGEN]) == tg, bar);
            __builtin_amdgcn_fence(__ATOMIC_ACQUIRE, "agent");
            xb_add(&bar[XB_XGEN(b.x)], 1u);
            asm volatile("s_waitcnt vmcnt(0)" ::: "memory");
        } else {
            XB_SPIN(xb_ld(&bar[XB_XGEN(b.x)]) == gen, bar);
            __builtin_amdgcn_fence(__ATOMIC_ACQUIRE, "agent");
            asm volatile("s_waitcnt vmcnt(0)" ::: "memory");
        }
    }
    __syncthreads();
}


__device__ __forceinline__ float wave_sum(float v) {
#pragma unroll
    for (int o = 1; o < 64; o <<= 1) v += __shfl_xor(v, o);
    return v;
}
__device__ __forceinline__ float wave_max(float v) {
#pragma unroll
    for (int o = 1; o < 64; o <<= 1) v = fmaxf(v, __shfl_xor(v, o));
    return v;
}
__device__ __forceinline__ float sigmoidf_(float x) { return 1.f / (1.f + expf(-x)); }
__device__ __forceinline__ float gelu_tanh(float x) { const float u = 0.7978845608028654f * (x + 0.044715f * x * x * x); return 0.5f * x * (1.f + tanhf(u)); }
__device__ __forceinline__ void sincos_acc(float ang, float& c, float& s) {
    const double x = (double)ang, q = rint(x * 0.63661977236758134), r = x - q * 1.5707963267948966;
    const int qi = ((int)q) & 3; const float rf = (float)r, r2 = rf * rf;
    const float sp = rf * (1.f + r2 * (-1.6666667e-1f + r2 * (8.3333333e-3f + r2 * (-1.9841270e-4f + r2 * 2.7557319e-6f))));
    const float cp = 1.f + r2 * (-0.5f + r2 * (4.1666667e-2f + r2 * (-1.3888889e-3f + r2 * (2.4801587e-5f - r2 * 2.7557319e-7f))));
    c = (qi == 0) ? cp : (qi == 1) ? -sp : (qi == 2) ? -cp : sp;
    s = (qi == 0) ? sp : (qi == 1) ? cp : (qi == 2) ? -sp : -cp;
}

#define AS4 __attribute__((address_space(4)))
typedef const void* cvp_t;
struct Ctx {
    LAS unsigned char* lds; volatile LAS unsigned* MISC;
    unsigned* ctl; unsigned char* ws;
    int tid, lane, wave, G, blk;
    const AS4 cvp_t* in;
};

__device__ __forceinline__ bool launder(Ctx& F) { int t = threadIdx.x; asm volatile("" : "+v"(t)); F.tid = t; F.lane = t & 63; F.wave = __builtin_amdgcn_readfirstlane(t >> 6);
    int z = 0; asm volatile("" : "+s"(z));
    const AS4 char* ka = (const AS4 char*)__builtin_amdgcn_kernarg_segment_ptr() + z;
    F.in = (const AS4 cvp_t*)ka; F.ws = *(unsigned char* const AS4*)(ka + 25 * 8 + 8); F.ctl = (unsigned*)(F.ws + WS_CTL); return true; }

__device__ __forceinline__ void p0_transpose_item(const float* W, int K, int N, bf16* WT, int dstrow0, LAS float* scr, int k0, int n0, int lane) {
#pragma unroll 8
    for (int i = 0; i < 32; ++i) { const int kk = 2 * i + (lane >> 5); scr[kk * 33 + (lane & 31)] = W[(size_t)(k0 + kk) * N + n0 + (lane & 31)]; }
    LDS_WAIT(); asm volatile("" ::: "memory");
    const int c = lane & 7;
#pragma unroll
    for (int j = 0; j < 4; ++j) { const int n = (lane >> 3) + 8 * j; const LAS float* s = scr + (8 * c) * 33 + n;
        v4u o; o.x = pk2(s[0 * 33], s[1 * 33]); o.y = pk2(s[2 * 33], s[3 * 33]); o.z = pk2(s[4 * 33], s[5 * 33]); o.w = pk2(s[6 * 33], s[7 * 33]);
        *(GAS v4u*)(WT + (size_t)(dstrow0 + n) * K + k0 + 8 * c) = o; }
    LDS_WAIT(); asm volatile("" ::: "memory");
}
__device__ __forceinline__ void p0_prologue(const Ctx& F) {
    const float* c_in = (const float*)F.in[1]; const int* pos_in = (const int*)F.in[2];
    const float* mod_w = (const float*)F.in[3]; const float* mod_b = (const float*)F.in[4];
    {
        LAS float* cs_s = (LAS float*)F.lds;
        LAS float* red = (LAS float*)(F.lds + 32768);
        for (int i = F.tid; i < 8192; i += NTHR) { const int b = i >> 10, k = i & 1023; const float v = c_in[i]; cs_s[k * 8 + b] = v / (1.f + expf(-v)); }
        __syncthreads();
        float* MOD = (float*)(F.ws + WS_MOD);
        const int kq = F.tid >> 6, col = F.tid & 63;
        for (int it = F.blk; it < 4 * 96; it += F.G) {
            const int l = it / 96, nb = it % 96;
            float acc[8];
#pragma unroll
            for (int b = 0; b < 8; ++b) acc[b] = 0.f;
            const float* wp = mod_w + ((size_t)l * 1024 + kq * 128) * 6144 + nb * 64 + col;
#pragma unroll 8
            for (int k = 0; k < 128; ++k) { const float w = wp[(size_t)k * 6144];
                const f32x4 c0 = *(const LAS f32x4*)(cs_s + (kq * 128 + k) * 8), c1 = *(const LAS f32x4*)(cs_s + (kq * 128 + k) * 8 + 4);
                acc[0] += c0[0] * w; acc[1] += c0[1] * w; acc[2] += c0[2] * w; acc[3] += c0[3] * w; acc[4] += c1[0] * w; acc[5] += c1[1] * w; acc[6] += c1[2] * w; acc[7] += c1[3] * w; }
#pragma unroll
            for (int b = 0; b < 8; ++b) red[(kq * 8 + b) * 64 + col] = acc[b];
            __syncthreads();
            { const int b = F.tid >> 6; float s = mod_b[l * 6144 + nb * 64 + col];
#pragma unroll
              for (int q = 0; q < 8; ++q) s += red[(q * 8 + b) * 64 + col];
              MOD[((size_t)l * 8 + b) * 6144 + nb * 64 + col] = s; }
            __syncthreads();
        }
    }
    {
        float* ROT = (float*)(F.ws + WS_ROT);
        for (int idx = F.blk * NTHR + F.tid; idx < T * 8; idx += F.G * NTHR) { const int row = idx >> 3, i = idx & 7;
            const float invf = exp2f(-(float)i * (18.931568569324174f / 8.0f));
            const float ang = (float)pos_in[row] * invf; float c, s; sincos_acc(ang, c, s);
            *(f32x2*)(ROT + (size_t)idx * 2) = (f32x2){c, s}; }
    }
    {
        LAS float* scr = (LAS float*)(F.lds + F.wave * 16384);
        const int gw = F.blk * NWAVES + F.wave, NGW = F.G * NWAVES;
        constexpr int I_IN = 2 * 16 * 80, I_OUT = 2 * 16 * 32, I_QKV = 2 * 16 * 96, I_O = 2 * 16 * 32, I_G = 64 * 256, I_U = 64 * 256, I_D = 64 * 256;
        constexpr int NITEMS = I_IN + I_OUT + I_QKV + I_O + I_G + I_U + I_D;
        for (int it = gw; it < NITEMS; it += NGW) {
            int r = it;
            if (r < I_IN) { const int mt = r / 1280, q = r % 1280, kb = q / 80, nb = q % 80;
                p0_transpose_item((const float*)F.in[8] + (size_t)mt * 1024 * 2560, 1024, 2560, (bf16*)(F.ws + WS_WIN) + (size_t)mt * 2560 * 1024, nb * 32, scr, kb * 64, nb * 32, F.lane); continue; } r -= I_IN;
            if (r < I_OUT) { const int mt = r / 512, q = r % 512, kb = q / 32, nb = q % 32;
                p0_transpose_item((const float*)F.in[17] + (size_t)mt * 1024 * 1024, 1024, 1024, (bf16*)(F.ws + WS_WOUT) + (size_t)mt * 1024 * 1024, nb * 32, scr, kb * 64, nb * 32, F.lane); continue; } r -= I_OUT;
            if (r < I_QKV) { const int mt = r / 1536, q = r % 1536, kb = q / 96, nb = q % 96;
                p0_transpose_item((const float*)F.in[18] + (size_t)mt * 1024 * 3072, 1024, 3072, (bf16*)(F.ws + WS_WQKV) + (size_t)mt * 3072 * 1024, nb * 32, scr, kb * 64, nb * 32, F.lane); continue; } r -= I_QKV;
            if (r < I_O) { const int mt = r / 512, q = r % 512, kb = q / 32, nb = q % 32;
                p0_transpose_item((const float*)F.in[19] + (size_t)mt * 1024 * 1024, 1024, 1024, (bf16*)(F.ws + WS_WO) + (size_t)mt * 1024 * 1024, nb * 32, scr, kb * 64, nb * 32, F.lane); continue; } r -= I_O;
            if (r < I_G + I_U) { const int up = (r >= I_G) ? 1 : 0; r -= up * I_G; const int mt = r / 256, q = r % 256, kb = q / 16, nb = q % 16, n0 = nb * 32;
                p0_transpose_item((const float*)F.in[22 + up] + (size_t)mt * 1024 * 512, 1024, 512, (bf16*)(F.ws + WS_WGU) + (size_t)mt * 1024 * 1024, (n0 >> 7) * 256 + (n0 & 127) + up * 128, scr, kb * 64, n0, F.lane); continue; } r -= I_G + I_U;
            { const int mt = r / 256, q = r % 256, kb = q / 32, nb = q % 32;
                p0_transpose_item((const float*)F.in[24] + (size_t)mt * 512 * 1024, 512, 1024, (bf16*)(F.ws + WS_WDN) + (size_t)mt * 1024 * 512, nb * 32, scr, kb * 64, nb * 32, F.lane); }
        }
    }
}

template <int NDELTA, bool ROUTE, bool FINAL>
__device__ __forceinline__ void norm_phase(const Ctx& F, const float* xin, float* xout, const bf16* delta, const float* gate, const float* gvec, const float* shift, const float* scale,
                                           bf16* hout, float* fout, unsigned* gcnt) {
    LAS float* rw_s = (LAS float*)F.lds;
    volatile LAS unsigned* lcnt = F.MISC + 40; volatile LAS unsigned* lbase = F.MISC + 56; volatile LAS unsigned* nent = F.MISC + 72;
    LAS unsigned* ent = (LAS unsigned*)(F.lds + ENT_OFF);
    if (ROUTE) {
        const float* rw = (const float*)F.in[20];
        for (int i = F.tid; i < 16384; i += NTHR) { const int k = i >> 4, e = i & 15; rw_s[e * 1024 + k] = rw[i]; }
        if (F.tid < 16) lcnt[F.tid] = 0u; if (F.tid == 16) nent[0] = 0u;
        __syncthreads();
    }
    const float* rbias = (const float*)F.in[21];
    const int ngrp = T / NWAVES;
    for (int rg = F.blk; rg < ngrp; rg += F.G) {
        const int row = rg * NWAVES + F.wave, b = row >> 11;
        f32x4 v[4]; float ss = 0.f;
#pragma unroll
        for (int j = 0; j < 4; ++j) { const int col = 4 * F.lane + 256 * j;
            v[j] = *(const f32x4*)(xin + (size_t)row * D + col);
            if (NDELTA >= 1) {
                const f32x4 g4 = *(const f32x4*)(gate + (size_t)b * 6144 + col);
                f32x4 dl;
                if (NDELTA == 1) { const v2u w = *(const v2u*)(delta + (size_t)row * D + col); dl = (f32x4){bflo(w.x), bfhi(w.x), bflo(w.y), bfhi(w.y)}; }
                else { const v2u w0 = *(const v2u*)(delta + (size_t)row * 2 * D + col), w1 = *(const v2u*)(delta + (size_t)row * 2 * D + D + col);
                    dl = (f32x4){bflo(w0.x) + bflo(w1.x), bfhi(w0.x) + bfhi(w1.x), bflo(w0.y) + bflo(w1.y), bfhi(w0.y) + bfhi(w1.y)}; }
                v[j] = v[j] + g4 * dl;
            }
            if (!FINAL) *(f32x4*)(xout + (size_t)row * D + col) = v[j];
            ss += (v[j][0] * v[j][0] + v[j][1] * v[j][1]) + (v[j][2] * v[j][2] + v[j][3] * v[j][3]);
        }
        ss = wave_sum(ss);
        const float rstd = 1.0f / sqrtf(ss * (1.0f / D) + 1e-6f);
#pragma unroll
        for (int j = 0; j < 4; ++j) { const int col = 4 * F.lane + 256 * j;
            const f32x4 g4 = *(const f32x4*)(gvec + col);
            f32x4 y = v[j] * rstd * g4;
            if (FINAL) { *(f32x4*)(fout + (size_t)row * D + col) = y; }
            else { const f32x4 sc = *(const f32x4*)(scale + (size_t)b * 6144 + col), sh = *(const f32x4*)(shift + (size_t)b * 6144 + col);
                y = y * (1.0f + sc) + sh; v[j] = y;
                v2u w; w.x = pk2(y[0], y[1]); w.y = pk2(y[2], y[3]); *(v2u*)(hout + (size_t)row * D + col) = w; }
        }
        if (ROUTE) {
            float lg[16];
#pragma unroll
            for (int e = 0; e < 16; ++e) { float a = 0.f;
#pragma unroll
                for (int j = 0; j < 4; ++j) { const f32x4 w = *(const LAS f32x4*)(rw_s + e * 1024 + 256 * j + 4 * F.lane); a += (v[j][0] * w[0] + v[j][1] * w[1]) + (v[j][2] * w[2] + v[j][3] * w[3]); }
                lg[e] = wave_sum(a); }
            float sc[16], bi[16];
#pragma unroll
            for (int e = 0; e < 16; ++e) { sc[e] = sigmoidf_(lg[e]); bi[e] = sc[e] + rbias[e]; }
            float bestgs = -1e30f, s1 = 0.f, s2 = 0.f; int e1 = 0, e2 = 1;
#pragma unroll
            for (int g = 0; g < 4; ++g) {
                float m1 = bi[4 * g], t1 = sc[4 * g]; int i1 = 0;
#pragma unroll
                for (int k = 1; k < 4; ++k) if (bi[4 * g + k] > m1) { m1 = bi[4 * g + k]; t1 = sc[4 * g + k]; i1 = k; }
                float m2 = -1e30f, t2 = 0.f; int i2 = 0;
#pragma unroll
                for (int k = 0; k < 4; ++k) if (k != i1 && bi[4 * g + k] > m2) { m2 = bi[4 * g + k]; t2 = sc[4 * g + k]; i2 = k; }
                const float gs = m1 + m2;
                if (gs > bestgs) { bestgs = gs; e1 = 4 * g + i1; e2 = 4 * g + i2; s1 = t1; s2 = t2; }
            }
            if (F.lane == 0) {
                const float inv = 1.0f / (s1 + s2);
                float* topw = (float*)(F.ws + WS_TOPW);
                topw[row * 2] = s1 * inv; topw[row * 2 + 1] = s2 * inv;
                const unsigned p1 = __hip_atomic_fetch_add((LAS unsigned*)&lcnt[e1], 1u, __ATOMIC_RELAXED, __HIP_MEMORY_SCOPE_WORKGROUP), p2 = __hip_atomic_fetch_add((LAS unsigned*)&lcnt[e2], 1u, __ATOMIC_RELAXED, __HIP_MEMORY_SCOPE_WORKGROUP), n = __hip_atomic_fetch_add((LAS unsigned*)&nent[0], 2u, __ATOMIC_RELAXED, __HIP_MEMORY_SCOPE_WORKGROUP);
                ent[2 * n] = ((unsigned)e1 << 16) | p1; ent[2 * n + 1] = (unsigned)(row * 2);
                ent[2 * n + 2] = ((unsigned)e2 << 16) | p2; ent[2 * n + 3] = (unsigned)(row * 2 + 1);
            }
        }
    }
    if (ROUTE) {
        __syncthreads();
        if (F.tid < 16) lbase[F.tid] = __hip_atomic_fetch_add(gcnt + F.tid, lcnt[F.tid], RLX_AGENT);
        __syncthreads();
        int* list = (int*)(F.ws + WS_LIST); const unsigned n = nent[0];
        for (unsigned i = F.tid; i < n; i += NTHR) { const unsigned key = ent[2 * i], val = ent[2 * i + 1], e = key >> 16, p = key & 0xffffu; list[(size_t)e * T + lbase[e] + p] = (int)val; }
        __syncthreads();
    }
}

__device__ __forceinline__ void compute_tpre(const Ctx& F, unsigned* gcnt) {
    if (F.tid < 16) F.MISC[40 + F.tid] = __hip_atomic_load(gcnt + F.tid, RLX_AGENT);
    __syncthreads();
    if (F.tid == 0) { unsigned acc = 0;
        for (int e = 0; e < 16; ++e) { F.MISC[16 + e] = acc; acc += (F.MISC[40 + e] + 255u) >> 8; }
        F.MISC[32] = acc; }
    __syncthreads();
}
__device__ __forceinline__ void dispatch_phase(const Ctx& F, unsigned* gcnt) {
    compute_tpre(F, gcnt);
    const int gw = F.blk * NWAVES + F.wave, NGW = F.G * NWAVES;
    const int nrows = (int)F.MISC[32] * 256;
    const bf16* H = (const bf16*)(F.ws + WS_HB); bf16* XS = (bf16*)(F.ws + WS_R1 + R1_XS);
    const int* list = (const int*)(F.ws + WS_LIST); const float* topw = (const float*)(F.ws + WS_TOPW);
    int* sloti = (int*)(F.ws + WS_SLOTI); float* slotw = (float*)(F.ws + WS_SLOTW);
    for (int r = gw; r < nrows; r += NGW) {
        const int pt = r >> 8; int e = 0;
#pragma unroll
        for (int j = 1; j < 16; ++j) e += (pt >= (int)F.MISC[16 + j]) ? 1 : 0;
        const int pos = r - (int)F.MISC[16 + e] * 256, cnt = (int)F.MISC[40 + e];
        v4u a = (v4u){0u, 0u, 0u, 0u}, bq = a; int info = -1; float w = 0.f;
        if (pos < cnt) { info = list[(size_t)e * T + pos]; w = topw[info];
            const v4u* src = (const v4u*)(H + (size_t)(info >> 1) * D); a = src[F.lane]; bq = src[64 + F.lane]; }
        v4u* dst = (v4u*)(XS + (size_t)r * D); dst[F.lane] = a; dst[64 + F.lane] = bq;
        if (F.lane == 0) { sloti[r] = info; slotw[r] = w; }
    }
}

template <bool OUT>
__device__ __forceinline__ void mix_phase(const Ctx& F, int jl) {
    LAS float* xr_s = (LAS float*)F.lds;
    LAS float* A_s = (LAS float*)(F.lds + 16384);
    LAS float* B_s = (LAS float*)(F.lds + 49152);
    const bf16* Z = (const bf16*)(F.ws + WS_R1 + R1_Z); bf16* Y = (bf16*)(F.ws + WS_HB);
    f32x2* AGG = (f32x2*)(F.ws + WS_AGG);
    const float* conv_a_w = (const float*)F.in[9] + (size_t)jl * 3 * 512; const float* conv_b_w = (const float*)F.in[10] + (size_t)jl * 4 * 512; const float* conv_b_b = (const float*)F.in[11] + (size_t)jl * 512;
    const float* lru_wa = (const float*)F.in[12] + (size_t)jl * 2 * 8 * 4096; const float* lru_ba = (const float*)F.in[13] + (size_t)jl * 2 * 512;
    const float* lru_wx = (const float*)F.in[14] + (size_t)jl * 2 * 8 * 4096; const float* lru_bx = (const float*)F.in[15] + (size_t)jl * 2 * 512;
    const float* lru_lam = (const float*)F.in[16] + (size_t)jl * 2 * 512;
    const int j = F.tid & 63, tg = F.tid >> 6;
    for (int unit = F.blk; unit < 8 * 32 * 8; unit += F.G) {
        const int b = unit >> 8, c = (unit >> 3) & 31, h = unit & 7, t0 = c * 64, ch = h * 64 + j; const size_t rb = (size_t)b * SEQ;
        { float wB[4];
#pragma unroll
          for (int k = 0; k < 4; ++k) wB[k] = conv_b_w[k * 512 + ch];
          const float bB = conv_b_b[ch];
#pragma unroll
          for (int i = 0; i < 8; ++i) { const int tt = tg * 8 + i, t = t0 + tt; float a = bB;
#pragma unroll
              for (int k = 0; k < 4; ++k) { const int ts = t + k - 1; if (ts >= 0 && ts < SEQ) a += wB[k] * bf2f(Z[(rb + ts) * IN_AB + 2048 + ch]); }
              xr_s[tt * 64 + j] = a; } }
        __syncthreads();
        float ar[2][8], ax[2][8];
#pragma unroll
        for (int d = 0; d < 2; ++d)
#pragma unroll
            for (int i = 0; i < 8; ++i) { ar[d][i] = 0.f; ax[d][i] = 0.f; }
        { const float* wa0 = lru_wa + (size_t)(0 * 8 + h) * 4096 + j; const float* wa1 = lru_wa + (size_t)(1 * 8 + h) * 4096 + j;
          const float* wx0 = lru_wx + (size_t)(0 * 8 + h) * 4096 + j; const float* wx1 = lru_wx + (size_t)(1 * 8 + h) * 4096 + j;
#pragma unroll 4
          for (int i = 0; i < 64; ++i) { const float a0 = wa0[i * 64], a1 = wa1[i * 64], x0 = wx0[i * 64], x1 = wx1[i * 64];
#pragma unroll
              for (int q = 0; q < 8; ++q) { const float xv = xr_s[(tg * 8 + q) * 64 + i]; ar[0][q] += xv * a0; ar[1][q] += xv * a1; ax[0][q] += xv * x0; ax[1][q] += xv * x1; } } }
#pragma unroll
        for (int d = 0; d < 2; ++d) { const float ba = lru_ba[d * 512 + ch], bx = lru_bx[d * 512 + ch], sp = log1pf(expf(-lru_lam[d * 512 + ch]));
#pragma unroll
            for (int q = 0; q < 8; ++q) { const int tt = tg * 8 + q; const float r = sigmoidf_(ar[d][q] + ba), ig = sigmoidf_(ax[d][q] + bx), la = -8.0f * r * sp, a = expf(la), mult = sqrtf(-expm1f(2.0f * la));
                A_s[(d * 64 + tt) * 64 + j] = a; B_s[(d * 64 + tt) * 64 + j] = xr_s[tt * 64 + j] * ig * mult; } }
        __syncthreads();
        if (F.tid < 128) { const int d = F.tid >> 6; float hs = 0.f, P = 1.f;
            if (OUT) {
                if (d == 0) { for (int cc = 0; cc < c; ++cc) { const f32x2 pg = AGG[((size_t)(b * 2 + 0) * 32 + cc) * 512 + ch]; hs = pg.x * hs + pg.y; } }
                else { for (int cc = 31; cc > c; --cc) { const f32x2 pg = AGG[((size_t)(b * 2 + 1) * 32 + cc) * 512 + ch]; hs = pg.x * hs + pg.y; } }
            }
            for (int s = 0; s < 64; ++s) { const int tt = d ? 63 - s : s; const float a = A_s[(d * 64 + tt) * 64 + j], bb = B_s[(d * 64 + tt) * 64 + j]; hs = a * hs + bb;
                if (OUT) B_s[(d * 64 + tt) * 64 + j] = hs; else P *= a; }
            if (!OUT) AGG[((size_t)(b * 2 + d) * 32 + c) * 512 + ch] = (f32x2){P, hs};
        }
        if (OUT) {
            __syncthreads();
            float wA[3];
#pragma unroll
            for (int k = 0; k < 3; ++k) wA[k] = conv_a_w[k * 512 + ch];
#pragma unroll
            for (int i = 0; i < 8; ++i) { const int tt = tg * 8 + i, t = t0 + tt; const size_t row = rb + t;
                const float hrec = B_s[(0 * 64 + tt) * 64 + j] + B_s[(1 * 64 + tt) * 64 + j];
                const float yb = gelu_tanh(bf2f(Z[row * IN_AB + 1536 + ch])) * hrec;
                float sa = 0.f;
#pragma unroll
                for (int k = 0; k < 3; ++k) { const int ts = t + k - 1; if (ts >= 0 && ts < SEQ) sa += wA[k] * (bf2f(Z[(rb + ts) * IN_AB + 1024 + ch]) * bf2f(Z[(rb + ts) * IN_AB + ch])); }
                const float ya = bf2f(Z[row * IN_AB + 512 + ch]) * sa;
                Y[row * D + ch] = (bf16)f2bf(ya); Y[row * D + 512 + ch] = (bf16)f2bf(yb); }
        }
        __syncthreads();
    }
}

__device__ __forceinline__ void attn_naive_phase(const Ctx& F) {
    const bf16* QKV = (const bf16*)(F.ws + WS_R1 + R1_Z); bf16* Y = (bf16*)(F.ws + WS_HB);
    LAS float* qs = (LAS float*)(F.lds + F.wave * 4096);
    LAS float* ps = qs + 64;
    const int gw = F.blk * NWAVES + F.wave, NGW = F.G * NWAVES;
    for (int unit = gw; unit < T * 16; unit += NGW) {
        const int row = unit >> 4, hd = unit & 15, b = row >> 11, t = row & 2047; const size_t rb = (size_t)b * SEQ;
        qs[F.lane] = bf2f(QKV[(size_t)row * NQKV + hd * 64 + F.lane]) * 0.125f;
        LDS_WAIT(); asm volatile("" ::: "memory");
        float sc[7]; float mx = -1e30f;
#pragma unroll
        for (int i = 0; i < 7; ++i) { const int n = F.lane + 64 * i, p = n / 129, jj = n - p * 129 - 64, dd = (p == 0) ? 1 : (p == 1) ? 4 : 16, tk = t + dd * jj;
            const bool valid = (n < 387) && tk >= 0 && tk < SEQ; float dot = -1e30f;
            if (valid) { const v4u* kp = (const v4u*)(QKV + (rb + tk) * NQKV + 1024 + hd * 64); dot = 0.f;
#pragma unroll
                for (int q = 0; q < 8; ++q) { const v4u w = kp[q]; const LAS float* qq = qs + q * 8;
                    dot += qq[0] * bflo(w.x) + qq[1] * bfhi(w.x) + qq[2] * bflo(w.y) + qq[3] * bfhi(w.y) + qq[4] * bflo(w.z) + qq[5] * bfhi(w.z) + qq[6] * bflo(w.w) + qq[7] * bfhi(w.w); } }
            sc[i] = dot; mx = fmaxf(mx, dot); }
        mx = wave_max(mx); float sum = 0.f;
#pragma unroll
        for (int i = 0; i < 7; ++i) { const float pr = (sc[i] > -1e29f) ? expf(sc[i] - mx) : 0.f; ps[F.lane + 64 * i] = pr; sum += pr; }
        sum = wave_sum(sum);
        LDS_WAIT(); asm volatile("" ::: "memory");
        float o = 0.f;
#pragma unroll
        for (int p = 0; p < 3; ++p) { const int dd = (p == 0) ? 1 : (p == 1) ? 4 : 16;
#pragma unroll 4
            for (int jj = -64; jj <= 64; ++jj) { const int tk = t + dd * jj; if (tk < 0 || tk >= SEQ) continue;
                o += ps[p * 129 + jj + 64] * bf2f(QKV[(rb + tk) * NQKV + 2048 + hd * 64 + F.lane]); } }
        Y[(size_t)row * D + hd * 64 + F.lane] = (bf16)f2bf(o / sum);
        LDS_WAIT(); asm volatile("" ::: "memory");
    }
}
#ifndef EN_P0
#define EN_P0 1
#endif
#ifndef EN_N1
#define EN_N1 1
#endif
#ifndef EN_G1E
#define EN_G1E 1
#endif
#ifndef EN_G1O
#define EN_G1O 1
#endif
#ifndef EN_MIXA
#define EN_MIXA 1
#endif
#ifndef EN_MIXB
#define EN_MIXB 1
#endif
#ifndef EN_ATT
#define EN_ATT 1
#endif
#ifndef EN_G2
#define EN_G2 1
#endif
#ifndef EN_N2
#define EN_N2 1
#endif
#ifndef EN_DISP
#define EN_DISP 1
#endif
#ifndef EN_GU
#define EN_GU 1
#endif
#ifndef EN_DN
#define EN_DN 1
#endif
#ifndef EN_FIN
#define EN_FIN 1
#endif

struct Args { const void* in[25]; float* out; unsigned char* ws; int ph_lo, ph_hi; };
constexpr int NPHASE = 2 + 9 * DEPTH;

__global__ void __launch_bounds__(NTHR, 2) fwd(Args args) {
    extern __shared__ __attribute__((aligned(16))) unsigned char lds[];
    Ctx F;
    F.lds = (LAS unsigned char*)lds; F.MISC = (volatile LAS unsigned*)(F.lds + MISC_OFF);
    F.tid = threadIdx.x; F.lane = F.tid & 63; F.wave = __builtin_amdgcn_readfirstlane(F.tid >> 6);
    F.G = gridDim.x; F.blk = blockIdx.x; launder(F);
    for (int u = F.tid; u < 256; u += NTHR) ((LAS unsigned*)(F.lds + MISC_OFF))[u] = 0u;
    __syncthreads();
#if MK_ONE_LAUNCH
    XcdBarrier bar = xcd_barrier_post(F.ctl + CW_BAR, F.MISC + 8);
#define GRID_BAR() xcd_barrier(bar)
#else
#define GRID_BAR() do { } while (0)
#endif
    const int lo = args.ph_lo, hi = args.ph_hi;
#define IN(k) (lo <= (k) && (k) < hi && launder(F))
#define SEAM(k) do { if (IN(k) && IN((k) + 1)) GRID_BAR(); } while (0)
#define WSP (F.ws)
#define MOD ((const float*)(F.ws + WS_MOD))
#define X ((float*)(F.ws + WS_X))
#define HB ((bf16*)(F.ws + WS_HB))
#define R1Z ((bf16*)(F.ws + WS_R1 + R1_Z))
#define DELTA ((bf16*)(F.ws + WS_R1 + R1_DELTA))
#define XS ((bf16*)(F.ws + WS_R1 + R1_XS))
#define ACT ((bf16*)(F.ws + WS_R1 + R1_ACT))
#define YW ((bf16*)(F.ws + WS_R1 + R1_YW))

    if (EN_P0 && IN(0)) { p0_prologue(F); } SEAM(0);

    for (int l = 0; l < DEPTH; ++l) {
        const int base = 1 + 9 * l, jl = l >> 1; const bool even = (l & 1) == 0;
#define modl (MOD + (size_t)l * 8 * 6144)
#define gcnt (F.ctl + CW_CNT + 64 * l)
        if (EN_N1 && IN(base + 0)) {
            const float* gv = (const float*)F.in[5] + (size_t)l * D;
            if (l == 0) norm_phase<0, false, false>(F, (const float*)F.in[0], X, nullptr, nullptr, gv, modl + 0, modl + 1024, HB, nullptr, nullptr);
            else norm_phase<2, false, false>(F, X, X, YW, MOD + (size_t)(l - 1) * 8 * 6144 + 5120, gv, modl + 0, modl + 1024, HB, nullptr, nullptr);
        }
        SEAM(base + 0);
        if (IN(base + 1)) {
            if (!EN_G1E && even) {} else if (even) { pg8::StaticOrder S; S.init(HB, (const bf16*)(WSP + WS_WIN) + (size_t)jl * IN_AB * D, T, IN_AB, D, F.G, F.blk);
                pg8::EpiStore E{R1Z, IN_AB};
                pg8::gemm_phase<pg8::EpiStore, pg8::StaticOrder, true, true>(F.lds, D, S, E, F.tid); }
            else if (EN_G1O) { pg8::StaticOrder S; S.init(HB, (const bf16*)(WSP + WS_WQKV) + (size_t)jl * NQKV * D, T, NQKV, D, F.G, F.blk);
                pg8::EpiQKV E{R1Z, (const float*)(WSP + WS_ROT)};
                pg8::gemm_phase<pg8::EpiQKV, pg8::StaticOrder, true, true>(F.lds, D, S, E, F.tid); }
        }
        SEAM(base + 1);
        if (IN(base + 2)) { if (even) { if (EN_MIXA) mix_phase<false>(F, jl); } else { if (EN_ATT) attn_naive_phase(F); } }
        SEAM(base + 2);
        if (EN_MIXB && IN(base + 3)) { if (even) mix_phase<true>(F, jl); }
        if (even) SEAM(base + 3);
        if (EN_G2 && IN(base + 4)) {
            pg8::StaticOrder S; S.init(HB, even ? (const bf16*)(WSP + WS_WOUT) + (size_t)jl * D * D : (const bf16*)(WSP + WS_WO) + (size_t)jl * D * D, T, D, D, F.G, F.blk);
            pg8::EpiStore E{DELTA, D};
            pg8::gemm_phase<pg8::EpiStore, pg8::StaticOrder, true, true>(F.lds, D, S, E, F.tid);
        }
        SEAM(base + 4);
        if (EN_N2 && IN(base + 5)) norm_phase<1, true, false>(F, X, X, DELTA, modl + 2048, (const float*)F.in[6] + (size_t)l * D, modl + 3072, modl + 4096, HB, nullptr, gcnt);
        SEAM(base + 5);
        if (EN_DISP && IN(base + 6)) dispatch_phase(F, gcnt);
        SEAM(base + 6);
        if (EN_GU && IN(base + 7)) {
            compute_tpre(F, gcnt);
            pg8::MoeOrder S; S.A = (const char*)XS; S.Bt = (const char*)((const bf16*)(WSP + WS_WGU) + (size_t)l * NE * 1024 * 1024); S.tstep = (size_t)256 * 1024 * 2; S.estride = (size_t)1024 * 1024 * 2; S.G = F.G; S.c = F.blk;
            S.tp = F.MISC + 16;
            pg8::EpiGU E{ACT};
            pg8::gemm_phase<pg8::EpiGU, pg8::MoeOrder, true, true>(F.lds, 1024, S, E, F.tid);
        }
        SEAM(base + 7);
        if (EN_DN && IN(base + 8)) {
            compute_tpre(F, gcnt);
            pg8::MoeOrder S; S.A = (const char*)ACT; S.Bt = (const char*)((const bf16*)(WSP + WS_WDN) + (size_t)l * NE * 1024 * 512); S.tstep = (size_t)256 * 512 * 2; S.estride = (size_t)1024 * 512 * 2; S.G = F.G; S.c = F.blk;
            S.tp = F.MISC + 16;
            pg8::EpiDN E{YW, (const int*)(WSP + WS_SLOTI), (const float*)(WSP + WS_SLOTW)};
            pg8::gemm_phase<pg8::EpiDN, pg8::MoeOrder, true, true>(F.lds, 512, S, E, F.tid);
        }
        SEAM(base + 8);
    }
    if (EN_FIN && IN(NPHASE - 1)) norm_phase<2, false, true>(F, X, nullptr, YW, MOD + (size_t)3 * 8 * 6144 + 5120, (const float*)F.in[7], nullptr, nullptr, nullptr, args.out, nullptr);
#undef IN
#undef SEAM
#undef WSP
#undef MOD
#undef X
#undef HB
#undef R1Z
#undef DELTA
#undef XS
#undef ACT
#undef YW
#undef modl
#undef gcnt
}

extern "C" void kernel_launch(void* const* d_in, const int* in_sizes, int n_in, void* d_out, int out_size, void* d_ws, size_t ws_size, hipStream_t stream) {
    static int grid = 0;
    if (grid == 0) {
        if (n_in != 25 || in_sizes[0] != T * D || out_size != T * D || ws_size < WS_END) { fprintf(stderr, "kernel_launch: unexpected shapes / workspace (n_in %d, ws %zu); nothing launched\n", n_in, ws_size); grid = -1; return; }
        int dev = 0, cus = 0, per_cu = 0;
        if (hipGetDevice(&dev) != hipSuccess || hipDeviceGetAttribute(&cus, hipDeviceAttributeMultiprocessorCount, dev) != hipSuccess) { grid = -1; return; }
        if (hipFuncSetAttribute((const void*)fwd, hipFuncAttributeMaxDynamicSharedMemorySize, LDS_BYTES) != hipSuccess) { fprintf(stderr, "kernel_launch: hipFuncSetAttribute failed\n"); grid = -1; return; }
        if (hipOccupancyMaxActiveBlocksPerMultiprocessor(&per_cu, (const void*)fwd, NTHR, LDS_BYTES) != hipSuccess || per_cu < 1) { fprintf(stderr, "kernel_launch: occupancy query reports %d\n", per_cu); }
        (void)hipGetLastError();
        grid = cus;
    }
    if (grid < 0) return;
    if (hipMemsetAsync((char*)d_ws + WS_CTL, 0, CTL_ZERO_BYTES, stream) != hipSuccess) return;
    Args a{};
    for (int i = 0; i < 25; ++i) a.in[i] = d_in[i];
    a.out = (float*)d_out; a.ws = (unsigned char*)d_ws;
#if MK_ONE_LAUNCH
    a.ph_lo = 0; a.ph_hi = NPHASE;
    hipLaunchKernelGGL(fwd, dim3(grid), dim3(NTHR), LDS_BYTES, stream, a);
#else
    for (int p = 0; p < NPHASE; ++p) {
        if (p >= 1 && p < NPHASE - 1) { const int l = (p - 1) / 9, s = (p - 1) % 9; if ((l & 1) == 1 && s == 3) continue; }
        a.ph_lo = p; a.ph_hi = p + 1;
        hipLaunchKernelGGL(fwd, dim3(grid), dim3(NTHR), LDS_BYTES, stream, a);
    }
#endif
}
```

```cpp
#include <hip/hip_runtime.h>
#include <cstdio>
#include <cstdint>

#ifndef MK_ONE_LAUNCH
#define MK_ONE_LAUNCH 1
#endif

namespace pg8 {
#define PG8_LAS __attribute__((address_space(3)))
typedef unsigned short bf16_t;
typedef short bf16x8 __attribute__((ext_vector_type(8)));
typedef float f32x4 __attribute__((ext_vector_type(4)));
typedef unsigned u32x4 __attribute__((ext_vector_type(4)));
constexpr int BM = 256, BK = 64, HALF = 128, HTB = HALF * BK * 2  , STAGE_BYTES = 8 * HTB, NXCD = 8, WGM = 8;

__host__ __device__ __forceinline__ int lds_byte(int r, int c) { const int st = (r >> 4) * 2 + (c >> 5), rr = r & 15, cc = c & 31, ob = rr * 64 + cc * 2; return st * 1024 + (ob ^ (((ob >> 9) & 1) << 5)); }
__host__ __device__ __forceinline__ void stage_rc(int b, int& R, int& C) { const int st = b / 1024, sb = b % 1024, swz = sb ^ (((sb >> 9) & 1) << 5); R = (st >> 1) * 16 + swz / 64; C = (st & 1) * 32 + (swz % 64) / 2; }
__host__ __device__ __forceinline__ int perm32(int rho) { const int n = rho >> 4, i = rho & 15; return 8 * (i >> 2) + 4 * n + (i & 3); }

struct Unit { int pm, pn, e; };

struct StaticOrder {
    const char* A; const char* Bt; size_t tstep;
    int nM, nN, nwg, G, c;
    __device__ void init(const void* A_, const void* Bt_, int M, int N, int K, int G_, int c_) { A = (const char*)A_; Bt = (const char*)Bt_; tstep = (size_t)256 * K * 2; nM = M / BM; nN = N / BM; nwg = nM * nN; G = G_; c = c_; }
    __device__ bool next(int i, Unit& u) const {
        const long L = (long)i * G + c; if (L >= nwg) return false;
        int wgid = (int)L; { const int q = nwg / NXCD, r = nwg % NXCD, xcd = wgid % NXCD, off = wgid / NXCD; wgid = (xcd < r ? xcd * (q + 1) : r * (q + 1) + (xcd - r) * q) + off; }
        const int nig = WGM * nN, gid = wgid / nig, fm = gid * WGM, gsz = (nM - fm) < WGM ? (nM - fm) : WGM;
        u.pm = fm + ((wgid % nig) % gsz); u.pn = (wgid % nig) / gsz; u.e = 0; return true;
    }
    __device__ __forceinline__ const char* a_base(const Unit& u) const { return A + (size_t)u.pm * tstep; }
    __device__ __forceinline__ const char* b_base(const Unit& u) const { return Bt + (size_t)u.pn * tstep; }
    __device__ __forceinline__ void a_ready(const Unit&) const {}
    __device__ __forceinline__ void done(const Unit&) const {}
};
struct MoeOrder {
    const char* A; const char* Bt; size_t tstep, estride;
    const volatile PG8_LAS unsigned* tp; int G, c;
    __device__ bool next(int i, Unit& u) const {
        const int L = i * G + c; if (L >= (int)tp[16] * 4) return false;
        const int pt = L >> 2; int e = 0;
#pragma unroll
        for (int j = 1; j < 16; ++j) e += (pt >= (int)tp[j]) ? 1 : 0;
        e = __builtin_amdgcn_readfirstlane(e);
        u.pm = pt; u.pn = L & 3; u.e = e; return true;
    }
    __device__ __forceinline__ const char* a_base(const Unit& u) const { return A + (size_t)u.pm * tstep; }
    __device__ __forceinline__ const char* b_base(const Unit& u) const { return Bt + (size_t)u.e * estride + (size_t)u.pn * tstep; }
    __device__ __forceinline__ void a_ready(const Unit&) const {}
    __device__ __forceinline__ void done(const Unit&) const {}
};

__device__ __forceinline__ unsigned cvt_pk_bf16(float lo, float hi) { unsigned r; asm volatile("v_cvt_pk_bf16_f32 %0, %1, %2" : "=v"(r) : "v"(lo), "v"(hi)); return r; }
__device__ __forceinline__ u32x4 pack8(const f32x4 v0, const f32x4 v1) { u32x4 w; w.x = cvt_pk_bf16(v0[0], v0[1]); w.y = cvt_pk_bf16(v0[2], v0[3]); w.z = cvt_pk_bf16(v1[0], v1[1]); w.w = cvt_pk_bf16(v1[2], v1[3]); return w; }

struct EpiStore {
    static constexpr bool PERM = true, AFTER_DRAIN = false;
    bf16_t* O; int ldc;
    __device__ __forceinline__ void operator()(const f32x4 (&acc)[2][2][4][2], const Unit& u, int wr, int wc, int fr, int fq) const {
        const int row0 = u.pm * BM + wr * 64 + fr, col0 = u.pn * BM + wc * 32 + 8 * fq;
#pragma unroll
        for (int ai = 0; ai < 2; ++ai)
#pragma unroll
            for (int m = 0; m < 4; ++m) { bf16_t* rowp = O + (size_t)(row0 + ai * HALF + m * 16) * ldc + col0;
#pragma unroll
                for (int bj = 0; bj < 2; ++bj) *(u32x4*)(rowp + bj * HALF) = pack8(acc[ai][bj][m][0], acc[ai][bj][m][1]); }
    }
};
struct EpiQKV {
    static constexpr bool PERM = true, AFTER_DRAIN = false;
    bf16_t* O; const float* rot;
    __device__ __forceinline__ void operator()(const f32x4 (&acc)[2][2][4][2], const Unit& u, int wr, int wc, int fr, int fq) const {
        const int row0 = u.pm * BM + wr * 64 + fr, col0 = u.pn * BM + wc * 32 + 8 * fq;
        const bool rotw = (u.pn < 8) && ((wc & 1) == 0);
#pragma unroll
        for (int ai = 0; ai < 2; ++ai)
#pragma unroll
            for (int m = 0; m < 4; ++m) { const int row = row0 + ai * HALF + m * 16; bf16_t* rowp = O + (size_t)row * 3072 + col0;
                f32x4 cs[4];
                if (rotw) {
#pragma unroll
                    for (int q = 0; q < 4; ++q) cs[q] = *(const f32x4*)(rot + (size_t)row * 16 + q * 4); }
#pragma unroll
                for (int bj = 0; bj < 2; ++bj) { f32x4 v0 = acc[ai][bj][m][0], v1 = acc[ai][bj][m][1];
                    if (rotw) {
                        f32x4 p0, p1;
#pragma unroll
                        for (int j = 0; j < 4; ++j) { p0[j] = __shfl_xor(v0[j], 16); p1[j] = __shfl_xor(v1[j], 16); }
                        if (fq < 2) { const float sg = (fq == 0) ? -1.f : 1.f;
                            v0[0] = v0[0] * cs[0][0] + sg * p0[0] * cs[0][1]; v0[1] = v0[1] * cs[0][2] + sg * p0[1] * cs[0][3];
                            v0[2] = v0[2] * cs[1][0] + sg * p0[2] * cs[1][1]; v0[3] = v0[3] * cs[1][2] + sg * p0[3] * cs[1][3];
                            v1[0] = v1[0] * cs[2][0] + sg * p1[0] * cs[2][1]; v1[1] = v1[1] * cs[2][2] + sg * p1[1] * cs[2][3];
                            v1[2] = v1[2] * cs[3][0] + sg * p1[2] * cs[3][1]; v1[3] = v1[3] * cs[3][2] + sg * p1[3] * cs[3][3]; }
                    }
                    *(u32x4*)(rowp + bj * HALF) = pack8(v0, v1); } }
    }
};
struct EpiGU {
    static constexpr bool PERM = true, AFTER_DRAIN = false;
    bf16_t* O;
    __device__ __forceinline__ void operator()(const f32x4 (&acc)[2][2][4][2], const Unit& u, int wr, int wc, int fr, int fq) const {
        const int row0 = u.pm * BM + wr * 64 + fr, col0 = u.pn * 128 + wc * 32 + 8 * fq;
#pragma unroll
        for (int ai = 0; ai < 2; ++ai)
#pragma unroll
            for (int m = 0; m < 4; ++m) { bf16_t* rowp = O + (size_t)(row0 + ai * HALF + m * 16) * 512 + col0;
                f32x4 o[2];
#pragma unroll
                for (int n = 0; n < 2; ++n)
#pragma unroll
                    for (int j = 0; j < 4; ++j) { const float g = acc[ai][0][m][n][j], up = acc[ai][1][m][n][j]; o[n][j] = g / (1.f + __expf(-g)) * up; }
                *(u32x4*)rowp = pack8(o[0], o[1]); }
    }
};
struct EpiDN {
    static constexpr bool PERM = true, AFTER_DRAIN = false;
    bf16_t* O; const int* sloti; const float* slotw;
    __device__ __forceinline__ void operator()(const f32x4 (&acc)[2][2][4][2], const Unit& u, int wr, int wc, int fr, int fq) const {
        const int row0 = u.pm * BM + wr * 64 + fr, col0 = u.pn * BM + wc * 32 + 8 * fq;
#pragma unroll
        for (int ai = 0; ai < 2; ++ai)
#pragma unroll
            for (int m = 0; m < 4; ++m) { const int row = row0 + ai * HALF + m * 16; const int info = sloti[row]; const float w = slotw[row];
                if (info >= 0) { bf16_t* rowp = O + (size_t)info * 1024 + col0;
#pragma unroll
                    for (int bj = 0; bj < 2; ++bj) *(u32x4*)(rowp + bj * HALF) = pack8(acc[ai][bj][m][0] * w, acc[ai][bj][m][1] * w); } }
    }
};

template <class Epi, class Sched, bool ALIGN_EPI = false, bool SP2 = false>
__device__ __forceinline__ void gemm_phase(PG8_LAS unsigned char* lds, const int K, const Sched& S, const Epi& E, const int tid) {
    const int wid = __builtin_amdgcn_readfirstlane(tid >> 6), lane = tid & 63, wr = wid >> 2, wc = wid & 3, fr = lane & 15, fq = lane >> 4;
    const int nt = K / BK;
    unsigned voffA[2], voffB[2];
#pragma unroll
    for (int i = 0; i < 2; ++i) { int R, C; stage_rc(tid * 16 + i * 8192, R, C); const int Rb = Epi::PERM ? ((R & ~31) + perm32(R & 31)) : R;
        voffA[i] = (unsigned)(R * K + C) * 2u; voffB[i] = (unsigned)(Rb * K + C) * 2u; }
    const size_t kstep = (size_t)(BK * 2);
    const size_t hstep = (size_t)HALF * K * 2;
    const unsigned ldsw = (unsigned)wid * 1024u;
    const int aoff = lds_byte(wr * 64 + fr, fq * 8), boff = lds_byte(wc * 32 + fr, fq * 8);
#define PG8_SA(b, h) (((b) * 2 + (h)) * HTB)
#define PG8_SB(b, h) ((4 + (b) * 2 + (h)) * HTB)
#define PG8_STAGE(bufoff, gbase, voff) do { _Pragma("unroll") for (int _i = 0; _i < 2; ++_i) \
        __builtin_amdgcn_global_load_lds((const unsigned*)((const char*)(gbase) + (voff)[_i]), (PG8_LAS unsigned*)(lds + (bufoff) + ldsw + _i * 8192), 16, 0, 0); } while (0)
#define PG8_LDA(dst, b, h) do { _Pragma("unroll") for (int m = 0; m < 4; ++m) _Pragma("unroll") for (int k = 0; k < 2; ++k) dst[m][k] = *(const PG8_LAS bf16x8*)(lds + PG8_SA(b, h) + aoff + m * 2048 + k * 1024); } while (0)
#define PG8_LDB(dst, b, h) do { _Pragma("unroll") for (int n = 0; n < 2; ++n) _Pragma("unroll") for (int k = 0; k < 2; ++k) dst[n][k] = *(const PG8_LAS bf16x8*)(lds + PG8_SB(b, h) + boff + n * 2048 + k * 1024); } while (0)
#define PG8_MMA(ai, bj, At, Bt) do { __builtin_amdgcn_s_setprio(1); _Pragma("unroll") for (int m = 0; m < 4; ++m) _Pragma("unroll") for (int n = 0; n < 2; ++n) _Pragma("unroll") for (int k = 0; k < 2; ++k) \
        acc[ai][bj][m][n] = __builtin_amdgcn_mfma_f32_16x16x32_bf16(Bt[n][k], At[m][k], acc[ai][bj][m][n], 0, 0, 0); __builtin_amdgcn_s_setprio(0); } while (0)
#define PG8_WAIT_V(n) asm volatile("s_waitcnt vmcnt(" #n ")" ::: "memory")
#define PG8_WAIT_L(n) asm volatile("s_waitcnt lgkmcnt(" #n ")" ::: "memory")
#define PG8_BAR __builtin_amdgcn_s_barrier()
#define PG8_SCHED __builtin_amdgcn_sched_barrier(0)
    Unit cur, nxt; int ui = 0;
    if (!S.next(0, cur)) return;
    f32x4 acc[2][2][4][2];
#pragma unroll
    for (int a = 0; a < 2; ++a)
#pragma unroll
        for (int b = 0; b < 2; ++b)
#pragma unroll
            for (int m = 0; m < 4; ++m)
#pragma unroll
                for (int n = 0; n < 2; ++n) acc[a][b][m][n] = (f32x4){0.f, 0.f, 0.f, 0.f};
    bf16x8 At[4][2], B0[2][2], B1[2][2];
    const char* cA = S.a_base(cur); const char* cB = S.b_base(cur);
    S.a_ready(cur);
    if constexpr (SP2) {
        PG8_STAGE(PG8_SB(0, 0), cB, voffB); PG8_STAGE(PG8_SB(0, 1), cB + hstep, voffB); PG8_STAGE(PG8_SA(0, 0), cA, voffA); PG8_STAGE(PG8_SA(0, 1), cA + hstep, voffA);
        if (wr == 1) PG8_BAR;
        PG8_WAIT_V(2); PG8_BAR;
        PG8_STAGE(PG8_SB(1, 0), cB + kstep, voffB); PG8_STAGE(PG8_SA(1, 0), cA + kstep, voffA); PG8_STAGE(PG8_SB(1, 1), cB + hstep + kstep, voffB);
        PG8_WAIT_V(6); PG8_BAR;
    } else {
        PG8_STAGE(PG8_SB(0, 0), cB, voffB); PG8_STAGE(PG8_SA(0, 0), cA, voffA); PG8_STAGE(PG8_SB(0, 1), cB + hstep, voffB); PG8_STAGE(PG8_SA(0, 1), cA + hstep, voffA);
        if (wr == 1) PG8_BAR;
        PG8_WAIT_V(4); PG8_BAR;
        PG8_STAGE(PG8_SB(1, 0), cB + kstep, voffB); PG8_STAGE(PG8_SA(1, 0), cA + kstep, voffA); PG8_STAGE(PG8_SB(1, 1), cB + hstep + kstep, voffB);
        PG8_WAIT_V(6); PG8_BAR;
    }
    for (;;) {
        const bool has_next = S.next(ui + 1, nxt);
        const char* nA = has_next ? S.a_base(nxt) : cA; const char* nB = has_next ? S.b_base(nxt) : cB;
        for (int t = 0; t < nt; t += 2) {
            const bool last = (t == nt - 2);
            const char* a1 = cA + (size_t)(t + 1) * kstep;
            const char* a2 = last ? nA : cA + (size_t)(t + 2) * kstep; const char* b2 = last ? nB : cB + (size_t)(t + 2) * kstep;
            const char* a3 = a2 + kstep; const char* b3 = b2 + kstep;
            if (last && has_next) S.a_ready(nxt);
            if constexpr (SP2) {
            PG8_LDB(B0, 0, 0); PG8_LDB(B1, 0, 1); PG8_SCHED; PG8_LDA(At, 0, 0); PG8_STAGE(PG8_SA(1, 1), a1 + hstep, voffA);
            PG8_WAIT_V(8); PG8_WAIT_L(0); PG8_BAR; PG8_MMA(0, 0, At, B0); PG8_MMA(0, 1, At, B1); PG8_BAR; PG8_SCHED;
            PG8_LDA(At, 0, 1); PG8_STAGE(PG8_SB(0, 0), b2, voffB); PG8_STAGE(PG8_SB(0, 1), b2 + hstep, voffB); PG8_STAGE(PG8_SA(0, 0), a2, voffA);
            PG8_WAIT_V(8); PG8_WAIT_L(0); PG8_BAR; PG8_MMA(1, 0, At, B0); PG8_MMA(1, 1, At, B1); PG8_BAR; PG8_SCHED;
            PG8_LDB(B0, 1, 0); PG8_LDB(B1, 1, 1); PG8_SCHED; PG8_LDA(At, 1, 0); PG8_STAGE(PG8_SA(0, 1), a2 + hstep, voffA);
            PG8_WAIT_V(8); PG8_WAIT_L(0); PG8_BAR; PG8_MMA(0, 0, At, B0); PG8_MMA(0, 1, At, B1); PG8_BAR; PG8_SCHED;
            PG8_LDA(At, 1, 1); PG8_STAGE(PG8_SB(1, 0), b3, voffB); PG8_STAGE(PG8_SB(1, 1), b3 + hstep, voffB); PG8_STAGE(PG8_SA(1, 0), a3, voffA);
            PG8_WAIT_V(8); PG8_WAIT_L(0); PG8_BAR; PG8_MMA(1, 0, At, B0); PG8_MMA(1, 1, At, B1); PG8_BAR; PG8_SCHED;
            } else {
            PG8_LDB(B0, 0, 0); PG8_SCHED; PG8_LDA(At, 0, 0); PG8_STAGE(PG8_SA(1, 1), a1 + hstep, voffA);
            PG8_WAIT_L(8); PG8_BAR; PG8_WAIT_L(0); PG8_MMA(0, 0, At, B0); PG8_BAR; PG8_SCHED;
            PG8_LDB(B1, 0, 1); PG8_STAGE(PG8_SB(0, 0), b2, voffB);
            PG8_BAR; PG8_WAIT_L(0); PG8_MMA(0, 1, At, B1); PG8_BAR;
            PG8_LDA(At, 0, 1); PG8_STAGE(PG8_SA(0, 0), a2, voffA);
            PG8_BAR; PG8_WAIT_L(0); PG8_MMA(1, 0, At, B0); PG8_BAR; PG8_SCHED;
            PG8_STAGE(PG8_SB(0, 1), b2 + hstep, voffB);
            PG8_WAIT_V(6); PG8_BAR; PG8_MMA(1, 1, At, B1); PG8_BAR;
            PG8_LDB(B0, 1, 0); PG8_SCHED; PG8_LDA(At, 1, 0); PG8_STAGE(PG8_SA(0, 1), a2 + hstep, voffA);
            PG8_WAIT_L(8); PG8_BAR; PG8_WAIT_L(0); PG8_MMA(0, 0, At, B0); PG8_BAR; PG8_SCHED;
            PG8_LDB(B1, 1, 1); PG8_STAGE(PG8_SB(1, 0), b3, voffB);
            PG8_BAR; PG8_WAIT_L(0); PG8_MMA(0, 1, At, B1); PG8_BAR;
            PG8_LDA(At, 1, 1); PG8_STAGE(PG8_SA(1, 0), a3, voffA);
            PG8_BAR; PG8_WAIT_L(0); PG8_MMA(1, 0, At, B0); PG8_BAR; PG8_SCHED;
            PG8_STAGE(PG8_SB(1, 1), b3 + hstep, voffB);
            PG8_WAIT_V(6); PG8_BAR; PG8_MMA(1, 1, At, B1); PG8_BAR;
            }
        }
        if constexpr (ALIGN_EPI) { if (wr == 0) PG8_BAR; }
        if constexpr (!Epi::AFTER_DRAIN) { E(acc, cur, wr, wc, fr, fq); S.done(cur); }
        if (!has_next) break;
#pragma unroll
        for (int a = 0; a < 2; ++a)
#pragma unroll
            for (int b = 0; b < 2; ++b)
#pragma unroll
                for (int m = 0; m < 4; ++m)
#pragma unroll
                    for (int n = 0; n < 2; ++n) acc[a][b][m][n] = (f32x4){0.f, 0.f, 0.f, 0.f};
        cur = nxt; cA = nA; cB = nB; ++ui;
        if constexpr (ALIGN_EPI) { if (wr == 1) PG8_BAR; }
    }
    PG8_WAIT_V(0);
    if constexpr (!ALIGN_EPI) { if (wr == 0) PG8_BAR; }
    PG8_BAR;
    if constexpr (Epi::AFTER_DRAIN) { E.fused(acc, cur, wr, wc, fr, fq, lds, wid, lane); S.done(cur); }
#undef PG8_SA
#undef PG8_SB
#undef PG8_STAGE
#undef PG8_LDA
#undef PG8_LDB
#undef PG8_MMA
#undef PG8_WAIT_V
#undef PG8_WAIT_L
#undef PG8_BAR
#undef PG8_SCHED
}
}

constexpr int NB = 8, SEQ = 2048, T = NB * SEQ, D = 1024, DEPTH = 4;
constexpr int IN_AB = 2560, NQKV = 3072, NE = 16, FF = 512;
constexpr int MAXTILES = 144, MPAD = MAXTILES * 256;
constexpr int NWAVES = 8, NTHR = 512;

constexpr size_t MiB = 1u << 20;
constexpr size_t WS_CTL = 0, CTL_ZERO_BYTES = 1 * MiB;
constexpr int CW_TMO = 0, CW_BAR = 64, CW_CNT = 8192;
constexpr size_t WS_MOD = 1 * MiB;
constexpr size_t WS_ROT = 2 * MiB;
constexpr size_t WS_AGG = 3 * MiB;
constexpr size_t WS_LIST = 5 * MiB;
constexpr size_t WS_TOPW = 6 * MiB;
constexpr size_t WS_SLOTI = 6 * MiB + 512 * 1024;
constexpr size_t WS_SLOTW = 7 * MiB;
constexpr size_t WS_LRUW = 7 * MiB + 512 * 1024;
constexpr size_t WS_WIN = 8 * MiB;
constexpr size_t WS_WOUT = 18 * MiB;
constexpr size_t WS_WQKV = 22 * MiB;
constexpr size_t WS_WO = 34 * MiB;
constexpr size_t WS_WGU = 38 * MiB;
constexpr size_t WS_WDN = 166 * MiB;
constexpr size_t WS_X = 230 * MiB;
constexpr size_t WS_HB = 294 * MiB;
constexpr size_t WS_R1 = 326 * MiB;
constexpr size_t R1_Z = 0;
constexpr size_t R1_DELTA = 0;
constexpr size_t R1_XS = 0;
constexpr size_t R1_ACT = 72 * MiB;
constexpr size_t R1_YW = 108 * MiB;
constexpr size_t WS_END = 526 * MiB;

constexpr int RING_BYTES = 131072;
constexpr int MISC_OFF = RING_BYTES;
constexpr int ENT_OFF = RING_BYTES + 1024;
constexpr int LDS_BYTES = 147456 + 4096;

#define GAS __attribute__((address_space(1)))
#define LAS __attribute__((address_space(3)))
typedef unsigned short bf16;
typedef unsigned v4u __attribute__((ext_vector_type(4)));
typedef unsigned v2u __attribute__((ext_vector_type(2)));
typedef float f32x4 __attribute__((ext_vector_type(4)));
typedef float f32x2 __attribute__((ext_vector_type(2)));
#define RLX_AGENT __ATOMIC_RELAXED, __HIP_MEMORY_SCOPE_AGENT
#define LDS_WAIT() asm volatile("s_waitcnt lgkmcnt(0)" ::: "memory")
#define VM_WAIT() asm volatile("s_waitcnt vmcnt(0)" ::: "memory")
__device__ __forceinline__ unsigned f2bf(float f) { unsigned u = __builtin_bit_cast(unsigned, f); return (u + 0x7fffu + ((u >> 16) & 1u)) >> 16; }
__device__ __forceinline__ unsigned pk2(float lo, float hi) { return f2bf(lo) | (f2bf(hi) << 16); }
__device__ __forceinline__ float bf2f(unsigned short b) { return __builtin_bit_cast(float, (unsigned)b << 16); }
__device__ __forceinline__ float bflo(unsigned w) { return __builtin_bit_cast(float, w << 16); }
__device__ __forceinline__ float bfhi(unsigned w) { return __builtin_bit_cast(float, w & 0xffff0000u); }

#define XB_TMO      128
#define XB_XCNT(j)  (256  + 64 * (j))
#define XB_XSUB(j)  (1280 + 64 * (j))
#define XB_XGEN(j)  (2304 + 64 * (j))
#define XB_TOP      3328
#define XB_TOPGEN   3392
#define XCD_BAR_WORDS 3456
#define XB_SPIN_CAP (1u << 18)

__device__ __forceinline__ unsigned xb_ld(unsigned* p)              { return __hip_atomic_load(p, __ATOMIC_RELAXED, __HIP_MEMORY_SCOPE_AGENT); }
__device__ __forceinline__ unsigned xb_add(unsigned* p, unsigned v) { return __hip_atomic_fetch_add(p, v, __ATOMIC_RELAXED, __HIP_MEMORY_SCOPE_AGENT); }
__device__ __forceinline__ unsigned xb_xcc_id() { return (unsigned)__builtin_amdgcn_s_getreg((3 << 11) | 20) & 0xFu; }
#define XB_SPIN(cond, bar) do { unsigned _sp = 0; while (cond) { __builtin_amdgcn_s_sleep(1); \
    if ((++_sp & 255u) == 0u) { if (xb_ld(&(bar)[XB_TMO])) break; if (_sp > XB_SPIN_CAP) { atomicAdd(&(bar)[XB_TMO], 1u); break; } } } } while (0)

struct XcdBarrier {
    unsigned* bar; unsigned x;
    volatile LAS unsigned* st;
};

__device__ __forceinline__ XcdBarrier xcd_barrier_post(unsigned* bar, volatile LAS unsigned* st) {
    XcdBarrier b; b.bar = bar; b.x = xb_xcc_id(); b.st = st;
    if (threadIdx.x == 0) (void)xb_add(&bar[XB_XCNT(b.x)], 1u);
    return b;
}
__device__ __forceinline__ void xcd_barrier_complete(unsigned* bar, unsigned x, unsigned& nloc, unsigned& nx) {
    const unsigned G = gridDim.x * gridDim.y * gridDim.z;
    unsigned sum, cnt, mine, sp = 0u;
    for (;;) {
        sum = 0u; cnt = 0u; mine = 0u;
#pragma unroll
        for (unsigned j = 0; j < 16; ++j) { const unsigned c = xb_ld(&bar[XB_XCNT(j)]); sum += c; cnt += (c > 0u) ? 1u : 0u; mine = (j == x) ? c : mine; }
        if (sum == G) break;
        __builtin_amdgcn_s_sleep(1);
        if ((++sp & 255u) == 0u) { if (xb_ld(&bar[XB_TMO])) break; if (sp > XB_SPIN_CAP) { atomicAdd(&bar[XB_TMO], 1u); break; } }
    }
    nloc = mine > 0u ? mine : 1u; nx = cnt > 0u ? cnt : 1u;
}

__device__ __forceinline__ void xcd_barrier(const XcdBarrier& b) {
    asm volatile("s_waitcnt vmcnt(0)" ::: "memory");
    __syncthreads();
    if (threadIdx.x == 0) {
        unsigned* bar = b.bar;
        __builtin_amdgcn_s_waitcnt(0);
        unsigned nloc = b.st[0], nx = b.st[1];
        if (nloc == 0u) { xcd_barrier_complete(bar, b.x, nloc, nx); b.st[0] = nloc; b.st[1] = nx; }
        const unsigned old = xb_add(&bar[XB_XSUB(b.x)], 1u);
        const unsigned gen = old / nloc;
        if (old + 1u == (gen + 1u) * nloc) {
            __builtin_amdgcn_fence(__ATOMIC_RELEASE, "agent");
            asm volatile("s_waitcnt vmcnt(0)" ::: "memory");
            const unsigned og = xb_add(&bar[XB_TOP], 1u);
            const unsigned tg = og / nx;
            if (og + 1u == (tg + 1u) * nx) xb_add(&bar[XB_TOPGEN], 1u);
            else XB_SPIN(xb_ld(&bar[XB_TOPGEN]) == tg, bar);
            __builtin_amdgcn_fence(__ATOMIC_ACQUIRE, "agent");
            xb_add(&bar[XB_XGEN(b.x)], 1u);
            asm volatile("s_waitcnt vmcnt(0)" ::: "memory");
        } else {
            XB_SPIN(xb_ld(&bar[XB_XGEN(b.x)]) == gen, bar);
            __builtin_amdgcn_fence(__ATOMIC_ACQUIRE, "agent");
            asm volatile("s_waitcnt vmcnt(0)" ::: "memory");
        }
    }
    __syncthreads();
}


__device__ __forceinline__ float wave_sum(float v) {
#pragma unroll
    for (int o = 1; o < 64; o <<= 1) v += __shfl_xor(v, o);
    return v;
}
__device__ __forceinline__ float wave_max(float v) {
#pragma unroll
    for (int o = 1; o < 64; o <<= 1) v = fmaxf(v, __shfl_xor(v, o));
    return v;
}
__device__ __forceinline__ float sigmoidf_(float x) { return 1.f / (1.f + expf(-x)); }
__device__ __forceinline__ float gelu_tanh(float x) { const float u = 0.7978845608028654f * (x + 0.044715f * x * x * x); return 0.5f * x * (1.f + tanhf(u)); }
__device__ __forceinline__ void sincos_acc(float ang, float& c, float& s) {
    const double x = (double)ang, q = rint(x * 0.63661977236758134), r = x - q * 1.5707963267948966;
    const int qi = ((int)q) & 3; const float rf = (float)r, r2 = rf * rf;
    const float sp = rf * (1.f + r2 * (-1.6666667e-1f + r2 * (8.3333333e-3f + r2 * (-1.9841270e-4f + r2 * 2.7557319e-6f))));
    const float cp = 1.f + r2 * (-0.5f + r2 * (4.1666667e-2f + r2 * (-1.3888889e-3f + r2 * (2.4801587e-5f - r2 * 2.7557319e-7f))));
    c = (qi == 0) ? cp : (qi == 1) ? -sp : (qi == 2) ? -cp : sp;
    s = (qi == 0) ? sp : (qi == 1) ? cp : (qi == 2) ? -sp : -cp;
}

#define AS4 __attribute__((address_space(4)))
typedef const void* cvp_t;
struct Ctx {
    LAS unsigned char* lds; volatile LAS unsigned* MISC; LAS unsigned char* lds0;
    unsigned* ctl; unsigned char* ws;
    int tid, lane, wave, G, blk;
    const AS4 cvp_t* in;
};

__device__ __forceinline__ bool launder(Ctx& F) { int t = threadIdx.x; asm volatile("" : "+v"(t)); F.tid = t; F.lane = t & 63; F.wave = __builtin_amdgcn_readfirstlane(t >> 6);
    int z = 0; asm volatile("" : "+s"(z));
    const AS4 char* ka = (const AS4 char*)__builtin_amdgcn_kernarg_segment_ptr() + z;
    F.in = (const AS4 cvp_t*)ka; F.ws = *(unsigned char* const AS4*)(ka + 25 * 8 + 8); F.ctl = (unsigned*)(F.ws + WS_CTL);
    F.lds = F.lds0 + z; F.MISC = (volatile LAS unsigned*)(F.lds + MISC_OFF); return true; }

__device__ __forceinline__ void p0_transpose_item(const float* W, int K, int N, bf16* WT, int dstrow0, LAS float* scr, int k0, int n0, int lane) {
#pragma unroll 8
    for (int i = 0; i < 32; ++i) { const int kk = 2 * i + (lane >> 5); scr[kk * 33 + (lane & 31)] = W[(size_t)(k0 + kk) * N + n0 + (lane & 31)]; }
    LDS_WAIT(); asm volatile("" ::: "memory");
    const int c = lane & 7;
#pragma unroll
    for (int j = 0; j < 4; ++j) { const int n = (lane >> 3) + 8 * j; const LAS float* s = scr + (8 * c) * 33 + n;
        v4u o; o.x = pk2(s[0 * 33], s[1 * 33]); o.y = pk2(s[2 * 33], s[3 * 33]); o.z = pk2(s[4 * 33], s[5 * 33]); o.w = pk2(s[6 * 33], s[7 * 33]);
        *(GAS v4u*)(WT + (size_t)(dstrow0 + n) * K + k0 + 8 * c) = o; }
    LDS_WAIT(); asm volatile("" ::: "memory");
}
__device__ __forceinline__ void p0_prologue(const Ctx& F) {
    const float* c_in = (const float*)F.in[1]; const int* pos_in = (const int*)F.in[2];
    const float* mod_w = (const float*)F.in[3]; const float* mod_b = (const float*)F.in[4];
    {
        LAS float* cs_s = (LAS float*)F.lds;
        LAS float* red = (LAS float*)(F.lds + 32768);
        for (int i = F.tid; i < 8192; i += NTHR) { const int b = i >> 10, k = i & 1023; const float v = c_in[i]; cs_s[k * 8 + b] = v / (1.f + expf(-v)); }
        __syncthreads();
        float* MOD = (float*)(F.ws + WS_MOD);
        const int kq = F.tid >> 6, col = F.tid & 63;
        for (int it = F.blk; it < 4 * 96; it += F.G) {
            const int l = it / 96, nb = it % 96;
            float acc[8];
#pragma unroll
            for (int b = 0; b < 8; ++b) acc[b] = 0.f;
            const float* wp = mod_w + ((size_t)l * 1024 + kq * 128) * 6144 + nb * 64 + col;
#pragma unroll 8
            for (int k = 0; k < 128; ++k) { const float w = wp[(size_t)k * 6144];
                const f32x4 c0 = *(const LAS f32x4*)(cs_s + (kq * 128 + k) * 8), c1 = *(const LAS f32x4*)(cs_s + (kq * 128 + k) * 8 + 4);
                acc[0] += c0[0] * w; acc[1] += c0[1] * w; acc[2] += c0[2] * w; acc[3] += c0[3] * w; acc[4] += c1[0] * w; acc[5] += c1[1] * w; acc[6] += c1[2] * w; acc[7] += c1[3] * w; }
#pragma unroll
            for (int b = 0; b < 8; ++b) red[(kq * 8 + b) * 64 + col] = acc[b];
            __syncthreads();
            { const int b = F.tid >> 6; float s = mod_b[l * 6144 + nb * 64 + col];
#pragma unroll
              for (int q = 0; q < 8; ++q) s += red[(q * 8 + b) * 64 + col];
              MOD[((size_t)l * 8 + b) * 6144 + nb * 64 + col] = s; }
            __syncthreads();
        }
    }
    {
        float* ROT = (float*)(F.ws + WS_ROT);
        for (int idx = F.blk * NTHR + F.tid; idx < T * 8; idx += F.G * NTHR) { const int row = idx >> 3, i = idx & 7;
            const float invf = exp2f(-(float)i * (18.931568569324174f / 8.0f));
            const float ang = (float)pos_in[row] * invf; float c, s; sincos_acc(ang, c, s);
            *(f32x2*)(ROT + (size_t)idx * 2) = (f32x2){c, s}; }
    }
    {
        LAS float* scr = (LAS float*)(F.lds + F.wave * 16384);
        const int gw = F.blk * NWAVES + F.wave, NGW = F.G * NWAVES;
        constexpr int I_IN = 2 * 16 * 80, I_OUT = 2 * 16 * 32, I_QKV = 2 * 16 * 96, I_O = 2 * 16 * 32, I_G = 64 * 256, I_U = 64 * 256, I_D = 64 * 256;
        constexpr int NITEMS = I_IN + I_OUT + I_QKV + I_O + I_G + I_U + I_D;
        for (int it = gw; it < NITEMS; it += NGW) {
            int r = it;
            if (r < I_IN) { const int mt = r / 1280, q = r % 1280, kb = q / 80, nb = q % 80;
                p0_transpose_item((const float*)F.in[8] + (size_t)mt * 1024 * 2560, 1024, 2560, (bf16*)(F.ws + WS_WIN) + (size_t)mt * 2560 * 1024, nb * 32, scr, kb * 64, nb * 32, F.lane); continue; } r -= I_IN;
            if (r < I_OUT) { const int mt = r / 512, q = r % 512, kb = q / 32, nb = q % 32;
                p0_transpose_item((const float*)F.in[17] + (size_t)mt * 1024 * 1024, 1024, 1024, (bf16*)(F.ws + WS_WOUT) + (size_t)mt * 1024 * 1024, nb * 32, scr, kb * 64, nb * 32, F.lane); continue; } r -= I_OUT;
            if (r < I_QKV) { const int mt = r / 1536, q = r % 1536, kb = q / 96, nb = q % 96;
                p0_transpose_item((const float*)F.in[18] + (size_t)mt * 1024 * 3072, 1024, 3072, (bf16*)(F.ws + WS_WQKV) + (size_t)mt * 3072 * 1024, nb * 32, scr, kb * 64, nb * 32, F.lane); continue; } r -= I_QKV;
            if (r < I_O) { const int mt = r / 512, q = r % 512, kb = q / 32, nb = q % 32;
                p0_transpose_item((const float*)F.in[19] + (size_t)mt * 1024 * 1024, 1024, 1024, (bf16*)(F.ws + WS_WO) + (size_t)mt * 1024 * 1024, nb * 32, scr, kb * 64, nb * 32, F.lane); continue; } r -= I_O;
            if (r < I_G + I_U) { const int up = (r >= I_G) ? 1 : 0; r -= up * I_G; const int mt = r / 256, q = r % 256, kb = q / 16, nb = q % 16, n0 = nb * 32;
                p0_transpose_item((const float*)F.in[22 + up] + (size_t)mt * 1024 * 512, 1024, 512, (bf16*)(F.ws + WS_WGU) + (size_t)mt * 1024 * 1024, (n0 >> 7) * 256 + (n0 & 127) + up * 128, scr, kb * 64, n0, F.lane); continue; } r -= I_G + I_U;
            { const int mt = r / 256, q = r % 256, kb = q / 32, nb = q % 32;
                p0_transpose_item((const float*)F.in[24] + (size_t)mt * 512 * 1024, 512, 1024, (bf16*)(F.ws + WS_WDN) + (size_t)mt * 1024 * 512, nb * 32, scr, kb * 64, nb * 32, F.lane); }
        }
    }
}

template <int NDELTA, bool ROUTE, bool FINAL>
__device__ __forceinline__ void norm_phase(const Ctx& F, const float* xin, float* xout, const bf16* delta, const float* gate, const float* gvec, const float* shift, const float* scale,
                                           bf16* hout, float* fout, unsigned* gcnt) {
    LAS float* rw_s = (LAS float*)F.lds;
    volatile LAS unsigned* lcnt = F.MISC + 40; volatile LAS unsigned* lbase = F.MISC + 56; volatile LAS unsigned* nent = F.MISC + 72;
    LAS unsigned* ent = (LAS unsigned*)(F.lds + ENT_OFF);
    if (ROUTE) {
        const float* rw = (const float*)F.in[20];
        for (int i = F.tid; i < 16384; i += NTHR) { const int k = i >> 4, e = i & 15; rw_s[e * 1024 + k] = rw[i]; }
        if (F.tid < 16) lcnt[F.tid] = 0u; if (F.tid == 16) nent[0] = 0u;
        __syncthreads();
    }
    const float* rbias = (const float*)F.in[21];
    const int ngrp = T / NWAVES;
    for (int rg = F.blk; rg < ngrp; rg += F.G) {
        const int row = rg * NWAVES + F.wave, b = row >> 11;
        f32x4 v[4]; float ss = 0.f;
#pragma unroll
        for (int j = 0; j < 4; ++j) { const int col = 4 * F.lane + 256 * j;
            v[j] = *(const f32x4*)(xin + (size_t)row * D + col);
            if (NDELTA >= 1) {
                const f32x4 g4 = *(const f32x4*)(gate + (size_t)b * 6144 + col);
                f32x4 dl;
                if (NDELTA == 1) { const v2u w = *(const v2u*)(delta + (size_t)row * D + col); dl = (f32x4){bflo(w.x), bfhi(w.x), bflo(w.y), bfhi(w.y)}; }
                else { const v2u w0 = *(const v2u*)(delta + (size_t)row * 2 * D + col), w1 = *(const v2u*)(delta + (size_t)row * 2 * D + D + col);
                    dl = (f32x4){bflo(w0.x) + bflo(w1.x), bfhi(w0.x) + bfhi(w1.x), bflo(w0.y) + bflo(w1.y), bfhi(w0.y) + bfhi(w1.y)}; }
                v[j] = v[j] + g4 * dl;
            }
            if (!FINAL) *(f32x4*)(xout + (size_t)row * D + col) = v[j];
            ss += (v[j][0] * v[j][0] + v[j][1] * v[j][1]) + (v[j][2] * v[j][2] + v[j][3] * v[j][3]);
        }
        ss = wave_sum(ss);
        const float rstd = 1.0f / sqrtf(ss * (1.0f / D) + 1e-6f);
#pragma unroll
        for (int j = 0; j < 4; ++j) { const int col = 4 * F.lane + 256 * j;
            const f32x4 g4 = *(const f32x4*)(gvec + col);
            f32x4 y = v[j] * rstd * g4;
            if (FINAL) { *(f32x4*)(fout + (size_t)row * D + col) = y; }
            else { const f32x4 sc = *(const f32x4*)(scale + (size_t)b * 6144 + col), sh = *(const f32x4*)(shift + (size_t)b * 6144 + col);
                y = y * (1.0f + sc) + sh; v[j] = y;
                v2u w; w.x = pk2(y[0], y[1]); w.y = pk2(y[2], y[3]); *(v2u*)(hout + (size_t)row * D + col) = w; }
        }
        if (ROUTE) {
            float lg[16];
#pragma unroll
            for (int e = 0; e < 16; ++e) { float a = 0.f;
#pragma unroll
                for (int j = 0; j < 4; ++j) { const f32x4 w = *(const LAS f32x4*)(rw_s + e * 1024 + 256 * j + 4 * F.lane); a += (v[j][0] * w[0] + v[j][1] * w[1]) + (v[j][2] * w[2] + v[j][3] * w[3]); }
                lg[e] = wave_sum(a); }
            float sc[16], bi[16];
#pragma unroll
            for (int e = 0; e < 16; ++e) { sc[e] = sigmoidf_(lg[e]); bi[e] = sc[e] + rbias[e]; }
            float bestgs = -1e30f, s1 = 0.f, s2 = 0.f; int e1 = 0, e2 = 1;
#pragma unroll
            for (int g = 0; g < 4; ++g) {
                float m1 = bi[4 * g], t1 = sc[4 * g]; int i1 = 0;
#pragma unroll
                for (int k = 1; k < 4; ++k) if (bi[4 * g + k] > m1) { m1 = bi[4 * g + k]; t1 = sc[4 * g + k]; i1 = k; }
                float m2 = -1e30f, t2 = 0.f; int i2 = 0;
#pragma unroll
                for (int k = 0; k < 4; ++k) if (k != i1 && bi[4 * g + k] > m2) { m2 = bi[4 * g + k]; t2 = sc[4 * g + k]; i2 = k; }
                const float gs = m1 + m2;
                if (gs > bestgs) { bestgs = gs; e1 = 4 * g + i1; e2 = 4 * g + i2; s1 = t1; s2 = t2; }
            }
            if (F.lane == 0) {
                const float inv = 1.0f / (s1 + s2);
                float* topw = (float*)(F.ws + WS_TOPW);
                topw[row * 2] = s1 * inv; topw[row * 2 + 1] = s2 * inv;
                const unsigned p1 = __hip_atomic_fetch_add((LAS unsigned*)&lcnt[e1], 1u, __ATOMIC_RELAXED, __HIP_MEMORY_SCOPE_WORKGROUP), p2 = __hip_atomic_fetch_add((LAS unsigned*)&lcnt[e2], 1u, __ATOMIC_RELAXED, __HIP_MEMORY_SCOPE_WORKGROUP), n = __hip_atomic_fetch_add((LAS unsigned*)&nent[0], 2u, __ATOMIC_RELAXED, __HIP_MEMORY_SCOPE_WORKGROUP);
                ent[2 * n] = ((unsigned)e1 << 16) | p1; ent[2 * n + 1] = (unsigned)(row * 2);
                ent[2 * n + 2] = ((unsigned)e2 << 16) | p2; ent[2 * n + 3] = (unsigned)(row * 2 + 1);
            }
        }
    }
    if (ROUTE) {
        __syncthreads();
        if (F.tid < 16) lbase[F.tid] = __hip_atomic_fetch_add(gcnt + F.tid, lcnt[F.tid], RLX_AGENT);
        __syncthreads();
        int* list = (int*)(F.ws + WS_LIST); const unsigned n = nent[0];
        for (unsigned i = F.tid; i < n; i += NTHR) { const unsigned key = ent[2 * i], val = ent[2 * i + 1], e = key >> 16, p = key & 0xffffu; list[(size_t)e * T + lbase[e] + p] = (int)val; }
        __syncthreads();
    }
}

__device__ __forceinline__ void compute_tpre(const Ctx& F, unsigned* gcnt) {
    if (F.tid < 16) F.MISC[40 + F.tid] = __hip_atomic_load(gcnt + F.tid, RLX_AGENT);
    __syncthreads();
    if (F.tid == 0) { unsigned acc = 0;
        for (int e = 0; e < 16; ++e) { F.MISC[16 + e] = acc; acc += (F.MISC[40 + e] + 255u) >> 8; }
        F.MISC[32] = acc; }
    __syncthreads();
}
__device__ __forceinline__ void dispatch_phase(const Ctx& F, unsigned* gcnt) {
    compute_tpre(F, gcnt);
    const int gw = F.blk * NWAVES + F.wave, NGW = F.G * NWAVES;
    const int nrows = (int)F.MISC[32] * 256;
    const bf16* H = (const bf16*)(F.ws + WS_HB); bf16* XS = (bf16*)(F.ws + WS_R1 + R1_XS);
    const int* list = (const int*)(F.ws + WS_LIST); const float* topw = (const float*)(F.ws + WS_TOPW);
    int* sloti = (int*)(F.ws + WS_SLOTI); float* slotw = (float*)(F.ws + WS_SLOTW);
    for (int r = gw; r < nrows; r += NGW) {
        const int pt = r >> 8; int e = 0;
#pragma unroll
        for (int j = 1; j < 16; ++j) e += (pt >= (int)F.MISC[16 + j]) ? 1 : 0;
        const int pos = r - (int)F.MISC[16 + e] * 256, cnt = (int)F.MISC[40 + e];
        v4u a = (v4u){0u, 0u, 0u, 0u}, bq = a; int info = -1; float w = 0.f;
        if (pos < cnt) { info = list[(size_t)e * T + pos]; w = topw[info];
            const v4u* src = (const v4u*)(H + (size_t)(info >> 1) * D); a = src[F.lane]; bq = src[64 + F.lane]; }
        v4u* dst = (v4u*)(XS + (size_t)r * D); dst[F.lane] = a; dst[64 + F.lane] = bq;
        if (F.lane == 0) { sloti[r] = info; slotw[r] = w; }
    }
}

template <bool OUT>
__device__ __forceinline__ void mix_phase(const Ctx& F, int jl) {
    LAS float* xr_s = (LAS float*)F.lds;
    LAS float* A_s = (LAS float*)(F.lds + 16384);
    LAS float* B_s = (LAS float*)(F.lds + 49152);
    const bf16* Z = (const bf16*)(F.ws + WS_R1 + R1_Z); bf16* Y = (bf16*)(F.ws + WS_HB);
    f32x2* AGG = (f32x2*)(F.ws + WS_AGG);
    const float* conv_a_w = (const float*)F.in[9] + (size_t)jl * 3 * 512; const float* conv_b_w = (const float*)F.in[10] + (size_t)jl * 4 * 512; const float* conv_b_b = (const float*)F.in[11] + (size_t)jl * 512;
    const float* lru_wa = (const float*)F.in[12] + (size_t)jl * 2 * 8 * 4096; const float* lru_ba = (const float*)F.in[13] + (size_t)jl * 2 * 512;
    const float* lru_wx = (const float*)F.in[14] + (size_t)jl * 2 * 8 * 4096; const float* lru_bx = (const float*)F.in[15] + (size_t)jl * 2 * 512;
    const float* lru_lam = (const float*)F.in[16] + (size_t)jl * 2 * 512;
    const int j = F.tid & 63, tg = F.tid >> 6;
    for (int unit = F.blk; unit < 8 * 32 * 8; unit += F.G) {
        const int b = unit >> 8, c = (unit >> 3) & 31, h = unit & 7, t0 = c * 64, ch = h * 64 + j; const size_t rb = (size_t)b * SEQ;
        { float wB[4];
#pragma unroll
          for (int k = 0; k < 4; ++k) wB[k] = conv_b_w[k * 512 + ch];
          const float bB = conv_b_b[ch];
#pragma unroll
          for (int i = 0; i < 8; ++i) { const int tt = tg * 8 + i, t = t0 + tt; float a = bB;
#pragma unroll
              for (int k = 0; k < 4; ++k) { const int ts = t + k - 1; if (ts >= 0 && ts < SEQ) a += wB[k] * bf2f(Z[(rb + ts) * IN_AB + 2048 + ch]); }
              xr_s[tt * 64 + j] = a; } }
        __syncthreads();
        float ar[2][8], ax[2][8];
#pragma unroll
        for (int d = 0; d < 2; ++d)
#pragma unroll
            for (int i = 0; i < 8; ++i) { ar[d][i] = 0.f; ax[d][i] = 0.f; }
        { const float* wa0 = lru_wa + (size_t)(0 * 8 + h) * 4096 + j; const float* wa1 = lru_wa + (size_t)(1 * 8 + h) * 4096 + j;
          const float* wx0 = lru_wx + (size_t)(0 * 8 + h) * 4096 + j; const float* wx1 = lru_wx + (size_t)(1 * 8 + h) * 4096 + j;
#pragma unroll 4
          for (int i = 0; i < 64; ++i) { const float a0 = wa0[i * 64], a1 = wa1[i * 64], x0 = wx0[i * 64], x1 = wx1[i * 64];
#pragma unroll
              for (int q = 0; q < 8; ++q) { const float xv = xr_s[(tg * 8 + q) * 64 + i]; ar[0][q] += xv * a0; ar[1][q] += xv * a1; ax[0][q] += xv * x0; ax[1][q] += xv * x1; } } }
#pragma unroll
        for (int d = 0; d < 2; ++d) { const float ba = lru_ba[d * 512 + ch], bx = lru_bx[d * 512 + ch], sp = log1pf(expf(-lru_lam[d * 512 + ch]));
#pragma unroll
            for (int q = 0; q < 8; ++q) { const int tt = tg * 8 + q; const float r = sigmoidf_(ar[d][q] + ba), ig = sigmoidf_(ax[d][q] + bx), la = -8.0f * r * sp, a = expf(la), mult = sqrtf(-expm1f(2.0f * la));
                A_s[(d * 64 + tt) * 64 + j] = a; B_s[(d * 64 + tt) * 64 + j] = xr_s[tt * 64 + j] * ig * mult; } }
        __syncthreads();
        if (F.tid < 128) { const int d = F.tid >> 6; float hs = 0.f, P = 1.f;
            if (OUT) {
                if (d == 0) { for (int cc = 0; cc < c; ++cc) { const f32x2 pg = AGG[((size_t)(b * 2 + 0) * 32 + cc) * 512 + ch]; hs = pg.x * hs + pg.y; } }
                else { for (int cc = 31; cc > c; --cc) { const f32x2 pg = AGG[((size_t)(b * 2 + 1) * 32 + cc) * 512 + ch]; hs = pg.x * hs + pg.y; } }
            }
            for (int s = 0; s < 64; ++s) { const int tt = d ? 63 - s : s; const float a = A_s[(d * 64 + tt) * 64 + j], bb = B_s[(d * 64 + tt) * 64 + j]; hs = a * hs + bb;
                if (OUT) B_s[(d * 64 + tt) * 64 + j] = hs; else P *= a; }
            if (!OUT) AGG[((size_t)(b * 2 + d) * 32 + c) * 512 + ch] = (f32x2){P, hs};
        }
        if (OUT) {
            __syncthreads();
            float wA[3];
#pragma unroll
            for (int k = 0; k < 3; ++k) wA[k] = conv_a_w[k * 512 + ch];
#pragma unroll
            for (int i = 0; i < 8; ++i) { const int tt = tg * 8 + i, t = t0 + tt; const size_t row = rb + t;
                const float hrec = B_s[(0 * 64 + tt) * 64 + j] + B_s[(1 * 64 + tt) * 64 + j];
                const float yb = gelu_tanh(bf2f(Z[row * IN_AB + 1536 + ch])) * hrec;
                float sa = 0.f;
#pragma unroll
                for (int k = 0; k < 3; ++k) { const int ts = t + k - 1; if (ts >= 0 && ts < SEQ) sa += wA[k] * (bf2f(Z[(rb + ts) * IN_AB + 1024 + ch]) * bf2f(Z[(rb + ts) * IN_AB + ch])); }
                const float ya = bf2f(Z[row * IN_AB + 512 + ch]) * sa;
                Y[row * D + ch] = (bf16)f2bf(ya); Y[row * D + 512 + ch] = (bf16)f2bf(yb); }
        }
        __syncthreads();
    }
}

__device__ __forceinline__ void attn_naive_phase(const Ctx& F) {
    const bf16* QKV = (const bf16*)(F.ws + WS_R1 + R1_Z); bf16* Y = (bf16*)(F.ws + WS_HB);
    LAS float* qs = (LAS float*)(F.lds + F.wave * 4096);
    LAS float* ps = qs + 64;
    const int gw = F.blk * NWAVES + F.wave, NGW = F.G * NWAVES;
    for (int unit = gw; unit < T * 16; unit += NGW) {
        const int row = unit >> 4, hd = unit & 15, b = row >> 11, t = row & 2047; const size_t rb = (size_t)b * SEQ;
        qs[F.lane] = bf2f(QKV[(size_t)row * NQKV + hd * 64 + F.lane]) * 0.125f;
        LDS_WAIT(); asm volatile("" ::: "memory");
        float sc[7]; float mx = -1e30f;
#pragma unroll
        for (int i = 0; i < 7; ++i) { const int n = F.lane + 64 * i, p = n / 129, jj = n - p * 129 - 64, dd = (p == 0) ? 1 : (p == 1) ? 4 : 16, tk = t + dd * jj;
            const bool valid = (n < 387) && tk >= 0 && tk < SEQ; float dot = -1e30f;
            if (valid) { const v4u* kp = (const v4u*)(QKV + (rb + tk) * NQKV + 1024 + hd * 64); dot = 0.f;
#pragma unroll
                for (int q = 0; q < 8; ++q) { const v4u w = kp[q]; const LAS float* qq = qs + q * 8;
                    dot += qq[0] * bflo(w.x) + qq[1] * bfhi(w.x) + qq[2] * bflo(w.y) + qq[3] * bfhi(w.y) + qq[4] * bflo(w.z) + qq[5] * bfhi(w.z) + qq[6] * bflo(w.w) + qq[7] * bfhi(w.w); } }
            sc[i] = dot; mx = fmaxf(mx, dot); }
        mx = wave_max(mx); float sum = 0.f;
#pragma unroll
        for (int i = 0; i < 7; ++i) { const float pr = (sc[i] > -1e29f) ? expf(sc[i] - mx) : 0.f; ps[F.lane + 64 * i] = pr; sum += pr; }
        sum = wave_sum(sum);
        LDS_WAIT(); asm volatile("" ::: "memory");
        float o = 0.f;
#pragma unroll
        for (int p = 0; p < 3; ++p) { const int dd = (p == 0) ? 1 : (p == 1) ? 4 : 16;
#pragma unroll 4
            for (int jj = -64; jj <= 64; ++jj) { const int tk = t + dd * jj; if (tk < 0 || tk >= SEQ) continue;
                o += ps[p * 129 + jj + 64] * bf2f(QKV[(rb + tk) * NQKV + 2048 + hd * 64 + F.lane]); } }
        Y[(size_t)row * D + hd * 64 + F.lane] = (bf16)f2bf(o / sum);
        LDS_WAIT(); asm volatile("" ::: "memory");
    }
}

typedef short bf16x8 __attribute__((ext_vector_type(8)));
typedef short s16x4 __attribute__((ext_vector_type(4)));
typedef float f32x16 __attribute__((ext_vector_type(16)));
typedef __bf16 bf16x2_t __attribute__((ext_vector_type(2)));
typedef short v4i16_t __attribute__((ext_vector_type(4)));
__device__ __forceinline__ unsigned cvtpk(float lo, float hi) { f32x2 v = {lo, hi}; bf16x2_t b = __builtin_convertvector(v, bf16x2_t); return __builtin_bit_cast(unsigned, b); }
__device__ __forceinline__ bool attn_tile_info(int ti, int w, int r16, int& d, int& ktok0) {
    if (ti < 5) { const int tt = (ti == 0) ? 2 : (ti <= 2 ? ti - 1 : ti); const int jt = 32 * w - 64 + 32 * tt; d = 16; ktok0 = r16 + 16 * jt; return jt >= 0 && jt < 128; }
    if (ti < 13) { const int jt = 128 * w - 64 + 32 * (ti - 5); d = 4; ktok0 = (r16 & 3) + 4 * jt; return jt >= 0 && jt < 512; }
    const int kt = 512 * w - 64 + 32 * (ti - 13); d = 1; ktok0 = kt; return kt >= 0 && kt < SEQ;
}
__device__ __forceinline__ void attn_phase(const Ctx& F) {
    const bf16* QKV = (const bf16*)(F.ws + WS_R1 + R1_Z); bf16* Y = (bf16*)(F.ws + WS_HB);
    LAS unsigned char* kl = F.lds + F.wave * 8704;
    LAS unsigned char* vl = kl + 4608;
    const int lane = F.lane, r = lane & 31, h = lane >> 5;
    const int gw = F.blk * NWAVES + F.wave, NGW = F.G * NWAVES;
    const int srow = lane >> 3, sch = lane & 7;
    const unsigned kst = srow * 144 + sch * 16, vst = (sch >> 2) * 2048 + srow * 64 + (sch & 3) * 16;
    const unsigned krd = r * 144 + h * 16;
    const int gi = (lane >> 4) & 1, i16 = lane & 15;
    const unsigned vrd = (4 * h + (i16 >> 2)) * 64 + gi * 32 + (i16 & 3) * 8;
    const float cexp = 0.125f * 1.4426950408889634f;
    for (int unit = gw; unit < 8192; unit += NGW) {
        const int r16 = unit & 15, w = (unit >> 4) & 3, hd = (unit >> 6) & 15, b = unit >> 10; const size_t rb = (size_t)b * SEQ;
        const int qtok = w * 512 + 16 * r + r16;
        bf16x8 qf[4];
        { const bf16* qp = QKV + (rb + qtok) * NQKV + hd * 64 + 8 * h;
#pragma unroll
          for (int kk = 0; kk < 4; ++kk) qf[kk] = *(const bf16x8*)(qp + 16 * kk); }
        f32x16 o0, o1;
#pragma unroll
        for (int i = 0; i < 16; ++i) { o0[i] = 0.f; o1[i] = 0.f; }
        float mrun = -1e30f, lrun = 0.f;
        const bf16* kbase = QKV + rb * NQKV + 1024 + hd * 64 + sch * 8;
        int d = 1, ktok0 = 0; bool inr = attn_tile_info(0, w, r16, d, ktok0);
        v4u kg[4], vg[4];
#pragma unroll
        for (int i = 0; i < 4; ++i) { int tok = ktok0 + d * (srow + 8 * i); tok = tok < 0 ? 0 : (tok > SEQ - 1 ? SEQ - 1 : tok); const bf16* p = kbase + (size_t)tok * NQKV; kg[i] = *(const v4u*)p; vg[i] = *(const v4u*)(p + 1024); }
#pragma nounroll
        for (int ti = 0; ti < 33; ++ti) {
            const int dcur = d, kcur = ktok0; const bool inrcur = inr;
#pragma unroll
            for (int i = 0; i < 4; ++i) { *(LAS v4u*)(kl + kst + i * 8 * 144) = kg[i]; *(LAS v4u*)(vl + vst + i * 8 * 64) = vg[i]; }
            if (ti + 1 < 33) {
                inr = attn_tile_info(ti + 1, w, r16, d, ktok0);
#pragma unroll
                for (int i = 0; i < 4; ++i) { int tok = ktok0 + d * (srow + 8 * i); tok = tok < 0 ? 0 : (tok > SEQ - 1 ? SEQ - 1 : tok); const bf16* p = kbase + (size_t)tok * NQKV; kg[i] = *(const v4u*)p; vg[i] = *(const v4u*)(p + 1024); }
            }
            f32x16 s;
#pragma unroll
            for (int i = 0; i < 16; ++i) s[i] = 0.f;
#pragma unroll
            for (int kk = 0; kk < 4; ++kk) { const bf16x8 kf = *(const LAS bf16x8*)(kl + krd + 32 * kk); s = __builtin_amdgcn_mfma_f32_32x32x16_bf16(kf, qf[kk], s, 0, 0, 0); }
            const int diff0 = kcur - qtok + dcur * 4 * h, lim = inrcur ? 64 * dcur : -1; float mx = -1e30f;
#pragma unroll
            for (int i = 0; i < 16; ++i) { const int df = diff0 + dcur * ((i & 3) + 8 * (i >> 2)); const bool ok = (df <= lim) && (df >= -lim); s[i] = ok ? s[i] : -1e30f; mx = fmaxf(mx, s[i]); }
            mx = fmaxf(mx, __shfl_xor(mx, 32));
            const float mnew = fmaxf(mrun, mx), alpha = exp2f((mrun - mnew) * cexp), mc = mnew * cexp; mrun = mnew;
            float ps = 0.f;
#pragma unroll
            for (int i = 0; i < 16; ++i) { s[i] = exp2f(s[i] * cexp - mc); ps += s[i]; }
            ps += __shfl_xor(ps, 32);
            lrun = lrun * alpha + ps;
#pragma unroll
            for (int i = 0; i < 16; ++i) { o0[i] *= alpha; o1[i] *= alpha; }
#pragma unroll
            for (int sx = 0; sx < 2; ++sx) {
                v4u pw; pw.x = cvtpk(s[8 * sx + 0], s[8 * sx + 1]); pw.y = cvtpk(s[8 * sx + 2], s[8 * sx + 3]); pw.z = cvtpk(s[8 * sx + 4], s[8 * sx + 5]); pw.w = cvtpk(s[8 * sx + 6], s[8 * sx + 7]);
                const bf16x8 pf = __builtin_bit_cast(bf16x8, pw);
#pragma unroll
                for (int dt = 0; dt < 2; ++dt) {
                    const s16x4 va = __builtin_bit_cast(s16x4, __builtin_amdgcn_ds_read_tr16_b64_v4i16((LAS v4i16_t*)(vl + vrd + dt * 2048 + (16 * sx) * 64)));
                    const s16x4 vb = __builtin_bit_cast(s16x4, __builtin_amdgcn_ds_read_tr16_b64_v4i16((LAS v4i16_t*)(vl + vrd + dt * 2048 + (16 * sx + 8) * 64)));
                    const bf16x8 vf = {va[0], va[1], va[2], va[3], vb[0], vb[1], vb[2], vb[3]};
                    if (dt == 0) o0 = __builtin_amdgcn_mfma_f32_32x32x16_bf16(vf, pf, o0, 0, 0, 0); else o1 = __builtin_amdgcn_mfma_f32_32x32x16_bf16(vf, pf, o1, 0, 0, 0);
                }
            }
        }
        const float inv = 1.0f / lrun;
        bf16* yp = Y + (rb + qtok) * D + hd * 64 + 4 * h;
#pragma unroll
        for (int g = 0; g < 4; ++g) {
            v2u w0; w0.x = cvtpk(o0[4 * g] * inv, o0[4 * g + 1] * inv); w0.y = cvtpk(o0[4 * g + 2] * inv, o0[4 * g + 3] * inv); *(v2u*)(yp + 8 * g) = w0;
            v2u w1; w1.x = cvtpk(o1[4 * g] * inv, o1[4 * g + 1] * inv); w1.y = cvtpk(o1[4 * g + 2] * inv, o1[4 * g + 3] * inv); *(v2u*)(yp + 32 + 8 * g) = w1;
        }
    }
}
#ifndef EN_P0
#define EN_P0 1
#endif
#ifndef EN_N1
#define EN_N1 1
#endif
#ifndef EN_G1E
#define EN_G1E 1
#endif
#ifndef EN_G1O
#define EN_G1O 1
#endif
#ifndef EN_MIXA
#define EN_MIXA 1
#endif
#ifndef EN_MIXB
#define EN_MIXB 1
#endif
#ifndef EN_ATT
#define EN_ATT 1
#endif
#ifndef EN_G2
#define EN_G2 1
#endif
#ifndef EN_N2
#define EN_N2 1
#endif
#ifndef EN_DISP
#define EN_DISP 1
#endif
#ifndef EN_GU
#define EN_GU 1
#endif
#ifndef EN_DN
#define EN_DN 1
#endif
#ifndef EN_FIN
#define EN_FIN 1
#endif

struct Args { const void* in[25]; float* out; unsigned char* ws; int ph_lo, ph_hi; };
constexpr int NPHASE = 2 + 9 * DEPTH;

__global__ void __launch_bounds__(NTHR, 2) fwd(Args args) {
    extern __shared__ __attribute__((aligned(16))) unsigned char lds[];
    Ctx F;
    F.lds0 = (LAS unsigned char*)lds; F.lds = F.lds0; F.MISC = (volatile LAS unsigned*)(F.lds + MISC_OFF);
    F.tid = threadIdx.x; F.lane = F.tid & 63; F.wave = __builtin_amdgcn_readfirstlane(F.tid >> 6);
    F.G = gridDim.x; F.blk = blockIdx.x; launder(F);
    for (int u = F.tid; u < 256; u += NTHR) ((LAS unsigned*)(F.lds + MISC_OFF))[u] = 0u;
    __syncthreads();
#if MK_ONE_LAUNCH
    XcdBarrier bar = xcd_barrier_post(F.ctl + CW_BAR, F.MISC + 8);
#define GRID_BAR() xcd_barrier(bar)
#else
#define GRID_BAR() do { } while (0)
#endif
    const int lo = args.ph_lo, hi = args.ph_hi;
#define IN(k) (lo <= (k) && (k) < hi && launder(F))
#define SEAM(k) do { if (IN(k) && IN((k) + 1)) GRID_BAR(); } while (0)
#define WSP (F.ws)
#define MOD ((const float*)(F.ws + WS_MOD))
#define X ((float*)(F.ws + WS_X))
#define HB ((bf16*)(F.ws + WS_HB))
#define R1Z ((bf16*)(F.ws + WS_R1 + R1_Z))
#define DELTA ((bf16*)(F.ws + WS_R1 + R1_DELTA))
#define XS ((bf16*)(F.ws + WS_R1 + R1_XS))
#define ACT ((bf16*)(F.ws + WS_R1 + R1_ACT))
#define YW ((bf16*)(F.ws + WS_R1 + R1_YW))

    if (EN_P0 && IN(0)) { p0_prologue(F); } SEAM(0);

    for (int l = 0; l < DEPTH; ++l) {
        const int base = 1 + 9 * l, jl = l >> 1; const bool even = (l & 1) == 0;
#define modl (MOD + (size_t)l * 8 * 6144)
#define gcnt (F.ctl + CW_CNT + 64 * l)
        if (EN_N1 && IN(base + 0)) {
            const float* gv = (const float*)F.in[5] + (size_t)l * D;
            if (l == 0) norm_phase<0, false, false>(F, (const float*)F.in[0], X, nullptr, nullptr, gv, modl + 0, modl + 1024, HB, nullptr, nullptr);
            else norm_phase<2, false, false>(F, X, X, YW, MOD + (size_t)(l - 1) * 8 * 6144 + 5120, gv, modl + 0, modl + 1024, HB, nullptr, nullptr);
        }
        SEAM(base + 0);
        if (IN(base + 1)) {
            if (!EN_G1E && even) {} else if (even) { pg8::StaticOrder S; S.init(HB, (const bf16*)(WSP + WS_WIN) + (size_t)jl * IN_AB * D, T, IN_AB, D, F.G, F.blk);
                pg8::EpiStore E{R1Z, IN_AB};
                pg8::gemm_phase<pg8::EpiStore, pg8::StaticOrder, true, true>(F.lds, D, S, E, F.tid); }
            else if (EN_G1O) { pg8::StaticOrder S; S.init(HB, (const bf16*)(WSP + WS_WQKV) + (size_t)jl * NQKV * D, T, NQKV, D, F.G, F.blk);
                pg8::EpiQKV E{R1Z, (const float*)(WSP + WS_ROT)};
                pg8::gemm_phase<pg8::EpiQKV, pg8::StaticOrder, true, true>(F.lds, D, S, E, F.tid); }
        }
        SEAM(base + 1);
        if (IN(base + 2)) { if (even) { if (EN_MIXA) mix_phase<false>(F, jl); } else { if (EN_ATT) attn_phase(F); } }
        SEAM(base + 2);
        if (EN_MIXB && IN(base + 3)) { if (even) mix_phase<true>(F, jl); }
        if (even) SEAM(base + 3);
        if (EN_G2 && IN(base + 4)) {
            pg8::StaticOrder S; S.init(HB, even ? (const bf16*)(WSP + WS_WOUT) + (size_t)jl * D * D : (const bf16*)(WSP + WS_WO) + (size_t)jl * D * D, T, D, D, F.G, F.blk);
            pg8::EpiStore E{DELTA, D};
            pg8::gemm_phase<pg8::EpiStore, pg8::StaticOrder, true, true>(F.lds, D, S, E, F.tid);
        }
        SEAM(base + 4);
        if (EN_N2 && IN(base + 5)) norm_phase<1, true, false>(F, X, X, DELTA, modl + 2048, (const float*)F.in[6] + (size_t)l * D, modl + 3072, modl + 4096, HB, nullptr, gcnt);
        SEAM(base + 5);
        if (EN_DISP && IN(base + 6)) dispatch_phase(F, gcnt);
        SEAM(base + 6);
        if (EN_GU && IN(base + 7)) {
            compute_tpre(F, gcnt);
            pg8::MoeOrder S; S.A = (const char*)XS; S.Bt = (const char*)((const bf16*)(WSP + WS_WGU) + (size_t)l * NE * 1024 * 1024); S.tstep = (size_t)256 * 1024 * 2; S.estride = (size_t)1024 * 1024 * 2; S.G = F.G; S.c = F.blk;
            S.tp = F.MISC + 16;
            pg8::EpiGU E{ACT};
            pg8::gemm_phase<pg8::EpiGU, pg8::MoeOrder, true, true>(F.lds, 1024, S, E, F.tid);
        }
        SEAM(base + 7);
        if (EN_DN && IN(base + 8)) {
            compute_tpre(F, gcnt);
            pg8::MoeOrder S; S.A = (const char*)ACT; S.Bt = (const char*)((const bf16*)(WSP + WS_WDN) + (size_t)l * NE * 1024 * 512); S.tstep = (size_t)256 * 512 * 2; S.estride = (size_t)1024 * 512 * 2; S.G = F.G; S.c = F.blk;
            S.tp = F.MISC + 16;
            pg8::EpiDN E{YW, (const int*)(WSP + WS_SLOTI), (const float*)(WSP + WS_SLOTW)};
            pg8::gemm_phase<pg8::EpiDN, pg8::MoeOrder, true, true>(F.lds, 512, S, E, F.tid);
        }
        SEAM(base + 8);
    }
    if (EN_FIN && IN(NPHASE - 1)) norm_phase<2, false, true>(F, X, nullptr, YW, MOD + (size_t)3 * 8 * 6144 + 5120, (const float*)F.in[7], nullptr, nullptr, nullptr, args.out, nullptr);
#undef IN
#undef SEAM
#undef WSP
#undef MOD
#undef X
#undef HB
#undef R1Z
#undef DELTA
#undef XS
#undef ACT
#undef YW
#undef modl
#undef gcnt
}

extern "C" void kernel_launch(void* const* d_in, const int* in_sizes, int n_in, void* d_out, int out_size, void* d_ws, size_t ws_size, hipStream_t stream) {
    static int grid = 0;
    if (grid == 0) {
        if (n_in != 25 || in_sizes[0] != T * D || out_size != T * D || ws_size < WS_END) { fprintf(stderr, "kernel_launch: unexpected shapes / workspace (n_in %d, ws %zu); nothing launched\n", n_in, ws_size); grid = -1; return; }
        int dev = 0, cus = 0, per_cu = 0;
        if (hipGetDevice(&dev) != hipSuccess || hipDeviceGetAttribute(&cus, hipDeviceAttributeMultiprocessorCount, dev) != hipSuccess) { grid = -1; return; }
        if (hipFuncSetAttribute((const void*)fwd, hipFuncAttributeMaxDynamicSharedMemorySize, LDS_BYTES) != hipSuccess) { fprintf(stderr, "kernel_launch: hipFuncSetAttribute failed\n"); grid = -1; return; }
        if (hipOccupancyMaxActiveBlocksPerMultiprocessor(&per_cu, (const void*)fwd, NTHR, LDS_BYTES) != hipSuccess || per_cu < 1) { fprintf(stderr, "kernel_launch: occupancy query reports %d\n", per_cu); }
        (void)hipGetLastError();
        grid = cus;
    }
    if (grid < 0) return;
    if (hipMemsetAsync((char*)d_ws + WS_CTL, 0, CTL_ZERO_BYTES, stream) != hipSuccess) return;
    Args a{};
    for (int i = 0; i < 25; ++i) a.in[i] = d_in[i];
    a.out = (float*)d_out; a.ws = (unsigned char*)d_ws;
#if MK_ONE_LAUNCH
    a.ph_lo = 0; a.ph_hi = NPHASE;
    hipLaunchKernelGGL(fwd, dim3(grid), dim3(NTHR), LDS_BYTES, stream, a);
#else
    for (int p = 0; p < NPHASE; ++p) {
        if (p >= 1 && p < NPHASE - 1) { const int l = (p - 1) / 9, s = (p - 1) % 9; if ((l & 1) == 1 && s == 3) continue; }
        a.ph_lo = p; a.ph_hi = p + 1;
        hipLaunchKernelGGL(fwd, dim3(grid), dim3(NTHR), LDS_BYTES, stream, a);
    }
#endif
}
```

```cpp
#include <hip/hip_runtime.h>
#include <cstdio>
#include <cstdint>

#ifndef MK_ONE_LAUNCH
#define MK_ONE_LAUNCH 1
#endif

namespace pg8 {
#define PG8_LAS __attribute__((address_space(3)))
typedef unsigned short bf16_t;
typedef short bf16x8 __attribute__((ext_vector_type(8)));
typedef float f32x4 __attribute__((ext_vector_type(4)));
typedef unsigned u32x4 __attribute__((ext_vector_type(4)));
constexpr int BM = 256, BK = 64, HALF = 128, HTB = HALF * BK * 2  , STAGE_BYTES = 8 * HTB, NXCD = 8, WGM = 8;

__host__ __device__ __forceinline__ int lds_byte(int r, int c) { const int st = (r >> 4) * 2 + (c >> 5), rr = r & 15, cc = c & 31, ob = rr * 64 + cc * 2; return st * 1024 + (ob ^ (((ob >> 9) & 1) << 5)); }
__host__ __device__ __forceinline__ void stage_rc(int b, int& R, int& C) { const int st = b / 1024, sb = b % 1024, swz = sb ^ (((sb >> 9) & 1) << 5); R = (st >> 1) * 16 + swz / 64; C = (st & 1) * 32 + (swz % 64) / 2; }
__host__ __device__ __forceinline__ int perm32(int rho) { const int n = rho >> 4, i = rho & 15; return 8 * (i >> 2) + 4 * n + (i & 3); }

struct Unit { int pm, pn, e; };

struct StaticOrder {
    const char* A; const char* Bt; size_t tstep;
    int nM, nN, nwg, G, c;
    __device__ void init(const void* A_, const void* Bt_, int M, int N, int K, int G_, int c_) { A = (const char*)A_; Bt = (const char*)Bt_; tstep = (size_t)256 * K * 2; nM = M / BM; nN = N / BM; nwg = nM * nN; G = G_; c = c_; }
    __device__ bool next(int i, Unit& u) const {
        const long L = (long)i * G + c; if (L >= nwg) return false;
        int wgid = (int)L; { const int q = nwg / NXCD, r = nwg % NXCD, xcd = wgid % NXCD, off = wgid / NXCD; wgid = (xcd < r ? xcd * (q + 1) : r * (q + 1) + (xcd - r) * q) + off; }
        const int nig = WGM * nN, gid = wgid / nig, fm = gid * WGM, gsz = (nM - fm) < WGM ? (nM - fm) : WGM;
        u.pm = fm + ((wgid % nig) % gsz); u.pn = (wgid % nig) / gsz; u.e = 0; return true;
    }
    __device__ __forceinline__ const char* a_base(const Unit& u) const { return A + (size_t)u.pm * tstep; }
    __device__ __forceinline__ const char* b_base(const Unit& u) const { return Bt + (size_t)u.pn * tstep; }
    __device__ __forceinline__ void a_ready(const Unit&) const {}
    __device__ __forceinline__ void done(const Unit&) const {}
};
struct MoeOrder {
    const char* A; const char* Bt; size_t tstep, estride;
    const volatile PG8_LAS unsigned* tp; int G, c;
    __device__ bool next(int i, Unit& u) const {
        const int L = i * G + c; if (L >= (int)tp[16] * 4) return false;
        const int pt = L >> 2; int e = 0;
#pragma unroll
        for (int j = 1; j < 16; ++j) e += (pt >= (int)tp[j]) ? 1 : 0;
        e = __builtin_amdgcn_readfirstlane(e);
        u.pm = pt; u.pn = L & 3; u.e = e; return true;
    }
    __device__ __forceinline__ const char* a_base(const Unit& u) const { return A + (size_t)u.pm * tstep; }
    __device__ __forceinline__ const char* b_base(const Unit& u) const { return Bt + (size_t)u.e * estride + (size_t)u.pn * tstep; }
    __device__ __forceinline__ void a_ready(const Unit&) const {}
    __device__ __forceinline__ void done(const Unit&) const {}
};

__device__ __forceinline__ unsigned cvt_pk_bf16(float lo, float hi) { unsigned r; asm volatile("v_cvt_pk_bf16_f32 %0, %1, %2" : "=v"(r) : "v"(lo), "v"(hi)); return r; }
__device__ __forceinline__ u32x4 pack8(const f32x4 v0, const f32x4 v1) { u32x4 w; w.x = cvt_pk_bf16(v0[0], v0[1]); w.y = cvt_pk_bf16(v0[2], v0[3]); w.z = cvt_pk_bf16(v1[0], v1[1]); w.w = cvt_pk_bf16(v1[2], v1[3]); return w; }

struct EpiStore {
    static constexpr bool PERM = true, AFTER_DRAIN = false;
    bf16_t* O; int ldc;
    __device__ __forceinline__ void operator()(const f32x4 (&acc)[2][2][4][2], const Unit& u, int wr, int wc, int fr, int fq) const {
        const int row0 = u.pm * BM + wr * 64 + fr, col0 = u.pn * BM + wc * 32 + 8 * fq;
#pragma unroll
        for (int ai = 0; ai < 2; ++ai)
#pragma unroll
            for (int m = 0; m < 4; ++m) { bf16_t* rowp = O + (size_t)(row0 + ai * HALF + m * 16) * ldc + col0;
#pragma unroll
                for (int bj = 0; bj < 2; ++bj) *(u32x4*)(rowp + bj * HALF) = pack8(acc[ai][bj][m][0], acc[ai][bj][m][1]); }
    }
};
struct EpiQKV {
    static constexpr bool PERM = true, AFTER_DRAIN = false;
    bf16_t* O; const float* rot;
    __device__ __forceinline__ void operator()(const f32x4 (&acc)[2][2][4][2], const Unit& u, int wr, int wc, int fr, int fq) const {
        const int row0 = u.pm * BM + wr * 64 + fr, col0 = u.pn * BM + wc * 32 + 8 * fq;
        const bool rotw = (u.pn < 8) && ((wc & 1) == 0);
#pragma unroll
        for (int ai = 0; ai < 2; ++ai)
#pragma unroll
            for (int m = 0; m < 4; ++m) { const int row = row0 + ai * HALF + m * 16; bf16_t* rowp = O + (size_t)row * 3072 + col0;
                f32x4 cs[4];
                if (rotw) {
#pragma unroll
                    for (int q = 0; q < 4; ++q) cs[q] = *(const f32x4*)(rot + (size_t)row * 16 + q * 4); }
#pragma unroll
                for (int bj = 0; bj < 2; ++bj) { f32x4 v0 = acc[ai][bj][m][0], v1 = acc[ai][bj][m][1];
                    if (rotw) {
                        f32x4 p0, p1;
#pragma unroll
                        for (int j = 0; j < 4; ++j) { p0[j] = __shfl_xor(v0[j], 16); p1[j] = __shfl_xor(v1[j], 16); }
                        if (fq < 2) { const float sg = (fq == 0) ? -1.f : 1.f;
                            v0[0] = v0[0] * cs[0][0] + sg * p0[0] * cs[0][1]; v0[1] = v0[1] * cs[0][2] + sg * p0[1] * cs[0][3];
                            v0[2] = v0[2] * cs[1][0] + sg * p0[2] * cs[1][1]; v0[3] = v0[3] * cs[1][2] + sg * p0[3] * cs[1][3];
                            v1[0] = v1[0] * cs[2][0] + sg * p1[0] * cs[2][1]; v1[1] = v1[1] * cs[2][2] + sg * p1[1] * cs[2][3];
                            v1[2] = v1[2] * cs[3][0] + sg * p1[2] * cs[3][1]; v1[3] = v1[3] * cs[3][2] + sg * p1[3] * cs[3][3]; }
                    }
                    *(u32x4*)(rowp + bj * HALF) = pack8(v0, v1); } }
    }
};
struct EpiGU {
    static constexpr bool PERM = true, AFTER_DRAIN = false;
    bf16_t* O;
    __device__ __forceinline__ void operator()(const f32x4 (&acc)[2][2][4][2], const Unit& u, int wr, int wc, int fr, int fq) const {
        const int row0 = u.pm * BM + wr * 64 + fr, col0 = u.pn * 128 + wc * 32 + 8 * fq;
#pragma unroll
        for (int ai = 0; ai < 2; ++ai)
#pragma unroll
            for (int m = 0; m < 4; ++m) { bf16_t* rowp = O + (size_t)(row0 + ai * HALF + m * 16) * 512 + col0;
                f32x4 o[2];
#pragma unroll
                for (int n = 0; n < 2; ++n)
#pragma unroll
                    for (int j = 0; j < 4; ++j) { const float g = acc[ai][0][m][n][j], up = acc[ai][1][m][n][j]; o[n][j] = g / (1.f + __expf(-g)) * up; }
                *(u32x4*)rowp = pack8(o[0], o[1]); }
    }
};
struct EpiDN {
    static constexpr bool PERM = true, AFTER_DRAIN = false;
    bf16_t* O; const int* sloti; const float* slotw;
    __device__ __forceinline__ void operator()(const f32x4 (&acc)[2][2][4][2], const Unit& u, int wr, int wc, int fr, int fq) const {
        const int row0 = u.pm * BM + wr * 64 + fr, col0 = u.pn * BM + wc * 32 + 8 * fq;
#pragma unroll
        for (int ai = 0; ai < 2; ++ai)
#pragma unroll
            for (int m = 0; m < 4; ++m) { const int row = row0 + ai * HALF + m * 16; const int info = sloti[row]; const float w = slotw[row];
                if (info >= 0) { bf16_t* rowp = O + (size_t)info * 1024 + col0;
#pragma unroll
                    for (int bj = 0; bj < 2; ++bj) *(u32x4*)(rowp + bj * HALF) = pack8(acc[ai][bj][m][0] * w, acc[ai][bj][m][1] * w); } }
    }
};

template <class Epi, class Sched, bool ALIGN_EPI = false, bool SP2 = false>
__device__ __forceinline__ void gemm_phase(PG8_LAS unsigned char* lds, const int K, const Sched& S, const Epi& E, const int tid) {
    const int wid = __builtin_amdgcn_readfirstlane(tid >> 6), lane = tid & 63, wr = wid >> 2, wc = wid & 3, fr = lane & 15, fq = lane >> 4;
    const int nt = K / BK;
    unsigned voffA[2], voffB[2];
#pragma unroll
    for (int i = 0; i < 2; ++i) { int R, C; stage_rc(tid * 16 + i * 8192, R, C); const int Rb = Epi::PERM ? ((R & ~31) + perm32(R & 31)) : R;
        voffA[i] = (unsigned)(R * K + C) * 2u; voffB[i] = (unsigned)(Rb * K + C) * 2u; }
    const size_t kstep = (size_t)(BK * 2);
    const size_t hstep = (size_t)HALF * K * 2;
    const unsigned ldsw = (unsigned)wid * 1024u;
    const int aoff = lds_byte(wr * 64 + fr, fq * 8), boff = lds_byte(wc * 32 + fr, fq * 8);
#define PG8_SA(b, h) (((b) * 2 + (h)) * HTB)
#define PG8_SB(b, h) ((4 + (b) * 2 + (h)) * HTB)
#define PG8_STAGE(bufoff, gbase, voff) do { _Pragma("unroll") for (int _i = 0; _i < 2; ++_i) \
        __builtin_amdgcn_global_load_lds((const unsigned*)((const char*)(gbase) + (voff)[_i]), (PG8_LAS unsigned*)(lds + (bufoff) + ldsw + _i * 8192), 16, 0, 0); } while (0)
#define PG8_LDA(dst, b, h) do { _Pragma("unroll") for (int m = 0; m < 4; ++m) _Pragma("unroll") for (int k = 0; k < 2; ++k) dst[m][k] = *(const PG8_LAS bf16x8*)(lds + PG8_SA(b, h) + aoff + m * 2048 + k * 1024); } while (0)
#define PG8_LDB(dst, b, h) do { _Pragma("unroll") for (int n = 0; n < 2; ++n) _Pragma("unroll") for (int k = 0; k < 2; ++k) dst[n][k] = *(const PG8_LAS bf16x8*)(lds + PG8_SB(b, h) + boff + n * 2048 + k * 1024); } while (0)
#define PG8_MMA(ai, bj, At, Bt) do { __builtin_amdgcn_s_setprio(1); _Pragma("unroll") for (int m = 0; m < 4; ++m) _Pragma("unroll") for (int n = 0; n < 2; ++n) _Pragma("unroll") for (int k = 0; k < 2; ++k) \
        acc[ai][bj][m][n] = __builtin_amdgcn_mfma_f32_16x16x32_bf16(Bt[n][k], At[m][k], acc[ai][bj][m][n], 0, 0, 0); __builtin_amdgcn_s_setprio(0); } while (0)
#define PG8_WAIT_V(n) asm volatile("s_waitcnt vmcnt(" #n ")" ::: "memory")
#define PG8_WAIT_L(n) asm volatile("s_waitcnt lgkmcnt(" #n ")" ::: "memory")
#define PG8_BAR __builtin_amdgcn_s_barrier()
#define PG8_SCHED __builtin_amdgcn_sched_barrier(0)
    Unit cur, nxt; int ui = 0;
    if (!S.next(0, cur)) return;
    f32x4 acc[2][2][4][2];
#pragma unroll
    for (int a = 0; a < 2; ++a)
#pragma unroll
        for (int b = 0; b < 2; ++b)
#pragma unroll
            for (int m = 0; m < 4; ++m)
#pragma unroll
                for (int n = 0; n < 2; ++n) acc[a][b][m][n] = (f32x4){0.f, 0.f, 0.f, 0.f};
    bf16x8 At[4][2], B0[2][2], B1[2][2];
    const char* cA = S.a_base(cur); const char* cB = S.b_base(cur);
    S.a_ready(cur);
    if constexpr (SP2) {
        PG8_STAGE(PG8_SB(0, 0), cB, voffB); PG8_STAGE(PG8_SB(0, 1), cB + hstep, voffB); PG8_STAGE(PG8_SA(0, 0), cA, voffA); PG8_STAGE(PG8_SA(0, 1), cA + hstep, voffA);
        if (wr == 1) PG8_BAR;
        PG8_WAIT_V(2); PG8_BAR;
        PG8_STAGE(PG8_SB(1, 0), cB + kstep, voffB); PG8_STAGE(PG8_SA(1, 0), cA + kstep, voffA); PG8_STAGE(PG8_SB(1, 1), cB + hstep + kstep, voffB);
        PG8_WAIT_V(6); PG8_BAR;
    } else {
        PG8_STAGE(PG8_SB(0, 0), cB, voffB); PG8_STAGE(PG8_SA(0, 0), cA, voffA); PG8_STAGE(PG8_SB(0, 1), cB + hstep, voffB); PG8_STAGE(PG8_SA(0, 1), cA + hstep, voffA);
        if (wr == 1) PG8_BAR;
        PG8_WAIT_V(4); PG8_BAR;
        PG8_STAGE(PG8_SB(1, 0), cB + kstep, voffB); PG8_STAGE(PG8_SA(1, 0), cA + kstep, voffA); PG8_STAGE(PG8_SB(1, 1), cB + hstep + kstep, voffB);
        PG8_WAIT_V(6); PG8_BAR;
    }
    for (;;) {
        const bool has_next = S.next(ui + 1, nxt);
        const char* nA = has_next ? S.a_base(nxt) : cA; const char* nB = has_next ? S.b_base(nxt) : cB;
        for (int t = 0; t < nt; t += 2) {
            const bool last = (t == nt - 2);
            const char* a1 = cA + (size_t)(t + 1) * kstep;
            const char* a2 = last ? nA : cA + (size_t)(t + 2) * kstep; const char* b2 = last ? nB : cB + (size_t)(t + 2) * kstep;
            const char* a3 = a2 + kstep; const char* b3 = b2 + kstep;
            if (last && has_next) S.a_ready(nxt);
            if constexpr (SP2) {
            PG8_LDB(B0, 0, 0); PG8_LDB(B1, 0, 1); PG8_SCHED; PG8_LDA(At, 0, 0); PG8_STAGE(PG8_SA(1, 1), a1 + hstep, voffA);
            PG8_WAIT_V(8); PG8_WAIT_L(0); PG8_BAR; PG8_MMA(0, 0, At, B0); PG8_MMA(0, 1, At, B1); PG8_BAR; PG8_SCHED;
            PG8_LDA(At, 0, 1); PG8_STAGE(PG8_SB(0, 0), b2, voffB); PG8_STAGE(PG8_SB(0, 1), b2 + hstep, voffB); PG8_STAGE(PG8_SA(0, 0), a2, voffA);
            PG8_WAIT_V(8); PG8_WAIT_L(0); PG8_BAR; PG8_MMA(1, 0, At, B0); PG8_MMA(1, 1, At, B1); PG8_BAR; PG8_SCHED;
            PG8_LDB(B0, 1, 0); PG8_LDB(B1, 1, 1); PG8_SCHED; PG8_LDA(At, 1, 0); PG8_STAGE(PG8_SA(0, 1), a2 + hstep, voffA);
            PG8_WAIT_V(8); PG8_WAIT_L(0); PG8_BAR; PG8_MMA(0, 0, At, B0); PG8_MMA(0, 1, At, B1); PG8_BAR; PG8_SCHED;
            PG8_LDA(At, 1, 1); PG8_STAGE(PG8_SB(1, 0), b3, voffB); PG8_STAGE(PG8_SB(1, 1), b3 + hstep, voffB); PG8_STAGE(PG8_SA(1, 0), a3, voffA);
            PG8_WAIT_V(8); PG8_WAIT_L(0); PG8_BAR; PG8_MMA(1, 0, At, B0); PG8_MMA(1, 1, At, B1); PG8_BAR; PG8_SCHED;
            } else {
            PG8_LDB(B0, 0, 0); PG8_SCHED; PG8_LDA(At, 0, 0); PG8_STAGE(PG8_SA(1, 1), a1 + hstep, voffA);
            PG8_WAIT_L(8); PG8_BAR; PG8_WAIT_L(0); PG8_MMA(0, 0, At, B0); PG8_BAR; PG8_SCHED;
            PG8_LDB(B1, 0, 1); PG8_STAGE(PG8_SB(0, 0), b2, voffB);
            PG8_BAR; PG8_WAIT_L(0); PG8_MMA(0, 1, At, B1); PG8_BAR;
            PG8_LDA(At, 0, 1); PG8_STAGE(PG8_SA(0, 0), a2, voffA);
            PG8_BAR; PG8_WAIT_L(0); PG8_MMA(1, 0, At, B0); PG8_BAR; PG8_SCHED;
            PG8_STAGE(PG8_SB(0, 1), b2 + hstep, voffB);
            PG8_WAIT_V(6); PG8_BAR; PG8_MMA(1, 1, At, B1); PG8_BAR;
            PG8_LDB(B0, 1, 0); PG8_SCHED; PG8_LDA(At, 1, 0); PG8_STAGE(PG8_SA(0, 1), a2 + hstep, voffA);
            PG8_WAIT_L(8); PG8_BAR; PG8_WAIT_L(0); PG8_MMA(0, 0, At, B0); PG8_BAR; PG8_SCHED;
            PG8_LDB(B1, 1, 1); PG8_STAGE(PG8_SB(1, 0), b3, voffB);
            PG8_BAR; PG8_WAIT_L(0); PG8_MMA(0, 1, At, B1); PG8_BAR;
            PG8_LDA(At, 1, 1); PG8_STAGE(PG8_SA(1, 0), a3, voffA);
            PG8_BAR; PG8_WAIT_L(0); PG8_MMA(1, 0, At, B0); PG8_BAR; PG8_SCHED;
            PG8_STAGE(PG8_SB(1, 1), b3 + hstep, voffB);
            PG8_WAIT_V(6); PG8_BAR; PG8_MMA(1, 1, At, B1); PG8_BAR;
            }
        }
        if constexpr (ALIGN_EPI) { if (wr == 0) PG8_BAR; }
        if constexpr (!Epi::AFTER_DRAIN) { E(acc, cur, wr, wc, fr, fq); S.done(cur); }
        if (!has_next) break;
#pragma unroll
        for (int a = 0; a < 2; ++a)
#pragma unroll
            for (int b = 0; b < 2; ++b)
#pragma unroll
                for (int m = 0; m < 4; ++m)
#pragma unroll
                    for (int n = 0; n < 2; ++n) acc[a][b][m][n] = (f32x4){0.f, 0.f, 0.f, 0.f};
        cur = nxt; cA = nA; cB = nB; ++ui;
        if constexpr (ALIGN_EPI) { if (wr == 1) PG8_BAR; }
    }
    PG8_WAIT_V(0);
    if constexpr (!ALIGN_EPI) { if (wr == 0) PG8_BAR; }
    PG8_BAR;
    if constexpr (Epi::AFTER_DRAIN) { E.fused(acc, cur, wr, wc, fr, fq, lds, wid, lane); S.done(cur); }
#undef PG8_SA
#undef PG8_SB
#undef PG8_STAGE
#undef PG8_LDA
#undef PG8_LDB
#undef PG8_MMA
#undef PG8_WAIT_V
#undef PG8_WAIT_L
#undef PG8_BAR
#undef PG8_SCHED
}
}

constexpr int NB = 8, SEQ = 2048, T = NB * SEQ, D = 1024, DEPTH = 4;
constexpr int IN_AB = 2560, NQKV = 3072, NE = 16, FF = 512;
constexpr int MAXTILES = 144, MPAD = MAXTILES * 256;
constexpr int NWAVES = 8, NTHR = 512;

constexpr size_t MiB = 1u << 20;
constexpr size_t WS_CTL = 0, CTL_ZERO_BYTES = 1 * MiB;
constexpr int CW_TMO = 0, CW_BAR = 64, CW_CNT = 8192;
constexpr size_t WS_MOD = 1 * MiB;
constexpr size_t WS_ROT = 2 * MiB;
constexpr size_t WS_AGG = 3 * MiB;
constexpr size_t WS_LIST = 5 * MiB;
constexpr size_t WS_TOPW = 6 * MiB;
constexpr size_t WS_SLOTI = 6 * MiB + 512 * 1024;
constexpr size_t WS_SLOTW = 7 * MiB;
constexpr size_t WS_LRUW = 7 * MiB + 512 * 1024;
constexpr size_t WS_WIN = 8 * MiB;
constexpr size_t WS_WOUT = 18 * MiB;
constexpr size_t WS_WQKV = 22 * MiB;
constexpr size_t WS_WO = 34 * MiB;
constexpr size_t WS_WGU = 38 * MiB;
constexpr size_t WS_WDN = 166 * MiB;
constexpr size_t WS_X = 230 * MiB;
constexpr size_t WS_HB = 294 * MiB;
constexpr size_t WS_R1 = 326 * MiB;
constexpr size_t R1_Z = 0;
constexpr size_t R1_DELTA = 0;
constexpr size_t R1_XS = 0;
constexpr size_t R1_ACT = 72 * MiB;
constexpr size_t R1_YW = 108 * MiB;
constexpr size_t R1_AGG = 96 * MiB, R1_CARRY = 100 * MiB;
constexpr size_t WS_MCST = 6 * MiB + 256 * 1024;
constexpr size_t WS_END = 526 * MiB;

constexpr int RING_BYTES = 131072;
constexpr int MISC_OFF = RING_BYTES;
constexpr int ENT_OFF = RING_BYTES + 1024;
constexpr int LDS_BYTES = 147456 + 4096;

#define GAS __attribute__((address_space(1)))
#define LAS __attribute__((address_space(3)))
typedef unsigned short bf16;
typedef unsigned v4u __attribute__((ext_vector_type(4)));
typedef unsigned v2u __attribute__((ext_vector_type(2)));
typedef float f32x4 __attribute__((ext_vector_type(4)));
typedef float f32x2 __attribute__((ext_vector_type(2)));
#define RLX_AGENT __ATOMIC_RELAXED, __HIP_MEMORY_SCOPE_AGENT
#define LDS_WAIT() asm volatile("s_waitcnt lgkmcnt(0)" ::: "memory")
#define VM_WAIT() asm volatile("s_waitcnt vmcnt(0)" ::: "memory")
__device__ __forceinline__ unsigned f2bf(float f) { unsigned u = __builtin_bit_cast(unsigned, f); return (u + 0x7fffu + ((u >> 16) & 1u)) >> 16; }
__device__ __forceinline__ unsigned pk2(float lo, float hi) { return f2bf(lo) | (f2bf(hi) << 16); }
__device__ __forceinline__ float bf2f(unsigned short b) { return __builtin_bit_cast(float, (unsigned)b << 16); }
__device__ __forceinline__ float bflo(unsigned w) { return __builtin_bit_cast(float, w << 16); }
__device__ __forceinline__ float bfhi(unsigned w) { return __builtin_bit_cast(float, w & 0xffff0000u); }

#define XB_TMO      128
#define XB_XCNT(j)  (256  + 64 * (j))
#define XB_XSUB(j)  (1280 + 64 * (j))
#define XB_XGEN(j)  (2304 + 64 * (j))
#define XB_TOP      3328
#define XB_TOPGEN   3392
#define XCD_BAR_WORDS 3456
#define XB_SPIN_CAP (1u << 18)

__device__ __forceinline__ unsigned xb_ld(unsigned* p)              { return __hip_atomic_load(p, __ATOMIC_RELAXED, __HIP_MEMORY_SCOPE_AGENT); }
__device__ __forceinline__ unsigned xb_add(unsigned* p, unsigned v) { return __hip_atomic_fetch_add(p, v, __ATOMIC_RELAXED, __HIP_MEMORY_SCOPE_AGENT); }
__device__ __forceinline__ unsigned xb_xcc_id() { return (unsigned)__builtin_amdgcn_s_getreg((3 << 11) | 20) & 0xFu; }
#define XB_SPIN(cond, bar) do { unsigned _sp = 0; while (cond) { __builtin_amdgcn_s_sleep(1); \
    if ((++_sp & 255u) == 0u) { if (xb_ld(&(bar)[XB_TMO])) break; if (_sp > XB_SPIN_CAP) { atomicAdd(&(bar)[XB_TMO], 1u); break; } } } } while (0)

struct XcdBarrier {
    unsigned* bar; unsigned x;
    volatile LAS unsigned* st;
};

__device__ __forceinline__ XcdBarrier xcd_barrier_post(unsigned* bar, volatile LAS unsigned* st) {
    XcdBarrier b; b.bar = bar; b.x = xb_xcc_id(); b.st = st;
    if (threadIdx.x == 0) (void)xb_add(&bar[XB_XCNT(b.x)], 1u);
    return b;
}
__device__ __forceinline__ void xcd_barrier_complete(unsigned* bar, unsigned x, unsigned& nloc, unsigned& nx) {
    const unsigned G = gridDim.x * gridDim.y * gridDim.z;
    unsigned sum, cnt, mine, sp = 0u;
    for (;;) {
        sum = 0u; cnt = 0u; mine = 0u;
#pragma unroll
        for (unsigned j = 0; j < 16; ++j) { const unsigned c = xb_ld(&bar[XB_XCNT(j)]); sum += c; cnt += (c > 0u) ? 1u : 0u; mine = (j == x) ? c : mine; }
        if (sum == G) break;
        __builtin_amdgcn_s_sleep(1);
        if ((++sp & 255u) == 0u) { if (xb_ld(&bar[XB_TMO])) break; if (sp > XB_SPIN_CAP) { atomicAdd(&bar[XB_TMO], 1u); break; } }
    }
    nloc = mine > 0u ? mine : 1u; nx = cnt > 0u ? cnt : 1u;
}

__device__ __forceinline__ void xcd_barrier(const XcdBarrier& b) {
    asm volatile("s_waitcnt vmcnt(0)" ::: "memory");
    __syncthreads();
    if (threadIdx.x == 0) {
        unsigned* bar = b.bar;
        __builtin_amdgcn_s_waitcnt(0);
        unsigned nloc = b.st[0], nx = b.st[1];
        if (nloc == 0u) { xcd_barrier_complete(bar, b.x, nloc, nx); b.st[0] = nloc; b.st[1] = nx; }
        const unsigned old = xb_add(&bar[XB_XSUB(b.x)], 1u);
        const unsigned gen = old / nloc;
        if (old + 1u == (gen + 1u) * nloc) {
            __builtin_amdgcn_fence(__ATOMIC_RELEASE, "agent");
            asm volatile("s_waitcnt vmcnt(0)" ::: "memory");
            const unsigned og = xb_add(&bar[XB_TOP], 1u);
            const unsigned tg = og / nx;
            if (og + 1u == (tg + 1u) * nx) xb_add(&bar[XB_TOPGEN], 1u);
            else XB_SPIN(xb_ld(&bar[XB_TOPGEN]) == tg, bar);
            __builtin_amdgcn_fence(__ATOMIC_ACQUIRE, "agent");
            xb_add(&bar[XB_XGEN(b.x)], 1u);
            asm volatile("s_waitcnt vmcnt(0)" ::: "memory");
        } else {
            XB_SPIN(xb_ld(&bar[XB_XGEN(b.x)]) == gen, bar);
            __builtin_amdgcn_fence(__ATOMIC_ACQUIRE, "agent");
            asm volatile("s_waitcnt vmcnt(0)" ::: "memory");
        }
    }
    __syncthreads();
}


__device__ __forceinline__ float wave_sum(float v) {
#pragma unroll
    for (int o = 1; o < 64; o <<= 1) v += __shfl_xor(v, o);
    return v;
}
__device__ __forceinline__ float wave_max(float v) {
#pragma unroll
    for (int o = 1; o < 64; o <<= 1) v = fmaxf(v, __shfl_xor(v, o));
    return v;
}
typedef __bf16 bf16x2_t __attribute__((ext_vector_type(2)));
__device__ __forceinline__ unsigned cvtpk(float lo, float hi) { f32x2 v = {lo, hi}; bf16x2_t b = __builtin_convertvector(v, bf16x2_t); return __builtin_bit_cast(unsigned, b); }
__device__ __forceinline__ float sigmoidf_(float x) { return 1.f / (1.f + expf(-x)); }
__device__ __forceinline__ float gelu_tanh(float x) { const float u = 0.7978845608028654f * (x + 0.044715f * x * x * x); return 0.5f * x * (1.f + tanhf(u)); }
__device__ __forceinline__ void sincos_acc(float ang, float& c, float& s) {
    const double x = (double)ang, q = rint(x * 0.63661977236758134), r = x - q * 1.5707963267948966;
    const int qi = ((int)q) & 3; const float rf = (float)r, r2 = rf * rf;
    const float sp = rf * (1.f + r2 * (-1.6666667e-1f + r2 * (8.3333333e-3f + r2 * (-1.9841270e-4f + r2 * 2.7557319e-6f))));
    const float cp = 1.f + r2 * (-0.5f + r2 * (4.1666667e-2f + r2 * (-1.3888889e-3f + r2 * (2.4801587e-5f - r2 * 2.7557319e-7f))));
    c = (qi == 0) ? cp : (qi == 1) ? -sp : (qi == 2) ? -cp : sp;
    s = (qi == 0) ? sp : (qi == 1) ? cp : (qi == 2) ? -sp : -cp;
}

#define AS4 __attribute__((address_space(4)))
typedef const void* cvp_t;
struct Ctx {
    LAS unsigned char* lds; volatile LAS unsigned* MISC; LAS unsigned char* lds0;
    unsigned* ctl; unsigned char* ws;
    int tid, lane, wave, G, blk, lo, hi;
    const AS4 cvp_t* in;
};

__device__ __forceinline__ bool launder(Ctx& F) { int t = threadIdx.x; asm volatile("" : "+v"(t)); F.tid = t; F.lane = t & 63; F.wave = __builtin_amdgcn_readfirstlane(t >> 6);
    int z = 0; asm volatile("" : "+s"(z));
    const AS4 char* ka = (const AS4 char*)__builtin_amdgcn_kernarg_segment_ptr() + z;
    F.in = (const AS4 cvp_t*)ka; F.ws = *(unsigned char* const AS4*)(ka + 25 * 8 + 8); F.ctl = (unsigned*)(F.ws + WS_CTL);
    F.lds = F.lds0 + z; F.MISC = (volatile LAS unsigned*)(F.lds + MISC_OFF);
    F.G = (int)gridDim.x + z; F.blk = (int)blockIdx.x + z; F.lo = *(const AS4 int*)(ka + 25 * 8 + 16); F.hi = *(const AS4 int*)(ka + 25 * 8 + 20); return true; }

__device__ __forceinline__ void p0_transpose_item(const float* W, int K, int N, bf16* WT, int dstrow0, LAS float* scr, int k0, int n0, int lane) {
#pragma unroll 8
    for (int i = 0; i < 32; ++i) { const int kk = 2 * i + (lane >> 5); scr[kk * 33 + (lane & 31)] = W[(size_t)(k0 + kk) * N + n0 + (lane & 31)]; }
    LDS_WAIT(); asm volatile("" ::: "memory");
    const int c = lane & 7;
#pragma unroll
    for (int j = 0; j < 4; ++j) { const int n = (lane >> 3) + 8 * j; const LAS float* s = scr + (8 * c) * 33 + n;
        v4u o; o.x = pk2(s[0 * 33], s[1 * 33]); o.y = pk2(s[2 * 33], s[3 * 33]); o.z = pk2(s[4 * 33], s[5 * 33]); o.w = pk2(s[6 * 33], s[7 * 33]);
        *(GAS v4u*)(WT + (size_t)(dstrow0 + n) * K + k0 + 8 * c) = o; }
    LDS_WAIT(); asm volatile("" ::: "memory");
}
__device__ __forceinline__ void p0_prologue(const Ctx& F) {
    const float* c_in = (const float*)F.in[1]; const int* pos_in = (const int*)F.in[2];
    const float* mod_w = (const float*)F.in[3]; const float* mod_b = (const float*)F.in[4];
    {
        LAS float* cs_s = (LAS float*)F.lds;
        LAS float* red = (LAS float*)(F.lds + 32768);
        for (int i = F.tid; i < 8192; i += NTHR) { const int b = i >> 10, k = i & 1023; const float v = c_in[i]; cs_s[k * 8 + b] = v / (1.f + expf(-v)); }
        __syncthreads();
        float* MOD = (float*)(F.ws + WS_MOD);
        const int kq = F.tid >> 6, col = F.tid & 63;
        for (int it = F.blk; it < 4 * 96; it += F.G) {
            const int l = it / 96, nb = it % 96;
            float acc[8];
#pragma unroll
            for (int b = 0; b < 8; ++b) acc[b] = 0.f;
            const float* wp = mod_w + ((size_t)l * 1024 + kq * 128) * 6144 + nb * 64 + col;
#pragma unroll 8
            for (int k = 0; k < 128; ++k) { const float w = wp[(size_t)k * 6144];
                const f32x4 c0 = *(const LAS f32x4*)(cs_s + (kq * 128 + k) * 8), c1 = *(const LAS f32x4*)(cs_s + (kq * 128 + k) * 8 + 4);
                acc[0] += c0[0] * w; acc[1] += c0[1] * w; acc[2] += c0[2] * w; acc[3] += c0[3] * w; acc[4] += c1[0] * w; acc[5] += c1[1] * w; acc[6] += c1[2] * w; acc[7] += c1[3] * w; }
#pragma unroll
            for (int b = 0; b < 8; ++b) red[(kq * 8 + b) * 64 + col] = acc[b];
            __syncthreads();
            { const int b = F.tid >> 6; float s = mod_b[l * 6144 + nb * 64 + col];
#pragma unroll
              for (int q = 0; q < 8; ++q) s += red[(q * 8 + b) * 64 + col];
              MOD[((size_t)l * 8 + b) * 6144 + nb * 64 + col] = s; }
            __syncthreads();
        }
    }
    {
        float* ROT = (float*)(F.ws + WS_ROT);
        for (int idx = F.blk * NTHR + F.tid; idx < T * 8; idx += F.G * NTHR) { const int row = idx >> 3, i = idx & 7;
            const float invf = exp2f(-(float)i * (18.931568569324174f / 8.0f));
            const float ang = (float)pos_in[row] * invf; float c, s; sincos_acc(ang, c, s);
            *(f32x2*)(ROT + (size_t)idx * 2) = (f32x2){c, s}; }
    }
    {
        bf16* WG = (bf16*)(F.ws + WS_LRUW);
        for (int idx = F.blk * NTHR + F.tid; idx < 2 * 2 * 2 * 8 * 4096; idx += F.G * NTHR) { const int jj = idx & 7, hq = (idx >> 3) & 1, s = (idx >> 4) & 3, out = (idx >> 6) & 63, hd = (idx >> 12) & 7, dr = (idx >> 15) & 1, ty = (idx >> 16) & 1, jl = idx >> 17;
            const int in_ = 16 * s + 8 * (jj >> 2) + 4 * hq + (jj & 3);
            const float* src = (const float*)F.in[ty ? 14 : 12]; WG[idx] = (bf16)f2bf(src[((size_t)((jl * 2 + dr) * 8 + hd) * 64 + in_) * 64 + out]); }
        float* MC = (float*)(F.ws + WS_MCST);
        for (int idx = F.blk * NTHR + F.tid; idx < 2 * 2 * 3 * 512; idx += F.G * NTHR) { const int cc = idx & 511, k = (idx >> 9) % 3, jd = idx / 1536;
            const float* src = (const float*)F.in[k == 0 ? 13 : (k == 1 ? 15 : 16)]; float v = src[jd * 512 + cc]; if (k == 2) v = log1pf(expf(-v)); MC[idx] = v; }
    }
    {
        LAS float* scr = (LAS float*)(F.lds + F.wave * 16384);
        const int gw = F.blk * NWAVES + F.wave, NGW = F.G * NWAVES;
        constexpr int I_IN = 2 * 16 * 80, I_OUT = 2 * 16 * 32, I_QKV = 2 * 16 * 96, I_O = 2 * 16 * 32, I_G = 64 * 256, I_U = 64 * 256, I_D = 64 * 256;
        constexpr int NITEMS = I_IN + I_OUT + I_QKV + I_O + I_G + I_U + I_D;
        for (int it = gw; it < NITEMS; it += NGW) {
            int r = it;
            if (r < I_IN) { const int mt = r / 1280, q = r % 1280, kb = q / 80, nb = q % 80;
                p0_transpose_item((const float*)F.in[8] + (size_t)mt * 1024 * 2560, 1024, 2560, (bf16*)(F.ws + WS_WIN) + (size_t)mt * 2560 * 1024, nb * 32, scr, kb * 64, nb * 32, F.lane); continue; } r -= I_IN;
            if (r < I_OUT) { const int mt = r / 512, q = r % 512, kb = q / 32, nb = q % 32;
                p0_transpose_item((const float*)F.in[17] + (size_t)mt * 1024 * 1024, 1024, 1024, (bf16*)(F.ws + WS_WOUT) + (size_t)mt * 1024 * 1024, nb * 32, scr, kb * 64, nb * 32, F.lane); continue; } r -= I_OUT;
            if (r < I_QKV) { const int mt = r / 1536, q = r % 1536, kb = q / 96, nb = q % 96;
                p0_transpose_item((const float*)F.in[18] + (size_t)mt * 1024 * 3072, 1024, 3072, (bf16*)(F.ws + WS_WQKV) + (size_t)mt * 3072 * 1024, nb * 32, scr, kb * 64, nb * 32, F.lane); continue; } r -= I_QKV;
            if (r < I_O) { const int mt = r / 512, q = r % 512, kb = q / 32, nb = q % 32;
                p0_transpose_item((const float*)F.in[19] + (size_t)mt * 1024 * 1024, 1024, 1024, (bf16*)(F.ws + WS_WO) + (size_t)mt * 1024 * 1024, nb * 32, scr, kb * 64, nb * 32, F.lane); continue; } r -= I_O;
            if (r < I_G + I_U) { const int up = (r >= I_G) ? 1 : 0; r -= up * I_G; const int mt = r / 256, q = r % 256, kb = q / 16, nb = q % 16, n0 = nb * 32;
                p0_transpose_item((const float*)F.in[22 + up] + (size_t)mt * 1024 * 512, 1024, 512, (bf16*)(F.ws + WS_WGU) + (size_t)mt * 1024 * 1024, (n0 >> 7) * 256 + (n0 & 127) + up * 128, scr, kb * 64, n0, F.lane); continue; } r -= I_G + I_U;
            { const int mt = r / 256, q = r % 256, kb = q / 32, nb = q % 32;
                p0_transpose_item((const float*)F.in[24] + (size_t)mt * 512 * 1024, 512, 1024, (bf16*)(F.ws + WS_WDN) + (size_t)mt * 1024 * 512, nb * 32, scr, kb * 64, nb * 32, F.lane); }
        }
    }
}

template <int NDELTA, bool ROUTE, bool FINAL>
__device__ __forceinline__ void norm_phase(const Ctx& F, const float* xin, float* xout, const bf16* delta, const float* gate, const float* gvec, const float* shift, const float* scale,
                                           bf16* hout, float* fout, unsigned* gcnt) {
    LAS float* rw_s = (LAS float*)F.lds;
    volatile LAS unsigned* lcnt = F.MISC + 40; volatile LAS unsigned* lbase = F.MISC + 56; volatile LAS unsigned* nent = F.MISC + 72;
    LAS unsigned* ent = (LAS unsigned*)(F.lds + ENT_OFF);
    if (ROUTE) {
        const float* rw = (const float*)F.in[20];
        for (int i = F.tid; i < 16384; i += NTHR) { const int k = i >> 4, e = i & 15; rw_s[e * 1024 + k] = rw[i]; }
        if (F.tid < 16) lcnt[F.tid] = 0u; if (F.tid == 16) nent[0] = 0u;
        __syncthreads();
    }
    const float* rbias = (const float*)F.in[21];
    const int ngrp = T / NWAVES;
    for (int rg = F.blk; rg < ngrp; rg += F.G) {
        const int row = rg * NWAVES + F.wave, b = row >> 11;
        f32x4 v[4]; float ss = 0.f;
#pragma unroll
        for (int j = 0; j < 4; ++j) { const int col = 4 * F.lane + 256 * j;
            v[j] = *(const f32x4*)(xin + (size_t)row * D + col);
            if (NDELTA >= 1) {
                const f32x4 g4 = *(const f32x4*)(gate + (size_t)b * 6144 + col);
                f32x4 dl;
                if (NDELTA == 1) { const v2u w = *(const v2u*)(delta + (size_t)row * D + col); dl = (f32x4){bflo(w.x), bfhi(w.x), bflo(w.y), bfhi(w.y)}; }
                else { const v2u w0 = *(const v2u*)(delta + (size_t)row * 2 * D + col), w1 = *(const v2u*)(delta + (size_t)row * 2 * D + D + col);
                    dl = (f32x4){bflo(w0.x) + bflo(w1.x), bfhi(w0.x) + bfhi(w1.x), bflo(w0.y) + bflo(w1.y), bfhi(w0.y) + bfhi(w1.y)}; }
                v[j] = v[j] + g4 * dl;
            }
            if (!FINAL) *(f32x4*)(xout + (size_t)row * D + col) = v[j];
            ss += (v[j][0] * v[j][0] + v[j][1] * v[j][1]) + (v[j][2] * v[j][2] + v[j][3] * v[j][3]);
        }
        ss = wave_sum(ss);
        const float rstd = 1.0f / sqrtf(ss * (1.0f / D) + 1e-6f);
#pragma unroll
        for (int j = 0; j < 4; ++j) { const int col = 4 * F.lane + 256 * j;
            const f32x4 g4 = *(const f32x4*)(gvec + col);
            f32x4 y = v[j] * rstd * g4;
            if (FINAL) { *(f32x4*)(fout + (size_t)row * D + col) = y; }
            else { const f32x4 sc = *(const f32x4*)(scale + (size_t)b * 6144 + col), sh = *(const f32x4*)(shift + (size_t)b * 6144 + col);
                y = y * (1.0f + sc) + sh; v[j] = y;
                v2u w; w.x = pk2(y[0], y[1]); w.y = pk2(y[2], y[3]); *(v2u*)(hout + (size_t)row * D + col) = w; }
        }
        if (ROUTE) {
            float lg[16];
#pragma unroll
            for (int e = 0; e < 16; ++e) { float a = 0.f;
#pragma unroll
                for (int j = 0; j < 4; ++j) { const f32x4 w = *(const LAS f32x4*)(rw_s + e * 1024 + 256 * j + 4 * F.lane); a += (v[j][0] * w[0] + v[j][1] * w[1]) + (v[j][2] * w[2] + v[j][3] * w[3]); }
                lg[e] = wave_sum(a); }
            float sc[16], bi[16];
#pragma unroll
            for (int e = 0; e < 16; ++e) { sc[e] = sigmoidf_(lg[e]); bi[e] = sc[e] + rbias[e]; }
            float bestgs = -1e30f, s1 = 0.f, s2 = 0.f; int e1 = 0, e2 = 1;
#pragma unroll
            for (int g = 0; g < 4; ++g) {
                float m1 = bi[4 * g], t1 = sc[4 * g]; int i1 = 0;
#pragma unroll
                for (int k = 1; k < 4; ++k) if (bi[4 * g + k] > m1) { m1 = bi[4 * g + k]; t1 = sc[4 * g + k]; i1 = k; }
                float m2 = -1e30f, t2 = 0.f; int i2 = 0;
#pragma unroll
                for (int k = 0; k < 4; ++k) if (k != i1 && bi[4 * g + k] > m2) { m2 = bi[4 * g + k]; t2 = sc[4 * g + k]; i2 = k; }
                const float gs = m1 + m2;
                if (gs > bestgs) { bestgs = gs; e1 = 4 * g + i1; e2 = 4 * g + i2; s1 = t1; s2 = t2; }
            }
            if (F.lane == 0) {
                const float inv = 1.0f / (s1 + s2);
                float* topw = (float*)(F.ws + WS_TOPW);
                topw[row * 2] = s1 * inv; topw[row * 2 + 1] = s2 * inv;
                const unsigned p1 = __hip_atomic_fetch_add((LAS unsigned*)&lcnt[e1], 1u, __ATOMIC_RELAXED, __HIP_MEMORY_SCOPE_WORKGROUP), p2 = __hip_atomic_fetch_add((LAS unsigned*)&lcnt[e2], 1u, __ATOMIC_RELAXED, __HIP_MEMORY_SCOPE_WORKGROUP), n = __hip_atomic_fetch_add((LAS unsigned*)&nent[0], 2u, __ATOMIC_RELAXED, __HIP_MEMORY_SCOPE_WORKGROUP);
                ent[2 * n] = ((unsigned)e1 << 16) | p1; ent[2 * n + 1] = (unsigned)(row * 2);
                ent[2 * n + 2] = ((unsigned)e2 << 16) | p2; ent[2 * n + 3] = (unsigned)(row * 2 + 1);
            }
        }
    }
    if (ROUTE) {
        __syncthreads();
        if (F.tid < 16) lbase[F.tid] = __hip_atomic_fetch_add(gcnt + F.tid, lcnt[F.tid], RLX_AGENT);
        __syncthreads();
        int* list = (int*)(F.ws + WS_LIST); const unsigned n = nent[0];
        for (unsigned i = F.tid; i < n; i += NTHR) { const unsigned key = ent[2 * i], val = ent[2 * i + 1], e = key >> 16, p = key & 0xffffu; list[(size_t)e * T + lbase[e] + p] = (int)val; }
        __syncthreads();
    }
}

__device__ __forceinline__ void compute_tpre(const Ctx& F, unsigned* gcnt) {
    if (F.tid < 16) F.MISC[40 + F.tid] = __hip_atomic_load(gcnt + F.tid, RLX_AGENT);
    __syncthreads();
    if (F.tid == 0) { unsigned acc = 0;
        for (int e = 0; e < 16; ++e) { F.MISC[16 + e] = acc; acc += (F.MISC[40 + e] + 255u) >> 8; }
        F.MISC[32] = acc; }
    __syncthreads();
}
__device__ __forceinline__ void dispatch_phase(const Ctx& F, unsigned* gcnt) {
    compute_tpre(F, gcnt);
    const int gw = F.blk * NWAVES + F.wave, NGW = F.G * NWAVES;
    const int nrows = (int)F.MISC[32] * 256;
    const bf16* H = (const bf16*)(F.ws + WS_HB); bf16* XS = (bf16*)(F.ws + WS_R1 + R1_XS);
    const int* list = (const int*)(F.ws + WS_LIST); const float* topw = (const float*)(F.ws + WS_TOPW);
    int* sloti = (int*)(F.ws + WS_SLOTI); float* slotw = (float*)(F.ws + WS_SLOTW);
    for (int r = gw; r < nrows; r += NGW) {
        const int pt = r >> 8; int e = 0;
#pragma unroll
        for (int j = 1; j < 16; ++j) e += (pt >= (int)F.MISC[16 + j]) ? 1 : 0;
        const int pos = r - (int)F.MISC[16 + e] * 256, cnt = (int)F.MISC[40 + e];
        v4u a = (v4u){0u, 0u, 0u, 0u}, bq = a; int info = -1; float w = 0.f;
        if (pos < cnt) { info = list[(size_t)e * T + pos]; w = topw[info];
            const v4u* src = (const v4u*)(H + (size_t)(info >> 1) * D); a = src[F.lane]; bq = src[64 + F.lane]; }
        v4u* dst = (v4u*)(XS + (size_t)r * D); dst[F.lane] = a; dst[64 + F.lane] = bq;
        if (F.lane == 0) { sloti[r] = info; slotw[r] = w; }
    }
}

typedef short mx_bf16x8 __attribute__((ext_vector_type(8)));
typedef float mx_f32x16 __attribute__((ext_vector_type(16)));
__device__ __forceinline__ float fgelu_tanh(float x);
__device__ __forceinline__ float fsigmoid(float x) { return __builtin_amdgcn_rcpf(1.f + __builtin_amdgcn_exp2f(-1.4426950408889634f * x)); }
__device__ __forceinline__ float fgelu_tanh(float x) { return x * fsigmoid(1.5957691216057308f * x * (1.0f + 0.044715f * x * x)); }
template <int CTRL> __device__ __forceinline__ float dpp_f(float old, float src) { return __builtin_bit_cast(float, __builtin_amdgcn_update_dpp(__builtin_bit_cast(int, old), __builtin_bit_cast(int, src), CTRL, 0xF, 0xF, false)); }
template <int PAT> __device__ __forceinline__ float swz_f(float v) { return __builtin_bit_cast(float, __builtin_amdgcn_ds_swizzle(__builtin_bit_cast(int, v), PAT)); }
template <int CTRL> __device__ __forceinline__ void scan_step(float (&a)[16], float (&b)[16]) {
#pragma unroll
    for (int i = 0; i < 16; ++i) { const float ap = dpp_f<CTRL>(1.0f, a[i]), bp = dpp_f<CTRL>(0.0f, b[i]); b[i] = a[i] * bp + b[i]; a[i] = a[i] * ap; }
}
template <bool OUT>
__device__ __forceinline__ void mix_phase(const Ctx& F, int jl) {
    const char* Zc = (const char*)(F.ws + WS_R1 + R1_Z); char* Yc = (char*)(F.ws + WS_HB);
    f32x2* AGG = (f32x2*)(F.ws + WS_R1 + R1_AGG); const float* CARRY = (const float*)(F.ws + WS_R1 + R1_CARRY);
    const bf16* WG = (const bf16*)(F.ws + WS_LRUW) + (size_t)jl * 2 * 2 * 8 * 4096;
    const float* MC = (const float*)(F.ws + WS_MCST) + (size_t)jl * 2 * 3 * 512;
    const float* conv_a_w = (const float*)F.in[9] + (size_t)jl * 3 * 512; const float* conv_b_w = (const float*)F.in[10] + (size_t)jl * 4 * 512; const float* conv_b_b = (const float*)F.in[11] + (size_t)jl * 512;
    const int lane = F.lane, r32 = lane & 31, hh = lane >> 5;
    const int gw = F.blk * NWAVES + F.wave, NGW = F.G * NWAVES;
    for (int wu = gw; wu < 8 * 64 * 8; wu += NGW) {
        const int h = wu & 7, c = (wu >> 3) & 63, b = wu >> 9, t0 = c * 32, t = t0 + r32, rbi = b * SEQ;
        float xr[2][16];
#pragma unroll
        for (int g = 0; g < 2; ++g) {
            __builtin_amdgcn_sched_barrier(0);
#pragma unroll
            for (int q = 0; q < 4; ++q) { const int chq = h * 64 + 32 * g + 8 * q + 4 * hh;
                f32x4 a4 = *(const f32x4*)(conv_b_b + chq);
#pragma unroll
                for (int k = 0; k < 4; ++k) { const int ts = t + k - 1; const bool ok = ts >= 0 && ts < SEQ; const int tc = ok ? ts : t;
                    const v2u w = *(const v2u*)(Zc + ((unsigned)(rbi + tc) * IN_AB + 2048u + chq) * 2u); f32x4 w4 = *(const f32x4*)(conv_b_w + k * 512 + chq);
                    if (!ok) w4 = (f32x4){0.f, 0.f, 0.f, 0.f};
                    a4 = a4 + w4 * (f32x4){bflo(w.x), bfhi(w.x), bflo(w.y), bfhi(w.y)}; }
                xr[g][4 * q] = a4[0]; xr[g][4 * q + 1] = a4[1]; xr[g][4 * q + 2] = a4[2]; xr[g][4 * q + 3] = a4[3]; } }
        __builtin_amdgcn_sched_barrier(0);
        mx_bf16x8 xb[4];
#pragma unroll
        for (int s = 0; s < 4; ++s) { const int g = s >> 1, o = 8 * (s & 1); v4u p; p.x = cvtpk(xr[g][o], xr[g][o + 1]); p.y = cvtpk(xr[g][o + 2], xr[g][o + 3]); p.z = cvtpk(xr[g][o + 4], xr[g][o + 5]); p.w = cvtpk(xr[g][o + 6], xr[g][o + 7]);
            xb[s] = __builtin_bit_cast(mx_bf16x8, p); }
#pragma nounroll
        for (int mt = 0; mt < 2; ++mt) {
            float hrec[16];
#pragma unroll
            for (int i = 0; i < 16; ++i) hrec[i] = 0.f;
            const v4u pa = mt ? __builtin_bit_cast(v4u, xb[2]) : __builtin_bit_cast(v4u, xb[0]), pb = mt ? __builtin_bit_cast(v4u, xb[3]) : __builtin_bit_cast(v4u, xb[1]);
#pragma unroll
            for (int dir = 0; dir < 2; ++dir) {
                __builtin_amdgcn_sched_barrier(0);
                mx_f32x16 accr, acci;
#pragma unroll
                for (int i = 0; i < 16; ++i) { accr[i] = 0.f; acci[i] = 0.f; }
                const unsigned wro = ((unsigned)(((0 * 2 + dir) * 8 + h) * 64 + 32 * mt + r32) * 64u + 8u * hh) * 2u, wxo = wro + 2u * 8u * 4096u * 2u;
#pragma unroll
                for (int s = 0; s < 4; ++s) { const mx_bf16x8 ar = *(const mx_bf16x8*)((const char*)WG + wro + 32u * s), ax = *(const mx_bf16x8*)((const char*)WG + wxo + 32u * s);
                    accr = __builtin_amdgcn_mfma_f32_32x32x16_bf16(ar, xb[s], accr, 0, 0, 0); acci = __builtin_amdgcn_mfma_f32_32x32x16_bf16(ax, xb[s], acci, 0, 0, 0); }
                float av[16], bv[16];
#pragma unroll
                for (int q = 0; q < 4; ++q) { const int cl = h * 64 + 32 * mt + 8 * q + 4 * hh;
                    const f32x4 ba = *(const f32x4*)(MC + (dir * 3 + 0) * 512 + cl), bx = *(const f32x4*)(MC + (dir * 3 + 1) * 512 + cl), sp = *(const f32x4*)(MC + (dir * 3 + 2) * 512 + cl);
#pragma unroll
                    for (int e = 0; e < 4; ++e) { const int i = 4 * q + e;
                        const float r = fsigmoid(accr[i] + ba[e]), ig = fsigmoid(acci[i] + bx[e]);
                        const float a = __builtin_amdgcn_exp2f(-8.0f * 1.4426950408889634f * r * sp[e]);
                        const unsigned xw = (i < 8) ? pa[(i & 7) >> 1] : pb[(i & 7) >> 1];
                        av[i] = a; bv[i] = ((i & 1) ? bfhi(xw) : bflo(xw)) * ig * __builtin_amdgcn_sqrtf(fmaxf(1.0f - a * a, 0.f)); } }
                if (dir == 0) { scan_step<0x111>(av, bv); scan_step<0x112>(av, bv); scan_step<0x114>(av, bv); scan_step<0x118>(av, bv);
#pragma unroll
                    for (int i = 0; i < 16; ++i) { const float ap = swz_f<0x1E0>(av[i]), bp = swz_f<0x1E0>(bv[i]); if (r32 >= 16) { bv[i] = av[i] * bp + bv[i]; av[i] = av[i] * ap; } } }
                else { scan_step<0x101>(av, bv); scan_step<0x102>(av, bv); scan_step<0x104>(av, bv); scan_step<0x108>(av, bv);
#pragma unroll
                    for (int i = 0; i < 16; ++i) { const float ap = swz_f<0x200>(av[i]), bp = swz_f<0x200>(bv[i]); if (r32 < 16) { bv[i] = av[i] * bp + bv[i]; av[i] = av[i] * ap; } } }
                const unsigned gb = ((unsigned)(b * 2 + dir) * 64u + c) * 512u + h * 64 + 32 * mt + 4 * hh;
                if (!OUT) {
                    if (r32 == (dir ? 0 : 31)) {
#pragma unroll
                        for (int i = 0; i < 16; ++i) *(f32x2*)((char*)AGG + (gb + (i & 3) + 8 * (i >> 2)) * 8u) = (f32x2){av[i], bv[i]}; }
                } else {
#pragma unroll
                    for (int q = 0; q < 4; ++q) { const f32x4 cin = *(const f32x4*)((const char*)CARRY + (gb + 8 * q) * 4u);
#pragma unroll
                        for (int e = 0; e < 4; ++e) hrec[4 * q + e] += av[4 * q + e] * cin[e] + bv[4 * q + e]; }
                }
            }
            __builtin_amdgcn_sched_barrier(0);
            if (OUT) {
#pragma unroll
                for (int q = 0; q < 4; ++q) { const int chq = h * 64 + 32 * mt + 8 * q + 4 * hh;
                    const v2u w = *(const v2u*)(Zc + ((unsigned)(rbi + t) * IN_AB + 1536u + chq) * 2u);
                    v2u o; o.x = cvtpk(fgelu_tanh(bflo(w.x)) * hrec[4 * q], fgelu_tanh(bfhi(w.x)) * hrec[4 * q + 1]); o.y = cvtpk(fgelu_tanh(bflo(w.y)) * hrec[4 * q + 2], fgelu_tanh(bfhi(w.y)) * hrec[4 * q + 3]);
                    *(v2u*)(Yc + ((unsigned)(rbi + t) * D + 512u + chq) * 2u) = o; }
            }
        }
        if (!OUT) {
            const int ch = h * 64 + lane; const unsigned zl = (unsigned)ch * 2u;
            float wA[3];
#pragma unroll
            for (int k = 0; k < 3; ++k) wA[k] = conv_a_w[k * 512 + ch];
            float prod[34];
#pragma unroll
            for (int u = 0; u < 34; ++u) { const int ts = t0 + u - 1; const bool ok = ts >= 0 && ts < SEQ; const int tc = ok ? ts : t0; const unsigned zk = zl + (unsigned)(rbi + tc) * (IN_AB * 2u);
                const float p = bf2f(*(const bf16*)(Zc + zk + 2048u)) * bf2f(*(const bf16*)(Zc + zk)); prod[u] = ok ? p : 0.f; }
#pragma unroll
            for (int u = 0; u < 32; ++u) { const unsigned zr = zl + (unsigned)(rbi + t0 + u) * (IN_AB * 2u);
                const float ya = bf2f(*(const bf16*)(Zc + zr + 1024u)) * (wA[0] * prod[u] + wA[1] * prod[u + 1] + wA[2] * prod[u + 2]);
                *(bf16*)(Yc + ((unsigned)(rbi + t0 + u) * D + ch) * 2u) = (bf16)f2bf(ya); }
        }
    }
}
__device__ __forceinline__ void carry_phase(const Ctx& F) {
    const f32x2* AGG = (const f32x2*)(F.ws + WS_R1 + R1_AGG); float* CARRY = (float*)(F.ws + WS_R1 + R1_CARRY);
    const int gw = F.blk * NWAVES + F.wave, NGW = F.G * NWAVES;
    for (int item = gw; item < 128; item += NGW) { const int bd = item >> 3, ch = (item & 7) * 64 + F.lane, dir = bd & 1;
        f32x2 pg[64];
#pragma unroll
        for (int cc = 0; cc < 64; ++cc) pg[cc] = AGG[((size_t)bd * 64 + cc) * 512 + ch];
        float hsv = 0.f;
        if (dir == 0) {
#pragma unroll
            for (int cc = 0; cc < 64; ++cc) { CARRY[((size_t)bd * 64 + cc) * 512 + ch] = hsv; hsv = pg[cc].x * hsv + pg[cc].y; } }
        else {
#pragma unroll
            for (int cc = 63; cc >= 0; --cc) { CARRY[((size_t)bd * 64 + cc) * 512 + ch] = hsv; hsv = pg[cc].x * hsv + pg[cc].y; } }
    }
}

__device__ __forceinline__ void attn_naive_phase(const Ctx& F) {
    const bf16* QKV = (const bf16*)(F.ws + WS_R1 + R1_Z); bf16* Y = (bf16*)(F.ws + WS_HB);
    LAS float* qs = (LAS float*)(F.lds + F.wave * 4096);
    LAS float* ps = qs + 64;
    const int gw = F.blk * NWAVES + F.wave, NGW = F.G * NWAVES;
    for (int unit = gw; unit < T * 16; unit += NGW) {
        const int row = unit >> 4, hd = unit & 15, b = row >> 11, t = row & 2047; const size_t rb = (size_t)b * SEQ;
        qs[F.lane] = bf2f(QKV[(size_t)row * NQKV + hd * 64 + F.lane]) * 0.125f;
        LDS_WAIT(); asm volatile("" ::: "memory");
        float sc[7]; float mx = -1e30f;
#pragma unroll
        for (int i = 0; i < 7; ++i) { const int n = F.lane + 64 * i, p = n / 129, jj = n - p * 129 - 64, dd = (p == 0) ? 1 : (p == 1) ? 4 : 16, tk = t + dd * jj;
            const bool valid = (n < 387) && tk >= 0 && tk < SEQ; float dot = -1e30f;
            if (valid) { const v4u* kp = (const v4u*)(QKV + (rb + tk) * NQKV + 1024 + hd * 64); dot = 0.f;
#pragma unroll
                for (int q = 0; q < 8; ++q) { const v4u w = kp[q]; const LAS float* qq = qs + q * 8;
                    dot += qq[0] * bflo(w.x) + qq[1] * bfhi(w.x) + qq[2] * bflo(w.y) + qq[3] * bfhi(w.y) + qq[4] * bflo(w.z) + qq[5] * bfhi(w.z) + qq[6] * bflo(w.w) + qq[7] * bfhi(w.w); } }
            sc[i] = dot; mx = fmaxf(mx, dot); }
        mx = wave_max(mx); float sum = 0.f;
#pragma unroll
        for (int i = 0; i < 7; ++i) { const float pr = (sc[i] > -1e29f) ? expf(sc[i] - mx) : 0.f; ps[F.lane + 64 * i] = pr; sum += pr; }
        sum = wave_sum(sum);
        LDS_WAIT(); asm volatile("" ::: "memory");
        float o = 0.f;
#pragma unroll
        for (int p = 0; p < 3; ++p) { const int dd = (p == 0) ? 1 : (p == 1) ? 4 : 16;
#pragma unroll 4
            for (int jj = -64; jj <= 64; ++jj) { const int tk = t + dd * jj; if (tk < 0 || tk >= SEQ) continue;
                o += ps[p * 129 + jj + 64] * bf2f(QKV[(rb + tk) * NQKV + 2048 + hd * 64 + F.lane]); } }
        Y[(size_t)row * D + hd * 64 + F.lane] = (bf16)f2bf(o / sum);
        LDS_WAIT(); asm volatile("" ::: "memory");
    }
}

typedef short bf16x8 __attribute__((ext_vector_type(8)));
typedef short s16x4 __attribute__((ext_vector_type(4)));
typedef float f32x16 __attribute__((ext_vector_type(16)));
typedef short v4i16_t __attribute__((ext_vector_type(4)));
__device__ __forceinline__ bool attn_tile_info(int ti, int w, int r16, int& d, int& ktok0) {
    if (ti < 5) { const int tt = (ti == 0) ? 2 : (ti <= 2 ? ti - 1 : ti); const int jt = 32 * w - 64 + 32 * tt; d = 16; ktok0 = r16 + 16 * jt; return jt >= 0 && jt < 128; }
    if (ti < 13) { const int jt = 128 * w - 64 + 32 * (ti - 5); d = 4; ktok0 = (r16 & 3) + 4 * jt; return jt >= 0 && jt < 512; }
    const int kt = 512 * w - 64 + 32 * (ti - 13); d = 1; ktok0 = kt; return kt >= 0 && kt < SEQ;
}
__device__ __forceinline__ void attn_phase(const Ctx& F) {
    const bf16* QKV = (const bf16*)(F.ws + WS_R1 + R1_Z); bf16* Y = (bf16*)(F.ws + WS_HB);
    LAS unsigned char* kl = F.lds + F.wave * 8704;
    LAS unsigned char* vl = kl + 4608;
    const int lane = F.lane, r = lane & 31, h = lane >> 5;
    const int gw = F.blk * NWAVES + F.wave, NGW = F.G * NWAVES;
    const int srow = lane >> 3, sch = lane & 7;
    const unsigned kst = srow * 144 + sch * 16, vst = (sch >> 2) * 2048 + srow * 64 + (sch & 3) * 16;
    const unsigned krd = r * 144 + h * 16;
    const int gi = (lane >> 4) & 1, i16 = lane & 15;
    const unsigned vrd = (4 * h + (i16 >> 2)) * 64 + gi * 32 + (i16 & 3) * 8;
    const float cexp = 0.125f * 1.4426950408889634f;
    for (int unit = gw; unit < 8192; unit += NGW) {
        const int r16 = unit & 15, w = (unit >> 4) & 3, hd = (unit >> 6) & 15, b = unit >> 10; const size_t rb = (size_t)b * SEQ;
        const int qtok = w * 512 + 16 * r + r16;
        bf16x8 qf[4];
        { const bf16* qp = QKV + (rb + qtok) * NQKV + hd * 64 + 8 * h;
#pragma unroll
          for (int kk = 0; kk < 4; ++kk) qf[kk] = *(const bf16x8*)(qp + 16 * kk); }
        f32x16 o0, o1;
#pragma unroll
        for (int i = 0; i < 16; ++i) { o0[i] = 0.f; o1[i] = 0.f; }
        float mrun = -1e30f, lrun = 0.f;
        const bf16* kbase = QKV + rb * NQKV + 1024 + hd * 64 + sch * 8;
        int d = 1, ktok0 = 0; bool inr = attn_tile_info(0, w, r16, d, ktok0);
        v4u kg[4], vg[4];
#pragma unroll
        for (int i = 0; i < 4; ++i) { int tok = ktok0 + d * (srow + 8 * i); tok = tok < 0 ? 0 : (tok > SEQ - 1 ? SEQ - 1 : tok); const bf16* p = kbase + (size_t)tok * NQKV; kg[i] = *(const v4u*)p; vg[i] = *(const v4u*)(p + 1024); }
#pragma nounroll
        for (int ti = 0; ti < 33; ++ti) {
            const int dcur = d, kcur = ktok0; const bool inrcur = inr;
#pragma unroll
            for (int i = 0; i < 4; ++i) { *(LAS v4u*)(kl + kst + i * 8 * 144) = kg[i]; *(LAS v4u*)(vl + vst + i * 8 * 64) = vg[i]; }
            if (ti + 1 < 33) {
                inr = attn_tile_info(ti + 1, w, r16, d, ktok0);
#pragma unroll
                for (int i = 0; i < 4; ++i) { int tok = ktok0 + d * (srow + 8 * i); tok = tok < 0 ? 0 : (tok > SEQ - 1 ? SEQ - 1 : tok); const bf16* p = kbase + (size_t)tok * NQKV; kg[i] = *(const v4u*)p; vg[i] = *(const v4u*)(p + 1024); }
            }
            f32x16 s;
#pragma unroll
            for (int i = 0; i < 16; ++i) s[i] = 0.f;
#pragma unroll
            for (int kk = 0; kk < 4; ++kk) { const bf16x8 kf = *(const LAS bf16x8*)(kl + krd + 32 * kk); s = __builtin_amdgcn_mfma_f32_32x32x16_bf16(kf, qf[kk], s, 0, 0, 0); }
            const int diff0 = kcur - qtok + dcur * 4 * h, lim = inrcur ? 64 * dcur : -1; float mx = -1e30f;
#pragma unroll
            for (int i = 0; i < 16; ++i) { const int df = diff0 + dcur * ((i & 3) + 8 * (i >> 2)); const bool ok = (df <= lim) && (df >= -lim); s[i] = ok ? s[i] : -1e30f; mx = fmaxf(mx, s[i]); }
            mx = fmaxf(mx, __shfl_xor(mx, 32));
            const float mnew = fmaxf(mrun, mx), alpha = exp2f((mrun - mnew) * cexp), mc = mnew * cexp; mrun = mnew;
            float ps = 0.f;
#pragma unroll
            for (int i = 0; i < 16; ++i) { s[i] = exp2f(s[i] * cexp - mc); ps += s[i]; }
            ps += __shfl_xor(ps, 32);
            lrun = lrun * alpha + ps;
#pragma unroll
            for (int i = 0; i < 16; ++i) { o0[i] *= alpha; o1[i] *= alpha; }
#pragma unroll
            for (int sx = 0; sx < 2; ++sx) {
                v4u pw; pw.x = cvtpk(s[8 * sx + 0], s[8 * sx + 1]); pw.y = cvtpk(s[8 * sx + 2], s[8 * sx + 3]); pw.z = cvtpk(s[8 * sx + 4], s[8 * sx + 5]); pw.w = cvtpk(s[8 * sx + 6], s[8 * sx + 7]);
                const bf16x8 pf = __builtin_bit_cast(bf16x8, pw);
#pragma unroll
                for (int dt = 0; dt < 2; ++dt) {
                    const s16x4 va = __builtin_bit_cast(s16x4, __builtin_amdgcn_ds_read_tr16_b64_v4i16((LAS v4i16_t*)(vl + vrd + dt * 2048 + (16 * sx) * 64)));
                    const s16x4 vb = __builtin_bit_cast(s16x4, __builtin_amdgcn_ds_read_tr16_b64_v4i16((LAS v4i16_t*)(vl + vrd + dt * 2048 + (16 * sx + 8) * 64)));
                    const bf16x8 vf = {va[0], va[1], va[2], va[3], vb[0], vb[1], vb[2], vb[3]};
                    if (dt == 0) o0 = __builtin_amdgcn_mfma_f32_32x32x16_bf16(vf, pf, o0, 0, 0, 0); else o1 = __builtin_amdgcn_mfma_f32_32x32x16_bf16(vf, pf, o1, 0, 0, 0);
                }
            }
        }
        const float inv = 1.0f / lrun;
        bf16* yp = Y + (rb + qtok) * D + hd * 64 + 4 * h;
#pragma unroll
        for (int g = 0; g < 4; ++g) {
            v2u w0; w0.x = cvtpk(o0[4 * g] * inv, o0[4 * g + 1] * inv); w0.y = cvtpk(o0[4 * g + 2] * inv, o0[4 * g + 3] * inv); *(v2u*)(yp + 8 * g) = w0;
            v2u w1; w1.x = cvtpk(o1[4 * g] * inv, o1[4 * g + 1] * inv); w1.y = cvtpk(o1[4 * g + 2] * inv, o1[4 * g + 3] * inv); *(v2u*)(yp + 32 + 8 * g) = w1;
        }
    }
}
#ifndef REP_P0
#define REP_P0 1
#endif
#ifndef REP_G1
#define REP_G1 1
#endif
#ifndef REP_MIX
#define REP_MIX 1
#endif
#ifndef REP_ATT
#define REP_ATT 1
#endif
#ifndef REP_G2
#define REP_G2 1
#endif
#ifndef REP_DISP
#define REP_DISP 1
#endif
#ifndef REP_GU
#define REP_GU 1
#endif
#ifndef REP_DN
#define REP_DN 1
#endif
#define REPEAT(n) _Pragma("nounroll") for (int rep_ = 0; rep_ < (n); ++rep_)
#ifndef EN_P0
#define EN_P0 1
#endif
#ifndef EN_N1
#define EN_N1 1
#endif
#ifndef EN_G1E
#define EN_G1E 1
#endif
#ifndef EN_G1O
#define EN_G1O 1
#endif
#ifndef EN_MIXA
#define EN_MIXA 1
#endif
#ifndef EN_MIXB
#define EN_MIXB 1
#endif
#ifndef EN_ATT
#define EN_ATT 1
#endif
#ifndef EN_G2
#define EN_G2 1
#endif
#ifndef EN_N2
#define EN_N2 1
#endif
#ifndef EN_DISP
#define EN_DISP 1
#endif
#ifndef EN_GU
#define EN_GU 1
#endif
#ifndef EN_DN
#define EN_DN 1
#endif
#ifndef EN_FIN
#define EN_FIN 1
#endif

struct Args { const void* in[25]; float* out; unsigned char* ws; int ph_lo, ph_hi; };
constexpr int NPHASE = 2 + 10 * DEPTH;

__global__ void __launch_bounds__(NTHR, 2) fwd(Args args) {
    extern __shared__ __attribute__((aligned(16))) unsigned char lds[];
    Ctx F;
    F.lds0 = (LAS unsigned char*)lds; F.lds = F.lds0; F.MISC = (volatile LAS unsigned*)(F.lds + MISC_OFF);
    F.tid = threadIdx.x; F.lane = F.tid & 63; F.wave = __builtin_amdgcn_readfirstlane(F.tid >> 6);
    F.G = gridDim.x; F.blk = blockIdx.x; launder(F);
    for (int u = F.tid; u < 256; u += NTHR) ((LAS unsigned*)(F.lds + MISC_OFF))[u] = 0u;
    __syncthreads();
#if MK_ONE_LAUNCH
    XcdBarrier bar = xcd_barrier_post(F.ctl + CW_BAR, F.MISC + 8);
#define GRID_BAR() xcd_barrier(bar)
#else
#define GRID_BAR() do { } while (0)
#endif
#define IN(k) (launder(F) && F.lo <= (k) && (k) < F.hi)
#define SEAM(k) do { if (IN(k) && IN((k) + 1)) GRID_BAR(); } while (0)
#define WSP (F.ws)
#define MOD ((const float*)(F.ws + WS_MOD))
#define X ((float*)(F.ws + WS_X))
#define HB ((bf16*)(F.ws + WS_HB))
#define R1Z ((bf16*)(F.ws + WS_R1 + R1_Z))
#define DELTA ((bf16*)(F.ws + WS_R1 + R1_DELTA))
#define XS ((bf16*)(F.ws + WS_R1 + R1_XS))
#define ACT ((bf16*)(F.ws + WS_R1 + R1_ACT))
#define YW ((bf16*)(F.ws + WS_R1 + R1_YW))

    if (EN_P0 && IN(0)) { REPEAT(REP_P0) p0_prologue(F); } SEAM(0);

    for (int l = 0; l < DEPTH; ++l) {
        const int base = 1 + 10 * l, jl = l >> 1; const bool even = (l & 1) == 0;
#define modl (MOD + (size_t)l * 8 * 6144)
#define gcnt (F.ctl + CW_CNT + 64 * l)
        if (EN_N1 && IN(base + 0)) {
            const float* gv = (const float*)F.in[5] + (size_t)l * D;
            if (l == 0) norm_phase<0, false, false>(F, (const float*)F.in[0], X, nullptr, nullptr, gv, modl + 0, modl + 1024, HB, nullptr, nullptr);
            else norm_phase<2, false, false>(F, X, X, YW, MOD + (size_t)(l - 1) * 8 * 6144 + 5120, gv, modl + 0, modl + 1024, HB, nullptr, nullptr);
        }
        SEAM(base + 0);
        if (IN(base + 1)) REPEAT(REP_G1) {
            if (!EN_G1E && even) {} else if (even) { pg8::StaticOrder S; S.init(HB, (const bf16*)(WSP + WS_WIN) + (size_t)jl * IN_AB * D, T, IN_AB, D, F.G, F.blk);
                pg8::EpiStore E{R1Z, IN_AB};
                pg8::gemm_phase<pg8::EpiStore, pg8::StaticOrder, true, true>(F.lds, D, S, E, F.tid); }
            else if (EN_G1O) { pg8::StaticOrder S; S.init(HB, (const bf16*)(WSP + WS_WQKV) + (size_t)jl * NQKV * D, T, NQKV, D, F.G, F.blk);
                pg8::EpiQKV E{R1Z, (const float*)(WSP + WS_ROT)};
                pg8::gemm_phase<pg8::EpiQKV, pg8::StaticOrder, true, true>(F.lds, D, S, E, F.tid); }
        }
        SEAM(base + 1);
        if (IN(base + 2)) { if (even) { if (EN_MIXA) REPEAT(REP_MIX) mix_phase<false>(F, jl); } else { if (EN_ATT) REPEAT(REP_ATT) attn_phase(F); } }
        SEAM(base + 2);
        if (IN(base + 3)) { if (even) carry_phase(F); }
        if (even) SEAM(base + 3);
        if (EN_MIXB && IN(base + 4)) { if (even) REPEAT(REP_MIX) mix_phase<true>(F, jl); }
        if (even) SEAM(base + 4);
        if (EN_G2 && IN(base + 5)) REPEAT(REP_G2) {
            pg8::StaticOrder S; S.init(HB, even ? (const bf16*)(WSP + WS_WOUT) + (size_t)jl * D * D : (const bf16*)(WSP + WS_WO) + (size_t)jl * D * D, T, D, D, F.G, F.blk);
            pg8::EpiStore E{DELTA, D};
            pg8::gemm_phase<pg8::EpiStore, pg8::StaticOrder, true, true>(F.lds, D, S, E, F.tid);
        }
        SEAM(base + 5);
        if (EN_N2 && IN(base + 6)) norm_phase<1, true, false>(F, X, X, DELTA, modl + 2048, (const float*)F.in[6] + (size_t)l * D, modl + 3072, modl + 4096, HB, nullptr, gcnt);
        SEAM(base + 6);
        if (EN_DISP && IN(base + 7)) REPEAT(REP_DISP) dispatch_phase(F, gcnt);
        SEAM(base + 7);
        if (EN_GU && IN(base + 8)) REPEAT(REP_GU) {
            compute_tpre(F, gcnt);
            pg8::MoeOrder S; S.A = (const char*)XS; S.Bt = (const char*)((const bf16*)(WSP + WS_WGU) + (size_t)l * NE * 1024 * 1024); S.tstep = (size_t)256 * 1024 * 2; S.estride = (size_t)1024 * 1024 * 2; S.G = F.G; S.c = F.blk;
            S.tp = F.MISC + 16;
            pg8::EpiGU E{ACT};
            pg8::gemm_phase<pg8::EpiGU, pg8::MoeOrder, true, true>(F.lds, 1024, S, E, F.tid);
        }
        SEAM(base + 8);
        if (EN_DN && IN(base + 9)) REPEAT(REP_DN) {
            compute_tpre(F, gcnt);
            pg8::MoeOrder S; S.A = (const char*)ACT; S.Bt = (const char*)((const bf16*)(WSP + WS_WDN) + (size_t)l * NE * 1024 * 512); S.tstep = (size_t)256 * 512 * 2; S.estride = (size_t)1024 * 512 * 2; S.G = F.G; S.c = F.blk;
            S.tp = F.MISC + 16;
            pg8::EpiDN E{YW, (const int*)(WSP + WS_SLOTI), (const float*)(WSP + WS_SLOTW)};
            pg8::gemm_phase<pg8::EpiDN, pg8::MoeOrder, true, true>(F.lds, 512, S, E, F.tid);
        }
        SEAM(base + 9);
    }
    if (EN_FIN && IN(NPHASE - 1)) norm_phase<2, false, true>(F, X, nullptr, YW, MOD + (size_t)3 * 8 * 6144 + 5120, (const float*)F.in[7], nullptr, nullptr, nullptr, args.out, nullptr);
#undef IN
#undef SEAM
#undef WSP
#undef MOD
#undef X
#undef HB
#undef R1Z
#undef DELTA
#undef XS
#undef ACT
#undef YW
#undef modl
#undef gcnt
}

extern "C" void kernel_launch(void* const* d_in, const int* in_sizes, int n_in, void* d_out, int out_size, void* d_ws, size_t ws_size, hipStream_t stream) {
    static int grid = 0;
    if (grid == 0) {
        if (n_in != 25 || in_sizes[0] != T * D || out_size != T * D || ws_size < WS_END) { fprintf(stderr, "kernel_launch: unexpected shapes / workspace (n_in %d, ws %zu); nothing launched\n", n_in, ws_size); grid = -1; return; }
        int dev = 0, cus = 0, per_cu = 0;
        if (hipGetDevice(&dev) != hipSuccess || hipDeviceGetAttribute(&cus, hipDeviceAttributeMultiprocessorCount, dev) != hipSuccess) { grid = -1; return; }
        if (hipFuncSetAttribute((const void*)fwd, hipFuncAttributeMaxDynamicSharedMemorySize, LDS_BYTES) != hipSuccess) { fprintf(stderr, "kernel_launch: hipFuncSetAttribute failed\n"); grid = -1; return; }
        if (hipOccupancyMaxActiveBlocksPerMultiprocessor(&per_cu, (const void*)fwd, NTHR, LDS_BYTES) != hipSuccess || per_cu < 1) { fprintf(stderr, "kernel_launch: occupancy query reports %d\n", per_cu); }
        (void)hipGetLastError();
        grid = cus;
    }
    if (grid < 0) return;
    if (hipMemsetAsync((char*)d_ws + WS_CTL, 0, CTL_ZERO_BYTES, stream) != hipSuccess) return;
    Args a{};
    for (int i = 0; i < 25; ++i) a.in[i] = d_in[i];
    a.out = (float*)d_out; a.ws = (unsigned char*)d_ws;
#if MK_ONE_LAUNCH
    a.ph_lo = 0; a.ph_hi = NPHASE;
    hipLaunchKernelGGL(fwd, dim3(grid), dim3(NTHR), LDS_BYTES, stream, a);
#else
    for (int p = 0; p < NPHASE; ++p) {
        if (p >= 1 && p < NPHASE - 1) { const int l = (p - 1) / 10, s = (p - 1) % 10; if ((l & 1) == 1 && (s == 3 || s == 4)) continue; }
        a.ph_lo = p; a.ph_hi = p + 1;
        hipLaunchKernelGGL(fwd, dim3(grid), dim3(NTHR), LDS_BYTES, stream, a);
    }
#endif
}
```

```cpp
#include <hip/hip_runtime.h>
#include <cstdio>
#include <cstdint>

#ifndef MK_ONE_LAUNCH
#define MK_ONE_LAUNCH 1
#endif

namespace pg8 {
#define PG8_LAS __attribute__((address_space(3)))
typedef unsigned short bf16_t;
typedef short bf16x8 __attribute__((ext_vector_type(8)));
typedef float f32x4 __attribute__((ext_vector_type(4)));
typedef unsigned u32x4 __attribute__((ext_vector_type(4)));
constexpr int BM = 256, BK = 64, HALF = 128, HTB = HALF * BK * 2  , STAGE_BYTES = 8 * HTB, NXCD = 8, WGM = 8;

__host__ __device__ __forceinline__ int lds_byte(int r, int c) { const int st = (r >> 4) * 2 + (c >> 5), rr = r & 15, cc = c & 31, ob = rr * 64 + cc * 2; return st * 1024 + (ob ^ (((ob >> 9) & 1) << 5)); }
__host__ __device__ __forceinline__ void stage_rc(int b, int& R, int& C) { const int st = b / 1024, sb = b % 1024, swz = sb ^ (((sb >> 9) & 1) << 5); R = (st >> 1) * 16 + swz / 64; C = (st & 1) * 32 + (swz % 64) / 2; }
__host__ __device__ __forceinline__ int perm32(int rho) { const int n = rho >> 4, i = rho & 15; return 8 * (i >> 2) + 4 * n + (i & 3); }

struct Unit { int pm, pn, e; };

struct StaticOrder {
    const char* A; const char* Bt; size_t tstep;
    int nM, nN, nwg, G, c;
    __device__ void init(const void* A_, const void* Bt_, int M, int N, int K, int G_, int c_) { A = (const char*)A_; Bt = (const char*)Bt_; tstep = (size_t)256 * K * 2; nM = M / BM; nN = N / BM; nwg = nM * nN; G = G_; c = c_; }
    __device__ bool next(int i, Unit& u) const {
        const long L = (long)i * G + c; if (L >= nwg) return false;
        int wgid = (int)L; { const int q = nwg / NXCD, r = nwg % NXCD, xcd = wgid % NXCD, off = wgid / NXCD; wgid = (xcd < r ? xcd * (q + 1) : r * (q + 1) + (xcd - r) * q) + off; }
        const int nig = WGM * nN, gid = wgid / nig, fm = gid * WGM, gsz = (nM - fm) < WGM ? (nM - fm) : WGM;
        u.pm = fm + ((wgid % nig) % gsz); u.pn = (wgid % nig) / gsz; u.e = 0; return true;
    }
    __device__ __forceinline__ const char* a_base(const Unit& u) const { return A + (size_t)u.pm * tstep; }
    __device__ __forceinline__ const char* b_base(const Unit& u) const { return Bt + (size_t)u.pn * tstep; }
    __device__ __forceinline__ void a_ready(const Unit&) const {}
    __device__ __forceinline__ void done(const Unit&) const {}
};
struct MoeOrder {
    const char* A; const char* Bt; size_t tstep, estride;
    const volatile PG8_LAS unsigned* tp; int G, c;
    __device__ bool next(int i, Unit& u) const {
        const int L = i * G + c; if (L >= (int)tp[16] * 4) return false;
        const int pt = L >> 2; int e = 0;
#pragma unroll
        for (int j = 1; j < 16; ++j) e += (pt >= (int)tp[j]) ? 1 : 0;
        e = __builtin_amdgcn_readfirstlane(e);
        u.pm = pt; u.pn = L & 3; u.e = e; return true;
    }
    __device__ __forceinline__ const char* a_base(const Unit& u) const { return A + (size_t)u.pm * tstep; }
    __device__ __forceinline__ const char* b_base(const Unit& u) const { return Bt + (size_t)u.e * estride + (size_t)u.pn * tstep; }
    __device__ __forceinline__ void a_ready(const Unit&) const {}
    __device__ __forceinline__ void done(const Unit&) const {}
};

__device__ __forceinline__ unsigned cvt_pk_bf16(float lo, float hi) { unsigned r; asm volatile("v_cvt_pk_bf16_f32 %0, %1, %2" : "=v"(r) : "v"(lo), "v"(hi)); return r; }
__device__ __forceinline__ u32x4 pack8(const f32x4 v0, const f32x4 v1) { u32x4 w; w.x = cvt_pk_bf16(v0[0], v0[1]); w.y = cvt_pk_bf16(v0[2], v0[3]); w.z = cvt_pk_bf16(v1[0], v1[1]); w.w = cvt_pk_bf16(v1[2], v1[3]); return w; }

struct EpiStore {
    static constexpr bool PERM = true, AFTER_DRAIN = false;
    bf16_t* O; int ldc;
    __device__ __forceinline__ void operator()(const f32x4 (&acc)[2][2][4][2], const Unit& u, int wr, int wc, int fr, int fq) const {
        const int row0 = u.pm * BM + wr * 64 + fr, col0 = u.pn * BM + wc * 32 + 8 * fq;
#pragma unroll
        for (int ai = 0; ai < 2; ++ai)
#pragma unroll
            for (int m = 0; m < 4; ++m) { bf16_t* rowp = O + (size_t)(row0 + ai * HALF + m * 16) * ldc + col0;
#pragma unroll
                for (int bj = 0; bj < 2; ++bj) *(u32x4*)(rowp + bj * HALF) = pack8(acc[ai][bj][m][0], acc[ai][bj][m][1]); }
    }
};
struct EpiQKV {
    static constexpr bool PERM = true, AFTER_DRAIN = false;
    bf16_t* O; const float* rot;
    __device__ __forceinline__ void operator()(const f32x4 (&acc)[2][2][4][2], const Unit& u, int wr, int wc, int fr, int fq) const {
        const int row0 = u.pm * BM + wr * 64 + fr, col0 = u.pn * BM + wc * 32 + 8 * fq;
        const bool rotw = (u.pn < 8) && ((wc & 1) == 0);
#pragma unroll
        for (int ai = 0; ai < 2; ++ai)
#pragma unroll
            for (int m = 0; m < 4; ++m) { const int row = row0 + ai * HALF + m * 16; bf16_t* rowp = O + (size_t)row * 3072 + col0;
                f32x4 cs[4];
                if (rotw) {
#pragma unroll
                    for (int q = 0; q < 4; ++q) cs[q] = *(const f32x4*)(rot + (size_t)row * 16 + q * 4); }
#pragma unroll
                for (int bj = 0; bj < 2; ++bj) { f32x4 v0 = acc[ai][bj][m][0], v1 = acc[ai][bj][m][1];
                    if (rotw) {
                        f32x4 p0, p1;
#pragma unroll
                        for (int j = 0; j < 4; ++j) { p0[j] = __shfl_xor(v0[j], 16); p1[j] = __shfl_xor(v1[j], 16); }
                        if (fq < 2) { const float sg = (fq == 0) ? -1.f : 1.f;
                            v0[0] = v0[0] * cs[0][0] + sg * p0[0] * cs[0][1]; v0[1] = v0[1] * cs[0][2] + sg * p0[1] * cs[0][3];
                            v0[2] = v0[2] * cs[1][0] + sg * p0[2] * cs[1][1]; v0[3] = v0[3] * cs[1][2] + sg * p0[3] * cs[1][3];
                            v1[0] = v1[0] * cs[2][0] + sg * p1[0] * cs[2][1]; v1[1] = v1[1] * cs[2][2] + sg * p1[1] * cs[2][3];
                            v1[2] = v1[2] * cs[3][0] + sg * p1[2] * cs[3][1]; v1[3] = v1[3] * cs[3][2] + sg * p1[3] * cs[3][3]; }
                    }
                    *(u32x4*)(rowp + bj * HALF) = pack8(v0, v1); } }
    }
};
struct EpiGU {
    static constexpr bool PERM = true, AFTER_DRAIN = false;
    bf16_t* O;
    __device__ __forceinline__ void operator()(const f32x4 (&acc)[2][2][4][2], const Unit& u, int wr, int wc, int fr, int fq) const {
        const int row0 = u.pm * BM + wr * 64 + fr, col0 = u.pn * 128 + wc * 32 + 8 * fq;
#pragma unroll
        for (int ai = 0; ai < 2; ++ai)
#pragma unroll
            for (int m = 0; m < 4; ++m) { bf16_t* rowp = O + (size_t)(row0 + ai * HALF + m * 16) * 512 + col0;
                f32x4 o[2];
#pragma unroll
                for (int n = 0; n < 2; ++n)
#pragma unroll
                    for (int j = 0; j < 4; ++j) { const float g = acc[ai][0][m][n][j], up = acc[ai][1][m][n][j]; o[n][j] = g / (1.f + __expf(-g)) * up; }
                *(u32x4*)rowp = pack8(o[0], o[1]); }
    }
};
struct EpiDN {
    static constexpr bool PERM = true, AFTER_DRAIN = false;
    bf16_t* O; const int* sloti; const float* slotw;
    __device__ __forceinline__ void operator()(const f32x4 (&acc)[2][2][4][2], const Unit& u, int wr, int wc, int fr, int fq) const {
        const int row0 = u.pm * BM + wr * 64 + fr, col0 = u.pn * BM + wc * 32 + 8 * fq;
#pragma unroll
        for (int ai = 0; ai < 2; ++ai)
#pragma unroll
            for (int m = 0; m < 4; ++m) { const int row = row0 + ai * HALF + m * 16; const int info = sloti[row]; const float w = slotw[row];
                if (info >= 0) { bf16_t* rowp = O + (size_t)info * 1024 + col0;
#pragma unroll
                    for (int bj = 0; bj < 2; ++bj) *(u32x4*)(rowp + bj * HALF) = pack8(acc[ai][bj][m][0] * w, acc[ai][bj][m][1] * w); } }
    }
};

template <class Epi, class Sched, bool ALIGN_EPI = false, bool SP2 = false>
__device__ __forceinline__ void gemm_phase(PG8_LAS unsigned char* lds, const int K, const Sched& S, const Epi& E, const int tid) {
    const int wid = __builtin_amdgcn_readfirstlane(tid >> 6), lane = tid & 63, wr = wid >> 2, wc = wid & 3, fr = lane & 15, fq = lane >> 4;
    const int nt = K / BK;
    unsigned voffA[2], voffB[2];
#pragma unroll
    for (int i = 0; i < 2; ++i) { int R, C; stage_rc(tid * 16 + i * 8192, R, C); const int Rb = Epi::PERM ? ((R & ~31) + perm32(R & 31)) : R;
        voffA[i] = (unsigned)(R * K + C) * 2u; voffB[i] = (unsigned)(Rb * K + C) * 2u; }
    const size_t kstep = (size_t)(BK * 2);
    const size_t hstep = (size_t)HALF * K * 2;
    const unsigned ldsw = (unsigned)wid * 1024u;
    const int aoff = lds_byte(wr * 64 + fr, fq * 8), boff = lds_byte(wc * 32 + fr, fq * 8);
#define PG8_SA(b, h) (((b) * 2 + (h)) * HTB)
#define PG8_SB(b, h) ((4 + (b) * 2 + (h)) * HTB)
#define PG8_STAGE(bufoff, gbase, voff) do { _Pragma("unroll") for (int _i = 0; _i < 2; ++_i) \
        __builtin_amdgcn_global_load_lds((const unsigned*)((const char*)(gbase) + (voff)[_i]), (PG8_LAS unsigned*)(lds + (bufoff) + ldsw + _i * 8192), 16, 0, 0); } while (0)
#define PG8_LDA(dst, b, h) do { _Pragma("unroll") for (int m = 0; m < 4; ++m) _Pragma("unroll") for (int k = 0; k < 2; ++k) dst[m][k] = *(const PG8_LAS bf16x8*)(lds + PG8_SA(b, h) + aoff + m * 2048 + k * 1024); } while (0)
#define PG8_LDB(dst, b, h) do { _Pragma("unroll") for (int n = 0; n < 2; ++n) _Pragma("unroll") for (int k = 0; k < 2; ++k) dst[n][k] = *(const PG8_LAS bf16x8*)(lds + PG8_SB(b, h) + boff + n * 2048 + k * 1024); } while (0)
#define PG8_MMA(ai, bj, At, Bt) do { __builtin_amdgcn_s_setprio(1); _Pragma("unroll") for (int m = 0; m < 4; ++m) _Pragma("unroll") for (int n = 0; n < 2; ++n) _Pragma("unroll") for (int k = 0; k < 2; ++k) \
        acc[ai][bj][m][n] = __builtin_amdgcn_mfma_f32_16x16x32_bf16(Bt[n][k], At[m][k], acc[ai][bj][m][n], 0, 0, 0); __builtin_amdgcn_s_setprio(0); } while (0)
#define PG8_WAIT_V(n) asm volatile("s_waitcnt vmcnt(" #n ")" ::: "memory")
#define PG8_WAIT_L(n) asm volatile("s_waitcnt lgkmcnt(" #n ")" ::: "memory")
#define PG8_BAR __builtin_amdgcn_s_barrier()
#define PG8_SCHED __builtin_amdgcn_sched_barrier(0)
    Unit cur, nxt; int ui = 0;
    if (!S.next(0, cur)) return;
    f32x4 acc[2][2][4][2];
#pragma unroll
    for (int a = 0; a < 2; ++a)
#pragma unroll
        for (int b = 0; b < 2; ++b)
#pragma unroll
            for (int m = 0; m < 4; ++m)
#pragma unroll
                for (int n = 0; n < 2; ++n) acc[a][b][m][n] = (f32x4){0.f, 0.f, 0.f, 0.f};
    bf16x8 At[4][2], B0[2][2], B1[2][2];
    const char* cA = S.a_base(cur); const char* cB = S.b_base(cur);
    S.a_ready(cur);
    if constexpr (SP2) {
        PG8_STAGE(PG8_SB(0, 0), cB, voffB); PG8_STAGE(PG8_SB(0, 1), cB + hstep, voffB); PG8_STAGE(PG8_SA(0, 0), cA, voffA); PG8_STAGE(PG8_SA(0, 1), cA + hstep, voffA);
        if (wr == 1) PG8_BAR;
        PG8_WAIT_V(2); PG8_BAR;
        PG8_STAGE(PG8_SB(1, 0), cB + kstep, voffB); PG8_STAGE(PG8_SA(1, 0), cA + kstep, voffA); PG8_STAGE(PG8_SB(1, 1), cB + hstep + kstep, voffB);
        PG8_WAIT_V(6); PG8_BAR;
    } else {
        PG8_STAGE(PG8_SB(0, 0), cB, voffB); PG8_STAGE(PG8_SA(0, 0), cA, voffA); PG8_STAGE(PG8_SB(0, 1), cB + hstep, voffB); PG8_STAGE(PG8_SA(0, 1), cA + hstep, voffA);
        if (wr == 1) PG8_BAR;
        PG8_WAIT_V(4); PG8_BAR;
        PG8_STAGE(PG8_SB(1, 0), cB + kstep, voffB); PG8_STAGE(PG8_SA(1, 0), cA + kstep, voffA); PG8_STAGE(PG8_SB(1, 1), cB + hstep + kstep, voffB);
        PG8_WAIT_V(6); PG8_BAR;
    }
    for (;;) {
        const bool has_next = S.next(ui + 1, nxt);
        const char* nA = has_next ? S.a_base(nxt) : cA; const char* nB = has_next ? S.b_base(nxt) : cB;
        for (int t = 0; t < nt; t += 2) {
            const bool last = (t == nt - 2);
            const char* a1 = cA + (size_t)(t + 1) * kstep;
            const char* a2 = last ? nA : cA + (size_t)(t + 2) * kstep; const char* b2 = last ? nB : cB + (size_t)(t + 2) * kstep;
            const char* a3 = a2 + kstep; const char* b3 = b2 + kstep;
            if (last && has_next) S.a_ready(nxt);
            if constexpr (SP2) {
            PG8_LDB(B0, 0, 0); PG8_LDB(B1, 0, 1); PG8_SCHED; PG8_LDA(At, 0, 0); PG8_STAGE(PG8_SA(1, 1), a1 + hstep, voffA);
            PG8_WAIT_V(8); PG8_WAIT_L(0); PG8_BAR; PG8_MMA(0, 0, At, B0); PG8_MMA(0, 1, At, B1); PG8_BAR; PG8_SCHED;
            PG8_LDA(At, 0, 1); PG8_STAGE(PG8_SB(0, 0), b2, voffB); PG8_STAGE(PG8_SB(0, 1), b2 + hstep, voffB); PG8_STAGE(PG8_SA(0, 0), a2, voffA);
            PG8_WAIT_V(8); PG8_WAIT_L(0); PG8_BAR; PG8_MMA(1, 0, At, B0); PG8_MMA(1, 1, At, B1); PG8_BAR; PG8_SCHED;
            PG8_LDB(B0, 1, 0); PG8_LDB(B1, 1, 1); PG8_SCHED; PG8_LDA(At, 1, 0); PG8_STAGE(PG8_SA(0, 1), a2 + hstep, voffA);
            PG8_WAIT_V(8); PG8_WAIT_L(0); PG8_BAR; PG8_MMA(0, 0, At, B0); PG8_MMA(0, 1, At, B1); PG8_BAR; PG8_SCHED;
            PG8_LDA(At, 1, 1); PG8_STAGE(PG8_SB(1, 0), b3, voffB); PG8_STAGE(PG8_SB(1, 1), b3 + hstep, voffB); PG8_STAGE(PG8_SA(1, 0), a3, voffA);
            PG8_WAIT_V(8); PG8_WAIT_L(0); PG8_BAR; PG8_MMA(1, 0, At, B0); PG8_MMA(1, 1, At, B1); PG8_BAR; PG8_SCHED;
            } else {
            PG8_LDB(B0, 0, 0); PG8_SCHED; PG8_LDA(At, 0, 0); PG8_STAGE(PG8_SA(1, 1), a1 + hstep, voffA);
            PG8_WAIT_L(8); PG8_BAR; PG8_WAIT_L(0); PG8_MMA(0, 0, At, B0); PG8_BAR; PG8_SCHED;
            PG8_LDB(B1, 0, 1); PG8_STAGE(PG8_SB(0, 0), b2, voffB);
            PG8_BAR; PG8_WAIT_L(0); PG8_MMA(0, 1, At, B1); PG8_BAR;
            PG8_LDA(At, 0, 1); PG8_STAGE(PG8_SA(0, 0), a2, voffA);
            PG8_BAR; PG8_WAIT_L(0); PG8_MMA(1, 0, At, B0); PG8_BAR; PG8_SCHED;
            PG8_STAGE(PG8_SB(0, 1), b2 + hstep, voffB);
            PG8_WAIT_V(6); PG8_BAR; PG8_MMA(1, 1, At, B1); PG8_BAR;
            PG8_LDB(B0, 1, 0); PG8_SCHED; PG8_LDA(At, 1, 0); PG8_STAGE(PG8_SA(0, 1), a2 + hstep, voffA);
            PG8_WAIT_L(8); PG8_BAR; PG8_WAIT_L(0); PG8_MMA(0, 0, At, B0); PG8_BAR; PG8_SCHED;
            PG8_LDB(B1, 1, 1); PG8_STAGE(PG8_SB(1, 0), b3, voffB);
            PG8_BAR; PG8_WAIT_L(0); PG8_MMA(0, 1, At, B1); PG8_BAR;
            PG8_LDA(At, 1, 1); PG8_STAGE(PG8_SA(1, 0), a3, voffA);
            PG8_BAR; PG8_WAIT_L(0); PG8_MMA(1, 0, At, B0); PG8_BAR; PG8_SCHED;
            PG8_STAGE(PG8_SB(1, 1), b3 + hstep, voffB);
            PG8_WAIT_V(6); PG8_BAR; PG8_MMA(1, 1, At, B1); PG8_BAR;
            }
        }
        if constexpr (ALIGN_EPI) { if (wr == 0) PG8_BAR; }
        if constexpr (!Epi::AFTER_DRAIN) { E(acc, cur, wr, wc, fr, fq); S.done(cur); }
        if (!has_next) break;
#pragma unroll
        for (int a = 0; a < 2; ++a)
#pragma unroll
            for (int b = 0; b < 2; ++b)
#pragma unroll
                for (int m = 0; m < 4; ++m)
#pragma unroll
                    for (int n = 0; n < 2; ++n) acc[a][b][m][n] = (f32x4){0.f, 0.f, 0.f, 0.f};
        cur = nxt; cA = nA; cB = nB; ++ui;
        if constexpr (ALIGN_EPI) { if (wr == 1) PG8_BAR; }
    }
    PG8_WAIT_V(0);
    if constexpr (!ALIGN_EPI) { if (wr == 0) PG8_BAR; }
    PG8_BAR;
    if constexpr (Epi::AFTER_DRAIN) { E.fused(acc, cur, wr, wc, fr, fq, lds, wid, lane); S.done(cur); }
#undef PG8_SA
#undef PG8_SB
#undef PG8_STAGE
#undef PG8_LDA
#undef PG8_LDB
#undef PG8_MMA
#undef PG8_WAIT_V
#undef PG8_WAIT_L
#undef PG8_BAR
#undef PG8_SCHED
}
}

constexpr int NB = 8, SEQ = 2048, T = NB * SEQ, D = 1024, DEPTH = 4;
constexpr int IN_AB = 2560, NQKV = 3072, NE = 16, FF = 512;
constexpr int MAXTILES = 144, MPAD = MAXTILES * 256;
constexpr int NWAVES = 8, NTHR = 512;

constexpr size_t MiB = 1u << 20;
constexpr size_t WS_CTL = 0, CTL_ZERO_BYTES = 1 * MiB;
constexpr int CW_TMO = 0, CW_BAR = 64, CW_CNT = 8192;
constexpr size_t WS_MOD = 1 * MiB;
constexpr size_t WS_ROT = 2 * MiB;
constexpr size_t WS_AGG = 3 * MiB;
constexpr size_t WS_LIST = 5 * MiB;
constexpr size_t WS_TOPW = 6 * MiB;
constexpr size_t WS_SLOTI = 6 * MiB + 512 * 1024;
constexpr size_t WS_SLOTW = 7 * MiB;
constexpr size_t WS_LRUW = 7 * MiB + 512 * 1024;
constexpr size_t WS_WIN = 8 * MiB;
constexpr size_t WS_WOUT = 18 * MiB;
constexpr size_t WS_WQKV = 22 * MiB;
constexpr size_t WS_WO = 34 * MiB;
constexpr size_t WS_WGU = 38 * MiB;
constexpr size_t WS_WDN = 166 * MiB;
constexpr size_t WS_X = 230 * MiB;
constexpr size_t WS_HB = 294 * MiB;
constexpr size_t WS_R1 = 326 * MiB;
constexpr size_t R1_Z = 0;
constexpr size_t R1_DELTA = 0;
constexpr size_t R1_XS = 0;
constexpr size_t R1_ACT = 72 * MiB;
constexpr size_t R1_YW = 108 * MiB;
constexpr size_t R1_AGG = 96 * MiB, R1_CARRY = 100 * MiB;
constexpr size_t WS_MCST = 6 * MiB + 256 * 1024;
constexpr size_t WS_END = 526 * MiB;

constexpr int RING_BYTES = 131072;
constexpr int MISC_OFF = 150528;
constexpr int ENT_OFF = RING_BYTES;
constexpr int LDS_BYTES = 147456 + 4096;

#define GAS __attribute__((address_space(1)))
#define LAS __attribute__((address_space(3)))
typedef unsigned short bf16;
typedef unsigned v4u __attribute__((ext_vector_type(4)));
typedef unsigned v2u __attribute__((ext_vector_type(2)));
typedef float f32x4 __attribute__((ext_vector_type(4)));
typedef float f32x2 __attribute__((ext_vector_type(2)));
#define RLX_AGENT __ATOMIC_RELAXED, __HIP_MEMORY_SCOPE_AGENT
#define LDS_WAIT() asm volatile("s_waitcnt lgkmcnt(0)" ::: "memory")
#define VM_WAIT() asm volatile("s_waitcnt vmcnt(0)" ::: "memory")
__device__ __forceinline__ unsigned f2bf(float f) { unsigned u = __builtin_bit_cast(unsigned, f); return (u + 0x7fffu + ((u >> 16) & 1u)) >> 16; }
__device__ __forceinline__ unsigned pk2(float lo, float hi) { return f2bf(lo) | (f2bf(hi) << 16); }
__device__ __forceinline__ float bf2f(unsigned short b) { return __builtin_bit_cast(float, (unsigned)b << 16); }
__device__ __forceinline__ float bflo(unsigned w) { return __builtin_bit_cast(float, w << 16); }
__device__ __forceinline__ float bfhi(unsigned w) { return __builtin_bit_cast(float, w & 0xffff0000u); }

#define XB_TMO      128
#define XB_XCNT(j)  (256  + 64 * (j))
#define XB_XSUB(j)  (1280 + 64 * (j))
#define XB_XGEN(j)  (2304 + 64 * (j))
#define XB_TOP      3328
#define XB_TOPGEN   3392
#define XCD_BAR_WORDS 3456
#define XB_SPIN_CAP (1u << 18)

__device__ __forceinline__ unsigned xb_ld(unsigned* p)              { return __hip_atomic_load(p, __ATOMIC_RELAXED, __HIP_MEMORY_SCOPE_AGENT); }
__device__ __forceinline__ unsigned xb_add(unsigned* p, unsigned v) { return __hip_atomic_fetch_add(p, v, __ATOMIC_RELAXED, __HIP_MEMORY_SCOPE_AGENT); }
__device__ __forceinline__ unsigned xb_xcc_id() { return (unsigned)__builtin_amdgcn_s_getreg((3 << 11) | 20) & 0xFu; }
#define XB_SPIN(cond, bar) do { unsigned _sp = 0; while (cond) { __builtin_amdgcn_s_sleep(1); \
    if ((++_sp & 255u) == 0u) { if (xb_ld(&(bar)[XB_TMO])) break; if (_sp > XB_SPIN_CAP) { atomicAdd(&(bar)[XB_TMO], 1u); break; } } } } while (0)

struct XcdBarrier {
    unsigned* bar; unsigned x;
    volatile LAS unsigned* st;
};

__device__ __forceinline__ XcdBarrier xcd_barrier_post(unsigned* bar, volatile LAS unsigned* st) {
    XcdBarrier b; b.bar = bar; b.x = xb_xcc_id(); b.st = st;
    if (threadIdx.x == 0) (void)xb_add(&bar[XB_XCNT(b.x)], 1u);
    return b;
}
__device__ __forceinline__ void xcd_barrier_complete(unsigned* bar, unsigned x, unsigned& nloc, unsigned& nx) {
    const unsigned G = gridDim.x * gridDim.y * gridDim.z;
    unsigned sum, cnt, mine, sp = 0u;
    for (;;) {
        sum = 0u; cnt = 0u; mine = 0u;
#pragma unroll
        for (unsigned j = 0; j < 16; ++j) { const unsigned c = xb_ld(&bar[XB_XCNT(j)]); sum += c; cnt += (c > 0u) ? 1u : 0u; mine = (j == x) ? c : mine; }
        if (sum == G) break;
        __builtin_amdgcn_s_sleep(1);
        if ((++sp & 255u) == 0u) { if (xb_ld(&bar[XB_TMO])) break; if (sp > XB_SPIN_CAP) { atomicAdd(&bar[XB_TMO], 1u); break; } }
    }
    nloc = mine > 0u ? mine : 1u; nx = cnt > 0u ? cnt : 1u;
}

__device__ __forceinline__ void xcd_barrier(const XcdBarrier& b) {
    asm volatile("s_waitcnt vmcnt(0)" ::: "memory");
    __syncthreads();
    if (threadIdx.x == 0) {
        unsigned* bar = b.bar;
        __builtin_amdgcn_s_waitcnt(0);
        unsigned nloc = b.st[0], nx = b.st[1];
        if (nloc == 0u) { xcd_barrier_complete(bar, b.x, nloc, nx); b.st[0] = nloc; b.st[1] = nx; }
        const unsigned old = xb_add(&bar[XB_XSUB(b.x)], 1u);
        const unsigned gen = old / nloc;
        if (old + 1u == (gen + 1u) * nloc) {
            __builtin_amdgcn_fence(__ATOMIC_RELEASE, "agent");
            asm volatile("s_waitcnt vmcnt(0)" ::: "memory");
            const unsigned og = xb_add(&bar[XB_TOP], 1u);
            const unsigned tg = og / nx;
            if (og + 1u == (tg + 1u) * nx) xb_add(&bar[XB_TOPGEN], 1u);
            else XB_SPIN(xb_ld(&bar[XB_TOPGEN]) == tg, bar);
            __builtin_amdgcn_fence(__ATOMIC_ACQUIRE, "agent");
            xb_add(&bar[XB_XGEN(b.x)], 1u);
            asm volatile("s_waitcnt vmcnt(0)" ::: "memory");
        } else {
            XB_SPIN(xb_ld(&bar[XB_XGEN(b.x)]) == gen, bar);
            __builtin_amdgcn_fence(__ATOMIC_ACQUIRE, "agent");
            asm volatile("s_waitcnt vmcnt(0)" ::: "memory");
        }
    }
    __syncthreads();
}


__device__ __forceinline__ float wave_sum(float v) {
#pragma unroll
    for (int o = 1; o < 64; o <<= 1) v += __shfl_xor(v, o);
    return v;
}
__device__ __forceinline__ float wave_max(float v) {
#pragma unroll
    for (int o = 1; o < 64; o <<= 1) v = fmaxf(v, __shfl_xor(v, o));
    return v;
}
typedef __bf16 bf16x2_t __attribute__((ext_vector_type(2)));
__device__ __forceinline__ unsigned cvtpk(float lo, float hi) { f32x2 v = {lo, hi}; bf16x2_t b = __builtin_convertvector(v, bf16x2_t); return __builtin_bit_cast(unsigned, b); }
__device__ __forceinline__ float sigmoidf_(float x) { return 1.f / (1.f + expf(-x)); }
__device__ __forceinline__ float gelu_tanh(float x) { const float u = 0.7978845608028654f * (x + 0.044715f * x * x * x); return 0.5f * x * (1.f + tanhf(u)); }
__device__ __forceinline__ void sincos_acc(float ang, float& c, float& s) {
    const double x = (double)ang, q = rint(x * 0.63661977236758134), r = x - q * 1.5707963267948966;
    const int qi = ((int)q) & 3; const float rf = (float)r, r2 = rf * rf;
    const float sp = rf * (1.f + r2 * (-1.6666667e-1f + r2 * (8.3333333e-3f + r2 * (-1.9841270e-4f + r2 * 2.7557319e-6f))));
    const float cp = 1.f + r2 * (-0.5f + r2 * (4.1666667e-2f + r2 * (-1.3888889e-3f + r2 * (2.4801587e-5f - r2 * 2.7557319e-7f))));
    c = (qi == 0) ? cp : (qi == 1) ? -sp : (qi == 2) ? -cp : sp;
    s = (qi == 0) ? sp : (qi == 1) ? cp : (qi == 2) ? -sp : -cp;
}

#define AS4 __attribute__((address_space(4)))
typedef const void* cvp_t;
struct Ctx {
    LAS unsigned char* lds; volatile LAS unsigned* MISC; LAS unsigned char* lds0;
    unsigned* ctl; unsigned char* ws;
    int tid, lane, wave, G, blk, lo, hi;
    const AS4 cvp_t* in;
};

__device__ __forceinline__ bool launder(Ctx& F) { int t = threadIdx.x; asm volatile("" : "+v"(t)); F.tid = t; F.lane = t & 63; F.wave = __builtin_amdgcn_readfirstlane(t >> 6);
    int z = 0; asm volatile("" : "+s"(z));
    const AS4 char* ka = (const AS4 char*)__builtin_amdgcn_kernarg_segment_ptr() + z;
    F.in = (const AS4 cvp_t*)ka; F.ws = *(unsigned char* const AS4*)(ka + 25 * 8 + 8); F.ctl = (unsigned*)(F.ws + WS_CTL);
    F.lds = F.lds0 + z; F.MISC = (volatile LAS unsigned*)(F.lds + MISC_OFF);
    F.G = (int)gridDim.x + z; F.blk = (int)blockIdx.x + z; F.lo = *(const AS4 int*)(ka + 25 * 8 + 16); F.hi = *(const AS4 int*)(ka + 25 * 8 + 20); return true; }

__device__ __forceinline__ void p0_transpose_item(const float* W, int K, int N, bf16* WT, int dstrow0, LAS float* scr, int k0, int n0, int lane) {
    f32x4 ld[8];
#pragma unroll
    for (int i = 0; i < 8; ++i) ld[i] = *(const f32x4*)(W + (size_t)(k0 + (lane >> 3) + 8 * i) * N + n0 + 4 * (lane & 7));
#pragma unroll
    for (int i = 0; i < 8; ++i) { LAS float* s = scr + ((lane >> 3) + 8 * i) * 33 + 4 * (lane & 7); s[0] = ld[i][0]; s[1] = ld[i][1]; s[2] = ld[i][2]; s[3] = ld[i][3]; }
    LDS_WAIT(); asm volatile("" ::: "memory");
    const int c = lane & 7;
#pragma unroll
    for (int j = 0; j < 4; ++j) { const int n = (lane >> 3) + 8 * j; const LAS float* s = scr + (8 * c) * 33 + n;
        v4u o; o.x = pk2(s[0 * 33], s[1 * 33]); o.y = pk2(s[2 * 33], s[3 * 33]); o.z = pk2(s[4 * 33], s[5 * 33]); o.w = pk2(s[6 * 33], s[7 * 33]);
        *(GAS v4u*)(WT + (size_t)(dstrow0 + n) * K + k0 + 8 * c) = o; }
    LDS_WAIT(); asm volatile("" ::: "memory");
}
__device__ __forceinline__ void p0_prologue(const Ctx& F) {
    const float* c_in = (const float*)F.in[1]; const int* pos_in = (const int*)F.in[2];
    const float* mod_w = (const float*)F.in[3]; const float* mod_b = (const float*)F.in[4];
    {
        __syncthreads();
        LAS float* cs_s = (LAS float*)F.lds;
        LAS float* red = (LAS float*)(F.lds + 32768);
        for (int i = F.tid; i < 8192; i += NTHR) { const int b = i >> 10, k = i & 1023; const float v = c_in[i]; cs_s[k * 8 + b] = v / (1.f + expf(-v)); }
        __syncthreads();
        float* MOD = (float*)(F.ws + WS_MOD);
        const int kq = F.tid >> 6, col = F.tid & 63;
        for (int it = F.blk; it < 4 * 96; it += F.G) {
            const int l = it / 96, nb = it % 96;
            float acc[8];
#pragma unroll
            for (int b = 0; b < 8; ++b) acc[b] = 0.f;
            const float* wp = mod_w + ((size_t)l * 1024 + kq * 128) * 6144 + nb * 64 + col;
#pragma unroll 16
            for (int k = 0; k < 128; ++k) { const float w = wp[(size_t)k * 6144];
                const f32x4 c0 = *(const LAS f32x4*)(cs_s + (kq * 128 + k) * 8), c1 = *(const LAS f32x4*)(cs_s + (kq * 128 + k) * 8 + 4);
                acc[0] += c0[0] * w; acc[1] += c0[1] * w; acc[2] += c0[2] * w; acc[3] += c0[3] * w; acc[4] += c1[0] * w; acc[5] += c1[1] * w; acc[6] += c1[2] * w; acc[7] += c1[3] * w; }
#pragma unroll
            for (int b = 0; b < 8; ++b) red[(kq * 8 + b) * 64 + col] = acc[b];
            __syncthreads();
            { const int b = F.tid >> 6; float s = mod_b[l * 6144 + nb * 64 + col];
#pragma unroll
              for (int q = 0; q < 8; ++q) s += red[(q * 8 + b) * 64 + col];
              MOD[((size_t)l * 8 + b) * 6144 + nb * 64 + col] = s; }
            __syncthreads();
        }
    }
    {
        float* ROT = (float*)(F.ws + WS_ROT);
        for (int idx = F.blk * NTHR + F.tid; idx < T * 8; idx += F.G * NTHR) { const int row = idx >> 3, i = idx & 7;
            const float invf = exp2f(-(float)i * (18.931568569324174f / 8.0f));
            const float ang = (float)pos_in[row] * invf; float c, s; sincos_acc(ang, c, s);
            *(f32x2*)(ROT + (size_t)idx * 2) = (f32x2){c, s}; }
    }
    {
        bf16* WG = (bf16*)(F.ws + WS_LRUW);
        for (int idx = F.blk * NTHR + F.tid; idx < 2 * 2 * 2 * 8 * 4096; idx += F.G * NTHR) { const int jj = idx & 7, hq = (idx >> 3) & 1, s = (idx >> 4) & 3, out = (idx >> 6) & 63, hd = (idx >> 12) & 7, dr = (idx >> 15) & 1, ty = (idx >> 16) & 1, jl = idx >> 17;
            const int in_ = 16 * s + 8 * (jj >> 2) + 4 * hq + (jj & 3);
            const float* src = (const float*)F.in[ty ? 14 : 12]; WG[idx] = (bf16)f2bf(src[((size_t)((jl * 2 + dr) * 8 + hd) * 64 + in_) * 64 + out]); }
        float* MC = (float*)(F.ws + WS_MCST);
        for (int idx = F.blk * NTHR + F.tid; idx < 2 * 2 * 3 * 512; idx += F.G * NTHR) { const int cc = idx & 511, k = (idx >> 9) % 3, jd = idx / 1536;
            const float* src = (const float*)F.in[k == 0 ? 13 : (k == 1 ? 15 : 16)]; float v = src[jd * 512 + cc]; if (k == 2) v = log1pf(expf(-v)); MC[idx] = v; }
    }
    {
        LAS float* scr = (LAS float*)(F.lds + F.wave * 16384);
        const int gw = F.blk * NWAVES + F.wave, NGW = F.G * NWAVES;
        constexpr int I_IN = 2 * 16 * 80, I_OUT = 2 * 16 * 32, I_QKV = 2 * 16 * 96, I_O = 2 * 16 * 32, I_G = 64 * 256, I_U = 64 * 256, I_D = 64 * 256;
        constexpr int NITEMS = I_IN + I_OUT + I_QKV + I_O + I_G + I_U + I_D;
        for (int it = gw; it < NITEMS; it += NGW) {
            int r = it;
            if (r < I_IN) { const int mt = r / 1280, q = r % 1280, kb = q / 80, nb = q % 80;
                p0_transpose_item((const float*)F.in[8] + (size_t)mt * 1024 * 2560, 1024, 2560, (bf16*)(F.ws + WS_WIN) + (size_t)mt * 2560 * 1024, nb * 32, scr, kb * 64, nb * 32, F.lane); continue; } r -= I_IN;
            if (r < I_OUT) { const int mt = r / 512, q = r % 512, kb = q / 32, nb = q % 32;
                p0_transpose_item((const float*)F.in[17] + (size_t)mt * 1024 * 1024, 1024, 1024, (bf16*)(F.ws + WS_WOUT) + (size_t)mt * 1024 * 1024, nb * 32, scr, kb * 64, nb * 32, F.lane); continue; } r -= I_OUT;
            if (r < I_QKV) { const int mt = r / 1536, q = r % 1536, kb = q / 96, nb = q % 96;
                p0_transpose_item((const float*)F.in[18] + (size_t)mt * 1024 * 3072, 1024, 3072, (bf16*)(F.ws + WS_WQKV) + (size_t)mt * 3072 * 1024, nb * 32, scr, kb * 64, nb * 32, F.lane); continue; } r -= I_QKV;
            if (r < I_O) { const int mt = r / 512, q = r % 512, kb = q / 32, nb = q % 32;
                p0_transpose_item((const float*)F.in[19] + (size_t)mt * 1024 * 1024, 1024, 1024, (bf16*)(F.ws + WS_WO) + (size_t)mt * 1024 * 1024, nb * 32, scr, kb * 64, nb * 32, F.lane); continue; } r -= I_O;
            if (r < I_G + I_U) { const int up = (r >= I_G) ? 1 : 0; r -= up * I_G; const int mt = r / 256, q = r % 256, kb = q / 16, nb = q % 16, n0 = nb * 32;
                p0_transpose_item((const float*)F.in[22 + up] + (size_t)mt * 1024 * 512, 1024, 512, (bf16*)(F.ws + WS_WGU) + (size_t)mt * 1024 * 1024, (n0 >> 7) * 256 + (n0 & 127) + up * 128, scr, kb * 64, n0, F.lane); continue; } r -= I_G + I_U;
            { const int mt = r / 256, q = r % 256, kb = q / 32, nb = q % 32;
                p0_transpose_item((const float*)F.in[24] + (size_t)mt * 512 * 1024, 512, 1024, (bf16*)(F.ws + WS_WDN) + (size_t)mt * 1024 * 512, nb * 32, scr, kb * 64, nb * 32, F.lane); }
        }
    }
}

template <int NDELTA, bool ROUTE, bool FINAL>
__device__ __forceinline__ void norm_phase(const Ctx& F, const float* xin, float* xout, const bf16* delta, const float* gate, const float* gvec, const float* shift, const float* scale,
                                           bf16* hout, float* fout, unsigned* gcnt) {
    LAS float* rw_s = (LAS float*)F.lds;
    volatile LAS unsigned* lcnt = F.MISC + 40; volatile LAS unsigned* lbase = F.MISC + 56; volatile LAS unsigned* nent = F.MISC + 72;
    LAS unsigned* ent = (LAS unsigned*)(F.lds + ENT_OFF);
    if (ROUTE) {
        const float* rw = (const float*)F.in[20];
        for (int i = F.tid; i < 16384; i += NTHR) { const int k = i >> 4, e = i & 15; rw_s[e * 1024 + k] = rw[i]; }
        if (F.tid < 16) lcnt[F.tid] = 0u; if (F.tid == 16) nent[0] = 0u;
        __syncthreads();
    }
    const float* rbias = (const float*)F.in[21];
    const int ngrp = T / NWAVES;
    constexpr int RPW = 4;
    for (int rg0 = F.blk; rg0 < ngrp; rg0 += RPW * F.G) {
        f32x4 v[RPW][4]; float ss[RPW];
#pragma unroll
        for (int u = 0; u < RPW; ++u) { const int rg = rg0 + u * F.G; const int row = (rg < ngrp ? rg : rg0) * NWAVES + F.wave, b = row >> 11;
            ss[u] = 0.f;
#pragma unroll
            for (int j = 0; j < 4; ++j) { const int col = 4 * F.lane + 256 * j;
                v[u][j] = *(const f32x4*)(xin + (size_t)row * D + col);
                if (NDELTA >= 1) {
                    const f32x4 g4 = *(const f32x4*)(gate + (size_t)b * 6144 + col);
                    f32x4 dl;
                    if (NDELTA == 1) { const v2u w = *(const v2u*)(delta + (size_t)row * D + col); dl = (f32x4){bflo(w.x), bfhi(w.x), bflo(w.y), bfhi(w.y)}; }
                    else { const v2u w0 = *(const v2u*)(delta + (size_t)row * 2 * D + col), w1 = *(const v2u*)(delta + (size_t)row * 2 * D + D + col);
                        dl = (f32x4){bflo(w0.x) + bflo(w1.x), bfhi(w0.x) + bfhi(w1.x), bflo(w0.y) + bflo(w1.y), bfhi(w0.y) + bfhi(w1.y)}; }
                    v[u][j] = v[u][j] + g4 * dl;
                }
                ss[u] += (v[u][j][0] * v[u][j][0] + v[u][j][1] * v[u][j][1]) + (v[u][j][2] * v[u][j][2] + v[u][j][3] * v[u][j][3]);
            }
        }
#pragma unroll
        for (int u = 0; u < RPW; ++u) { const int rg = rg0 + u * F.G; if (rg >= ngrp) continue;
            const int row = rg * NWAVES + F.wave, b = row >> 11;
            if (!FINAL) {
#pragma unroll
                for (int j = 0; j < 4; ++j) *(f32x4*)(xout + (size_t)row * D + 4 * F.lane + 256 * j) = v[u][j]; }
            const float rstd = 1.0f / sqrtf(wave_sum(ss[u]) * (1.0f / D) + 1e-6f);
#pragma unroll
            for (int j = 0; j < 4; ++j) { const int col = 4 * F.lane + 256 * j;
                const f32x4 g4 = *(const f32x4*)(gvec + col);
                f32x4 y = v[u][j] * rstd * g4;
                if (FINAL) { *(f32x4*)(fout + (size_t)row * D + col) = y; }
                else { const f32x4 sc = *(const f32x4*)(scale + (size_t)b * 6144 + col), sh = *(const f32x4*)(shift + (size_t)b * 6144 + col);
                    y = y * (1.0f + sc) + sh; v[u][j] = y;
                    v2u w; w.x = pk2(y[0], y[1]); w.y = pk2(y[2], y[3]); *(v2u*)(hout + (size_t)row * D + col) = w; }
            }
            if (ROUTE) {
                float lg[16];
#pragma unroll
                for (int e = 0; e < 16; ++e) { float a = 0.f;
#pragma unroll
                    for (int j = 0; j < 4; ++j) { const f32x4 w = *(const LAS f32x4*)(rw_s + e * 1024 + 256 * j + 4 * F.lane); a += (v[u][j][0] * w[0] + v[u][j][1] * w[1]) + (v[u][j][2] * w[2] + v[u][j][3] * w[3]); }
                    lg[e] = wave_sum(a); }
                float sc[16], bi[16];
#pragma unroll
                for (int e = 0; e < 16; ++e) { sc[e] = sigmoidf_(lg[e]); bi[e] = sc[e] + rbias[e]; }
                float bestgs = -1e30f, s1 = 0.f, s2 = 0.f; int e1 = 0, e2 = 1;
#pragma unroll
                for (int g = 0; g < 4; ++g) {
                    float m1 = bi[4 * g], t1 = sc[4 * g]; int i1 = 0;
#pragma unroll
                    for (int k = 1; k < 4; ++k) if (bi[4 * g + k] > m1) { m1 = bi[4 * g + k]; t1 = sc[4 * g + k]; i1 = k; }
                    float m2 = -1e30f, t2 = 0.f; int i2 = 0;
#pragma unroll
                    for (int k = 0; k < 4; ++k) if (k != i1 && bi[4 * g + k] > m2) { m2 = bi[4 * g + k]; t2 = sc[4 * g + k]; i2 = k; }
                    const float gs = m1 + m2;
                    if (gs > bestgs) { bestgs = gs; e1 = 4 * g + i1; e2 = 4 * g + i2; s1 = t1; s2 = t2; }
                }
                if (F.lane == 0) {
                    const float inv = 1.0f / (s1 + s2);
                    float* topw = (float*)(F.ws + WS_TOPW);
                    topw[row * 2] = s1 * inv; topw[row * 2 + 1] = s2 * inv;
                    const unsigned p1 = __hip_atomic_fetch_add((LAS unsigned*)&lcnt[e1], 1u, __ATOMIC_RELAXED, __HIP_MEMORY_SCOPE_WORKGROUP), p2 = __hip_atomic_fetch_add((LAS unsigned*)&lcnt[e2], 1u, __ATOMIC_RELAXED, __HIP_MEMORY_SCOPE_WORKGROUP), n = __hip_atomic_fetch_add((LAS unsigned*)&nent[0], 2u, __ATOMIC_RELAXED, __HIP_MEMORY_SCOPE_WORKGROUP);
                    ent[2 * n] = ((unsigned)e1 << 16) | p1; ent[2 * n + 1] = (unsigned)(row * 2);
                    ent[2 * n + 2] = ((unsigned)e2 << 16) | p2; ent[2 * n + 3] = (unsigned)(row * 2 + 1);
                }
            }
        }
    }
    if (ROUTE) {
        __syncthreads();
        if (F.tid < 16) lbase[F.tid] = __hip_atomic_fetch_add(gcnt + F.tid, lcnt[F.tid], RLX_AGENT);
        __syncthreads();
        int* list = (int*)(F.ws + WS_LIST); const unsigned n = nent[0];
        for (unsigned i = F.tid; i < n; i += NTHR) { const unsigned key = ent[2 * i], val = ent[2 * i + 1], e = key >> 16, p = key & 0xffffu; list[(size_t)e * T + lbase[e] + p] = (int)val; }
        __syncthreads();
    }
}

__device__ __forceinline__ void compute_tpre(const Ctx& F, unsigned* gcnt) {
    if (F.tid < 16) F.MISC[40 + F.tid] = __hip_atomic_load(gcnt + F.tid, RLX_AGENT);
    __syncthreads();
    if (F.tid == 0) { unsigned acc = 0;
        for (int e = 0; e < 16; ++e) { F.MISC[16 + e] = acc; acc += (F.MISC[40 + e] + 255u) >> 8; }
        F.MISC[32] = acc; }
    __syncthreads();
}
__device__ __forceinline__ void dispatch_phase(const Ctx& F, unsigned* gcnt) {
    compute_tpre(F, gcnt);
    const int gw = F.blk * NWAVES + F.wave, NGW = F.G * NWAVES;
    const int nrows = (int)F.MISC[32] * 256;
    const bf16* H = (const bf16*)(F.ws + WS_HB); bf16* XS = (bf16*)(F.ws + WS_R1 + R1_XS);
    const int* list = (const int*)(F.ws + WS_LIST); const float* topw = (const float*)(F.ws + WS_TOPW);
    int* sloti = (int*)(F.ws + WS_SLOTI); float* slotw = (float*)(F.ws + WS_SLOTW);
    for (int r0 = gw; r0 < nrows; r0 += 4 * NGW) {
        v4u a[4], bq[4]; int info[4]; float w[4];
#pragma unroll
        for (int u = 0; u < 4; ++u) { const int r = r0 + u * NGW; a[u] = (v4u){0u, 0u, 0u, 0u}; bq[u] = a[u]; info[u] = -1; w[u] = 0.f;
            if (r < nrows) { const int pt = r >> 8; int e = 0;
#pragma unroll
                for (int j = 1; j < 16; ++j) e += (pt >= (int)F.MISC[16 + j]) ? 1 : 0;
                const int pos = r - (int)F.MISC[16 + e] * 256, cnt = (int)F.MISC[40 + e];
                if (pos < cnt) info[u] = list[(size_t)e * T + pos]; } }
#pragma unroll
        for (int u = 0; u < 4; ++u) if (info[u] >= 0) { w[u] = topw[info[u]]; const v4u* src = (const v4u*)(H + (size_t)(info[u] >> 1) * D); a[u] = src[F.lane]; bq[u] = src[64 + F.lane]; }
#pragma unroll
        for (int u = 0; u < 4; ++u) { const int r = r0 + u * NGW; if (r < nrows) { v4u* dst = (v4u*)(XS + (size_t)r * D); dst[F.lane] = a[u]; dst[64 + F.lane] = bq[u];
            if (F.lane == 0) { sloti[r] = info[u]; slotw[r] = w[u]; } } }
    }
}

typedef short mx_bf16x8 __attribute__((ext_vector_type(8)));
typedef float mx_f32x16 __attribute__((ext_vector_type(16)));
__device__ __forceinline__ float fgelu_tanh(float x);
__device__ __forceinline__ float fsigmoid(float x) { return __builtin_amdgcn_rcpf(1.f + __builtin_amdgcn_exp2f(-1.4426950408889634f * x)); }
__device__ __forceinline__ float fgelu_tanh(float x) { return x * fsigmoid(1.5957691216057308f * x * (1.0f + 0.044715f * x * x)); }
template <int CTRL> __device__ __forceinline__ float dpp_f(float old, float src) { return __builtin_bit_cast(float, __builtin_amdgcn_update_dpp(__builtin_bit_cast(int, old), __builtin_bit_cast(int, src), CTRL, 0xF, 0xF, false)); }
template <int PAT> __device__ __forceinline__ float swz_f(float v) { return __builtin_bit_cast(float, __builtin_amdgcn_ds_swizzle(__builtin_bit_cast(int, v), PAT)); }
template <int CTRL> __device__ __forceinline__ void scan_step(float (&a)[16], float (&b)[16]) {
#pragma unroll
    for (int i = 0; i < 16; ++i) { const float ap = dpp_f<CTRL>(1.0f, a[i]), bp = dpp_f<CTRL>(0.0f, b[i]); b[i] = a[i] * bp + b[i]; a[i] = a[i] * ap; }
}
template <bool OUT>
__device__ __forceinline__ void mix_phase(const Ctx& F, int jl) {
    const char* Zc = (const char*)(F.ws + WS_R1 + R1_Z); char* Yc = (char*)(F.ws + WS_HB);
    f32x2* AGG = (f32x2*)(F.ws + WS_R1 + R1_AGG); const float* CARRY = (const float*)(F.ws + WS_R1 + R1_CARRY);
    const bf16* WG = (const bf16*)(F.ws + WS_LRUW) + (size_t)jl * 2 * 2 * 8 * 4096;
    const float* MC = (const float*)(F.ws + WS_MCST) + (size_t)jl * 2 * 3 * 512;
    const float* conv_a_w = (const float*)F.in[9] + (size_t)jl * 3 * 512; const float* conv_b_w = (const float*)F.in[10] + (size_t)jl * 4 * 512; const float* conv_b_b = (const float*)F.in[11] + (size_t)jl * 512;
    const int lane = F.lane, r32 = lane & 31, hh = lane >> 5;
    const int gw = F.blk * NWAVES + F.wave, NGW = F.G * NWAVES;
    for (int wu = gw; wu < 8 * 64 * 8; wu += NGW) {
        const int h = wu & 7, c = (wu >> 3) & 63, b = wu >> 9, t0 = c * 32, t = t0 + r32, rbi = b * SEQ;
        float xr[2][16];
#pragma unroll
        for (int g = 0; g < 2; ++g) {
            __builtin_amdgcn_sched_barrier(0);
#pragma unroll
            for (int q = 0; q < 4; ++q) { const int chq = h * 64 + 32 * g + 8 * q + 4 * hh;
                f32x4 a4 = *(const f32x4*)(conv_b_b + chq);
#pragma unroll
                for (int k = 0; k < 4; ++k) { const int ts = t + k - 1; const bool ok = ts >= 0 && ts < SEQ; const int tc = ok ? ts : t;
                    const v2u w = *(const v2u*)(Zc + ((unsigned)(rbi + tc) * IN_AB + 2048u + chq) * 2u); f32x4 w4 = *(const f32x4*)(conv_b_w + k * 512 + chq);
                    if (!ok) w4 = (f32x4){0.f, 0.f, 0.f, 0.f};
                    a4 = a4 + w4 * (f32x4){bflo(w.x), bfhi(w.x), bflo(w.y), bfhi(w.y)}; }
                xr[g][4 * q] = a4[0]; xr[g][4 * q + 1] = a4[1]; xr[g][4 * q + 2] = a4[2]; xr[g][4 * q + 3] = a4[3]; } }
        __builtin_amdgcn_sched_barrier(0);
        mx_bf16x8 xb[4];
#pragma unroll
        for (int s = 0; s < 4; ++s) { const int g = s >> 1, o = 8 * (s & 1); v4u p; p.x = cvtpk(xr[g][o], xr[g][o + 1]); p.y = cvtpk(xr[g][o + 2], xr[g][o + 3]); p.z = cvtpk(xr[g][o + 4], xr[g][o + 5]); p.w = cvtpk(xr[g][o + 6], xr[g][o + 7]);
            xb[s] = __builtin_bit_cast(mx_bf16x8, p); }
#pragma nounroll
        for (int mt = 0; mt < 2; ++mt) {
            float hrec[16];
#pragma unroll
            for (int i = 0; i < 16; ++i) hrec[i] = 0.f;
            const v4u pa = mt ? __builtin_bit_cast(v4u, xb[2]) : __builtin_bit_cast(v4u, xb[0]), pb = mt ? __builtin_bit_cast(v4u, xb[3]) : __builtin_bit_cast(v4u, xb[1]);
#pragma unroll
            for (int dir = 0; dir < 2; ++dir) {
                __builtin_amdgcn_sched_barrier(0);
                mx_f32x16 accr, acci;
#pragma unroll
                for (int i = 0; i < 16; ++i) { accr[i] = 0.f; acci[i] = 0.f; }
                const unsigned wro = ((unsigned)(((0 * 2 + dir) * 8 + h) * 64 + 32 * mt + r32) * 64u + 8u * hh) * 2u, wxo = wro + 2u * 8u * 4096u * 2u;
#pragma unroll
                for (int s = 0; s < 4; ++s) { const mx_bf16x8 ar = *(const mx_bf16x8*)((const char*)WG + wro + 32u * s), ax = *(const mx_bf16x8*)((const char*)WG + wxo + 32u * s);
                    accr = __builtin_amdgcn_mfma_f32_32x32x16_bf16(ar, xb[s], accr, 0, 0, 0); acci = __builtin_amdgcn_mfma_f32_32x32x16_bf16(ax, xb[s], acci, 0, 0, 0); }
                float av[16], bv[16];
#pragma unroll
                for (int q = 0; q < 4; ++q) { const int cl = h * 64 + 32 * mt + 8 * q + 4 * hh;
                    const f32x4 ba = *(const f32x4*)(MC + (dir * 3 + 0) * 512 + cl), bx = *(const f32x4*)(MC + (dir * 3 + 1) * 512 + cl), sp = *(const f32x4*)(MC + (dir * 3 + 2) * 512 + cl);
#pragma unroll
                    for (int e = 0; e < 4; ++e) { const int i = 4 * q + e;
                        const float r = fsigmoid(accr[i] + ba[e]), ig = fsigmoid(acci[i] + bx[e]);
                        const float a = __builtin_amdgcn_exp2f(-8.0f * 1.4426950408889634f * r * sp[e]);
                        const unsigned xw = (i < 8) ? pa[(i & 7) >> 1] : pb[(i & 7) >> 1];
                        av[i] = a; bv[i] = ((i & 1) ? bfhi(xw) : bflo(xw)) * ig * __builtin_amdgcn_sqrtf(fmaxf(1.0f - a * a, 0.f)); } }
                if (dir == 0) { scan_step<0x111>(av, bv); scan_step<0x112>(av, bv); scan_step<0x114>(av, bv); scan_step<0x118>(av, bv);
#pragma unroll
                    for (int i = 0; i < 16; ++i) { const float ap = swz_f<0x1E0>(av[i]), bp = swz_f<0x1E0>(bv[i]); if (r32 >= 16) { bv[i] = av[i] * bp + bv[i]; av[i] = av[i] * ap; } } }
                else { scan_step<0x101>(av, bv); scan_step<0x102>(av, bv); scan_step<0x104>(av, bv); scan_step<0x108>(av, bv);
#pragma unroll
                    for (int i = 0; i < 16; ++i) { const float ap = swz_f<0x200>(av[i]), bp = swz_f<0x200>(bv[i]); if (r32 < 16) { bv[i] = av[i] * bp + bv[i]; av[i] = av[i] * ap; } } }
                const unsigned gb = ((unsigned)(b * 2 + dir) * 64u + c) * 512u + h * 64 + 32 * mt + 4 * hh;
                if (!OUT) {
                    if (r32 == (dir ? 0 : 31)) {
#pragma unroll
                        for (int i = 0; i < 16; ++i) *(f32x2*)((char*)AGG + (gb + (i & 3) + 8 * (i >> 2)) * 8u) = (f32x2){av[i], bv[i]}; }
                } else {
#pragma unroll
                    for (int q = 0; q < 4; ++q) { const f32x4 cin = *(const f32x4*)((const char*)CARRY + (gb + 8 * q) * 4u);
#pragma unroll
                        for (int e = 0; e < 4; ++e) hrec[4 * q + e] += av[4 * q + e] * cin[e] + bv[4 * q + e]; }
                }
            }
            if (OUT) {
#pragma unroll
                for (int q = 0; q < 4; ++q) { const int chq = h * 64 + 32 * mt + 8 * q + 4 * hh;
                    const v2u w = *(const v2u*)(Zc + ((unsigned)(rbi + t) * IN_AB + 1536u + chq) * 2u);
                    v2u o; o.x = cvtpk(fgelu_tanh(bflo(w.x)) * hrec[4 * q], fgelu_tanh(bfhi(w.x)) * hrec[4 * q + 1]); o.y = cvtpk(fgelu_tanh(bflo(w.y)) * hrec[4 * q + 2], fgelu_tanh(bfhi(w.y)) * hrec[4 * q + 3]);
                    *(v2u*)(Yc + ((unsigned)(rbi + t) * D + 512u + chq) * 2u) = o; }
            }
        }
        if (!OUT) {
            const int ch = h * 64 + lane; const unsigned zl = (unsigned)ch * 2u;
            float wA[3];
#pragma unroll
            for (int k = 0; k < 3; ++k) wA[k] = conv_a_w[k * 512 + ch];
            float prod[34];
#pragma unroll
            for (int u = 0; u < 34; ++u) { const int ts = t0 + u - 1; const bool ok = ts >= 0 && ts < SEQ; const int tc = ok ? ts : t0; const unsigned zk = zl + (unsigned)(rbi + tc) * (IN_AB * 2u);
                const float p = bf2f(*(const bf16*)(Zc + zk + 2048u)) * bf2f(*(const bf16*)(Zc + zk)); prod[u] = ok ? p : 0.f; }
#pragma unroll
            for (int u = 0; u < 32; ++u) { const unsigned zr = zl + (unsigned)(rbi + t0 + u) * (IN_AB * 2u);
                const float ya = bf2f(*(const bf16*)(Zc + zr + 1024u)) * (wA[0] * prod[u] + wA[1] * prod[u + 1] + wA[2] * prod[u + 2]);
                *(bf16*)(Yc + ((unsigned)(rbi + t0 + u) * D + ch) * 2u) = (bf16)f2bf(ya); }
        }
    }
}
__device__ __forceinline__ void carry_phase(const Ctx& F) {
    const f32x2* AGG = (const f32x2*)(F.ws + WS_R1 + R1_AGG); float* CARRY = (float*)(F.ws + WS_R1 + R1_CARRY);
    const int gw = F.blk * NWAVES + F.wave, NGW = F.G * NWAVES;
    for (int item = gw; item < 128; item += NGW) { const int bd = item >> 3, ch = (item & 7) * 64 + F.lane, dir = bd & 1;
        f32x2 pg[64];
#pragma unroll
        for (int cc = 0; cc < 64; ++cc) pg[cc] = AGG[((size_t)bd * 64 + cc) * 512 + ch];
        float hsv = 0.f;
        if (dir == 0) {
#pragma unroll
            for (int cc = 0; cc < 64; ++cc) { CARRY[((size_t)bd * 64 + cc) * 512 + ch] = hsv; hsv = pg[cc].x * hsv + pg[cc].y; } }
        else {
#pragma unroll
            for (int cc = 63; cc >= 0; --cc) { CARRY[((size_t)bd * 64 + cc) * 512 + ch] = hsv; hsv = pg[cc].x * hsv + pg[cc].y; } }
    }
}

__device__ __forceinline__ void attn_naive_phase(const Ctx& F) {
    const bf16* QKV = (const bf16*)(F.ws + WS_R1 + R1_Z); bf16* Y = (bf16*)(F.ws + WS_HB);
    LAS float* qs = (LAS float*)(F.lds + F.wave * 4096);
    LAS float* ps = qs + 64;
    const int gw = F.blk * NWAVES + F.wave, NGW = F.G * NWAVES;
    for (int unit = gw; unit < T * 16; unit += NGW) {
        const int row = unit >> 4, hd = unit & 15, b = row >> 11, t = row & 2047; const size_t rb = (size_t)b * SEQ;
        qs[F.lane] = bf2f(QKV[(size_t)row * NQKV + hd * 64 + F.lane]) * 0.125f;
        LDS_WAIT(); asm volatile("" ::: "memory");
        float sc[7]; float mx = -1e30f;
#pragma unroll
        for (int i = 0; i < 7; ++i) { const int n = F.lane + 64 * i, p = n / 129, jj = n - p * 129 - 64, dd = (p == 0) ? 1 : (p == 1) ? 4 : 16, tk = t + dd * jj;
            const bool valid = (n < 387) && tk >= 0 && tk < SEQ; float dot = -1e30f;
            if (valid) { const v4u* kp = (const v4u*)(QKV + (rb + tk) * NQKV + 1024 + hd * 64); dot = 0.f;
#pragma unroll
                for (int q = 0; q < 8; ++q) { const v4u w = kp[q]; const LAS float* qq = qs + q * 8;
                    dot += qq[0] * bflo(w.x) + qq[1] * bfhi(w.x) + qq[2] * bflo(w.y) + qq[3] * bfhi(w.y) + qq[4] * bflo(w.z) + qq[5] * bfhi(w.z) + qq[6] * bflo(w.w) + qq[7] * bfhi(w.w); } }
            sc[i] = dot; mx = fmaxf(mx, dot); }
        mx = wave_max(mx); float sum = 0.f;
#pragma unroll
        for (int i = 0; i < 7; ++i) { const float pr = (sc[i] > -1e29f) ? expf(sc[i] - mx) : 0.f; ps[F.lane + 64 * i] = pr; sum += pr; }
        sum = wave_sum(sum);
        LDS_WAIT(); asm volatile("" ::: "memory");
        float o = 0.f;
#pragma unroll
        for (int p = 0; p < 3; ++p) { const int dd = (p == 0) ? 1 : (p == 1) ? 4 : 16;
#pragma unroll 4
            for (int jj = -64; jj <= 64; ++jj) { const int tk = t + dd * jj; if (tk < 0 || tk >= SEQ) continue;
                o += ps[p * 129 + jj + 64] * bf2f(QKV[(rb + tk) * NQKV + 2048 + hd * 64 + F.lane]); } }
        Y[(size_t)row * D + hd * 64 + F.lane] = (bf16)f2bf(o / sum);
        LDS_WAIT(); asm volatile("" ::: "memory");
    }
}

typedef short bf16x8 __attribute__((ext_vector_type(8)));
typedef short s16x4 __attribute__((ext_vector_type(4)));
typedef float f32x16 __attribute__((ext_vector_type(16)));
typedef short v4i16_t __attribute__((ext_vector_type(4)));
constexpr int ATT_STO = 69632, ATT_STM = 69632 + 65536;
template <int MODE> __device__ __forceinline__ bool attn_tile_info(int ti, int w, int r16, int qt0, int& d, int& ktok0) {
    if (MODE == 0) {
        if (ti < 5) { const int tt = (ti == 0) ? 2 : (ti <= 2 ? ti - 1 : ti); const int jt = 32 * w - 64 + 32 * tt; d = 16; ktok0 = r16 + 16 * jt; return jt >= 0 && jt < 128; }
        const int jt = 128 * w - 64 + 32 * (ti - 5); d = 4; ktok0 = (r16 & 3) + 4 * jt; return jt >= 0 && jt < 512;
    }
    d = 1; ktok0 = qt0 - 64 + 32 * ti; return ktok0 >= 0 && ktok0 < SEQ;
}
template <int MODE, int NT>
__device__ __forceinline__ void attn_run(const bf16* kbase, LAS unsigned char* kl, LAS unsigned char* vl, int lane, int w, int r16, int qt0, int qtok, const bf16x8 (&qf)[4],
                                         f32x16& o0, f32x16& o1, float& mrun, float& lrun) {
    const int h = lane >> 5, r = lane & 31;
    const int srow = lane >> 3, sch = lane & 7;
    const unsigned kst = srow * 144 + sch * 16, vst = (sch >> 2) * 2048 + srow * 64 + (sch & 3) * 16;
    const unsigned krd = r * 144 + h * 16;
    const int gi = (lane >> 4) & 1, i16 = lane & 15;
    const unsigned vrd = (4 * h + (i16 >> 2)) * 64 + gi * 32 + (i16 & 3) * 8;
    const float cexp = 0.125f * 1.4426950408889634f;
    int d = 1, ktok0 = 0; bool inr = attn_tile_info<MODE>(0, w, r16, qt0, d, ktok0);
    v4u kg[4], vg[4];
#pragma unroll
    for (int i = 0; i < 4; ++i) { int tok = ktok0 + d * (srow + 8 * i); tok = tok < 0 ? 0 : (tok > SEQ - 1 ? SEQ - 1 : tok); const bf16* p = kbase + (size_t)tok * NQKV; kg[i] = *(const v4u*)p; vg[i] = *(const v4u*)(p + 1024); }
#pragma nounroll
    for (int ti = 0; ti < NT; ++ti) {
        const int dcur = d, kcur = ktok0; const bool inrcur = inr;
#pragma unroll
        for (int i = 0; i < 4; ++i) { *(LAS v4u*)(kl + kst + i * 8 * 144) = kg[i]; *(LAS v4u*)(vl + vst + i * 8 * 64) = vg[i]; }
        if (ti + 1 < NT) {
            inr = attn_tile_info<MODE>(ti + 1, w, r16, qt0, d, ktok0);
#pragma unroll
            for (int i = 0; i < 4; ++i) { int tok = ktok0 + d * (srow + 8 * i); tok = tok < 0 ? 0 : (tok > SEQ - 1 ? SEQ - 1 : tok); const bf16* p = kbase + (size_t)tok * NQKV; kg[i] = *(const v4u*)p; vg[i] = *(const v4u*)(p + 1024); }
        }
        f32x16 s;
#pragma unroll
        for (int i = 0; i < 16; ++i) s[i] = 0.f;
#pragma unroll
        for (int kk = 0; kk < 4; ++kk) { const bf16x8 kf = *(const LAS bf16x8*)(kl + krd + 32 * kk); s = __builtin_amdgcn_mfma_f32_32x32x16_bf16(kf, qf[kk], s, 0, 0, 0); }
        const int lim = 64 * dcur; const unsigned ub = (unsigned)(inrcur ? (kcur - qtok + dcur * 4 * h + lim) : 0x40000000), ul = 2u * (unsigned)lim; float mx = -1e30f;
#pragma unroll
        for (int i = 0; i < 16; ++i) { const unsigned u = ub + (unsigned)(dcur * ((i & 3) + 8 * (i >> 2))); s[i] = (u <= ul) ? s[i] : -1e30f; mx = fmaxf(mx, s[i]); }
        mx = fmaxf(mx, __shfl_xor(mx, 32));
        const float mnew = fmaxf(mrun, mx), alpha = __builtin_amdgcn_exp2f((mrun - mnew) * cexp), mc = mnew * cexp; mrun = mnew;
        float ps = 0.f;
#pragma unroll
        for (int i = 0; i < 16; ++i) { s[i] = __builtin_amdgcn_exp2f(s[i] * cexp - mc); ps += s[i]; }
        ps += __shfl_xor(ps, 32);
        lrun = lrun * alpha + ps;
#pragma unroll
        for (int i = 0; i < 16; ++i) { o0[i] *= alpha; o1[i] *= alpha; }
#pragma unroll
        for (int sx = 0; sx < 2; ++sx) {
            v4u pw; pw.x = cvtpk(s[8 * sx + 0], s[8 * sx + 1]); pw.y = cvtpk(s[8 * sx + 2], s[8 * sx + 3]); pw.z = cvtpk(s[8 * sx + 4], s[8 * sx + 5]); pw.w = cvtpk(s[8 * sx + 6], s[8 * sx + 7]);
            const bf16x8 pf = __builtin_bit_cast(bf16x8, pw);
#pragma unroll
            for (int dt = 0; dt < 2; ++dt) {
                const s16x4 va = __builtin_bit_cast(s16x4, __builtin_amdgcn_ds_read_tr16_b64_v4i16((LAS v4i16_t*)(vl + vrd + dt * 2048 + (16 * sx) * 64)));
                const s16x4 vb = __builtin_bit_cast(s16x4, __builtin_amdgcn_ds_read_tr16_b64_v4i16((LAS v4i16_t*)(vl + vrd + dt * 2048 + (16 * sx + 8) * 64)));
                const bf16x8 vf = {va[0], va[1], va[2], va[3], vb[0], vb[1], vb[2], vb[3]};
                if (dt == 0) o0 = __builtin_amdgcn_mfma_f32_32x32x16_bf16(vf, pf, o0, 0, 0, 0); else o1 = __builtin_amdgcn_mfma_f32_32x32x16_bf16(vf, pf, o1, 0, 0, 0);
            }
        }
    }
}
__device__ __forceinline__ void attn_phase(const Ctx& F) {
    const bf16* QKV = (const bf16*)(F.ws + WS_R1 + R1_Z); bf16* Y = (bf16*)(F.ws + WS_HB);
    LAS unsigned char* kl = F.lds + F.wave * 8704;
    LAS unsigned char* vl = kl + 4608;
    LAS unsigned char* sto = F.lds + ATT_STO; LAS f32x2* stm = (LAS f32x2*)(F.lds + ATT_STM);
    const int lane = F.lane, r = lane & 31, h = lane >> 5;
    for (int bu = F.blk; bu < 512; bu += F.G) {
        const int w = bu & 3, hd = (bu >> 2) & 15, b = bu >> 6; const size_t rb = (size_t)b * SEQ;
        const bf16* kbase = QKV + rb * NQKV + 1024 + hd * 64 + (lane & 7) * 8;
#pragma nounroll
        for (int sub = 0; sub < 2; ++sub) {
            const int r16 = 2 * F.wave + sub, tl = 16 * r + r16, qtok = w * 512 + tl;
            bf16x8 qf[4];
            { const bf16* qp = QKV + (rb + qtok) * NQKV + hd * 64 + 8 * h;
#pragma unroll
              for (int kk = 0; kk < 4; ++kk) qf[kk] = *(const bf16x8*)(qp + 16 * kk); }
            f32x16 o0, o1;
#pragma unroll
            for (int i = 0; i < 16; ++i) { o0[i] = 0.f; o1[i] = 0.f; }
            float mrun = -1e30f, lrun = 0.f;
            attn_run<0, 13>(kbase, kl, vl, lane, w, r16, 0, qtok, qf, o0, o1, mrun, lrun);
#pragma unroll
            for (int g = 0; g < 4; ++g) {
                v2u w0; w0.x = cvtpk(o0[4 * g], o0[4 * g + 1]); w0.y = cvtpk(o0[4 * g + 2], o0[4 * g + 3]); *(LAS v2u*)(sto + tl * 128 + (8 * g + 4 * h) * 2) = w0;
                v2u w1; w1.x = cvtpk(o1[4 * g], o1[4 * g + 1]); w1.y = cvtpk(o1[4 * g + 2], o1[4 * g + 3]); *(LAS v2u*)(sto + tl * 128 + (32 + 8 * g + 4 * h) * 2) = w1; }
            if (h == 0) stm[tl] = (f32x2){mrun, lrun};
        }
        __syncthreads();
#pragma nounroll
        for (int sub = 0; sub < 2; ++sub) {
            const int g32 = 2 * F.wave + sub, tl = 32 * g32 + r, qt0 = w * 512 + 32 * g32, qtok = qt0 + r;
            bf16x8 qf[4];
            { const bf16* qp = QKV + (rb + qtok) * NQKV + hd * 64 + 8 * h;
#pragma unroll
              for (int kk = 0; kk < 4; ++kk) qf[kk] = *(const bf16x8*)(qp + 16 * kk); }
            f32x16 o0, o1;
#pragma unroll
            for (int g = 0; g < 4; ++g) { const v2u w0 = *(const LAS v2u*)(sto + tl * 128 + (8 * g + 4 * h) * 2), w1 = *(const LAS v2u*)(sto + tl * 128 + (32 + 8 * g + 4 * h) * 2);
                o0[4 * g] = bflo(w0.x); o0[4 * g + 1] = bfhi(w0.x); o0[4 * g + 2] = bflo(w0.y); o0[4 * g + 3] = bfhi(w0.y);
                o1[4 * g] = bflo(w1.x); o1[4 * g + 1] = bfhi(w1.x); o1[4 * g + 2] = bflo(w1.y); o1[4 * g + 3] = bfhi(w1.y); }
            const f32x2 ml = stm[tl]; float mrun = ml.x, lrun = ml.y;
            attn_run<1, 5>(kbase, kl, vl, lane, w, 0, qt0, qtok, qf, o0, o1, mrun, lrun);
            const float inv = 1.0f / lrun;
            bf16* yp = Y + (rb + qtok) * D + hd * 64 + 4 * h;
#pragma unroll
            for (int g = 0; g < 4; ++g) {
                v2u w0; w0.x = cvtpk(o0[4 * g] * inv, o0[4 * g + 1] * inv); w0.y = cvtpk(o0[4 * g + 2] * inv, o0[4 * g + 3] * inv); *(v2u*)(yp + 8 * g) = w0;
                v2u w1; w1.x = cvtpk(o1[4 * g] * inv, o1[4 * g + 1] * inv); w1.y = cvtpk(o1[4 * g + 2] * inv, o1[4 * g + 3] * inv); *(v2u*)(yp + 32 + 8 * g) = w1; }
        }
        __syncthreads();
    }
}
#ifndef REP_P0
#define REP_P0 1
#endif
#ifndef REP_G1
#define REP_G1 1
#endif
#ifndef REP_MIX
#define REP_MIX 1
#endif
#ifndef REP_ATT
#define REP_ATT 1
#endif
#ifndef REP_G2
#define REP_G2 1
#endif
#ifndef REP_DISP
#define REP_DISP 1
#endif
#ifndef REP_GU
#define REP_GU 1
#endif
#ifndef REP_DN
#define REP_DN 1
#endif
#define REPEAT(n) _Pragma("unroll") for (int rep_ = 0; rep_ < (n); ++rep_)
#ifndef EN_P0
#define EN_P0 1
#endif
#ifndef EN_N1
#define EN_N1 1
#endif
#ifndef EN_G1E
#define EN_G1E 1
#endif
#ifndef EN_G1O
#define EN_G1O 1
#endif
#ifndef EN_MIXA
#define EN_MIXA 1
#endif
#ifndef EN_MIXB
#define EN_MIXB 1
#endif
#ifndef EN_ATT
#define EN_ATT 1
#endif
#ifndef EN_G2
#define EN_G2 1
#endif
#ifndef EN_N2
#define EN_N2 1
#endif
#ifndef EN_DISP
#define EN_DISP 1
#endif
#ifndef EN_GU
#define EN_GU 1
#endif
#ifndef EN_DN
#define EN_DN 1
#endif
#ifndef EN_FIN
#define EN_FIN 1
#endif

struct Args { const void* in[25]; float* out; unsigned char* ws; int ph_lo, ph_hi; };
constexpr int NPHASE = 2 + 10 * DEPTH;

__global__ void __launch_bounds__(NTHR, 2) fwd(Args args) {
    extern __shared__ __attribute__((aligned(16))) unsigned char lds[];
    Ctx F;
    F.lds0 = (LAS unsigned char*)lds; F.lds = F.lds0; F.MISC = (volatile LAS unsigned*)(F.lds + MISC_OFF);
    F.tid = threadIdx.x; F.lane = F.tid & 63; F.wave = __builtin_amdgcn_readfirstlane(F.tid >> 6);
    F.G = gridDim.x; F.blk = blockIdx.x; launder(F);
    for (int u = F.tid; u < 256; u += NTHR) ((LAS unsigned*)(F.lds + MISC_OFF))[u] = 0u;
    __syncthreads();
#if MK_ONE_LAUNCH
    XcdBarrier bar = xcd_barrier_post(F.ctl + CW_BAR, F.MISC + 8);
#ifndef REP_BAR
#define REP_BAR 1
#endif
#define GRID_BAR() do { _Pragma("unroll") for (int rb_ = 0; rb_ < REP_BAR; ++rb_) xcd_barrier(bar); } while (0)
#else
#define GRID_BAR() do { } while (0)
#endif
#define IN(k) (launder(F) && F.lo <= (k) && (k) < F.hi)
#define SEAM(k) do { if (IN(k) && IN((k) + 1)) GRID_BAR(); } while (0)
#define WSP (F.ws)
#define MOD ((const float*)(F.ws + WS_MOD))
#define X ((float*)(F.ws + WS_X))
#define HB ((bf16*)(F.ws + WS_HB))
#define R1Z ((bf16*)(F.ws + WS_R1 + R1_Z))
#define DELTA ((bf16*)(F.ws + WS_R1 + R1_DELTA))
#define XS ((bf16*)(F.ws + WS_R1 + R1_XS))
#define ACT ((bf16*)(F.ws + WS_R1 + R1_ACT))
#define YW ((bf16*)(F.ws + WS_R1 + R1_YW))

    if (EN_P0 && IN(0)) { REPEAT(REP_P0) p0_prologue(F); } SEAM(0);

    for (int l = 0; l < DEPTH; ++l) {
        const int base = 1 + 10 * l, jl = l >> 1; const bool even = (l & 1) == 0;
#define modl (MOD + (size_t)l * 8 * 6144)
#define gcnt (F.ctl + CW_CNT + 64 * l)
        if (EN_N1 && IN(base + 0)) {
            const float* gv = (const float*)F.in[5] + (size_t)l * D;
            if (l == 0) norm_phase<0, false, false>(F, (const float*)F.in[0], X, nullptr, nullptr, gv, modl + 0, modl + 1024, HB, nullptr, nullptr);
            else norm_phase<2, false, false>(F, X, X, YW, MOD + (size_t)(l - 1) * 8 * 6144 + 5120, gv, modl + 0, modl + 1024, HB, nullptr, nullptr);
        }
#if defined(PROBE_NORM)
        if (EN_N1 && IN(base + 0) && l > 0) norm_phase<2, false, false>(F, X, (float*)(WSP + WS_R1), YW, MOD + (size_t)(l - 1) * 8 * 6144 + 5120, (const float*)F.in[5] + (size_t)l * D, modl + 0, modl + 1024, (bf16*)(WSP + WS_R1 + 64 * MiB), nullptr, nullptr);
#endif
        SEAM(base + 0);
        if (IN(base + 1)) REPEAT(REP_G1) {
            if (!EN_G1E && even) {} else if (even) { pg8::StaticOrder S; S.init(HB, (const bf16*)(WSP + WS_WIN) + (size_t)jl * IN_AB * D, T, IN_AB, D, F.G, F.blk);
                pg8::EpiStore E{R1Z, IN_AB};
                pg8::gemm_phase<pg8::EpiStore, pg8::StaticOrder, true, true>(F.lds, D, S, E, F.tid); }
            else if (EN_G1O) { pg8::StaticOrder S; S.init(HB, (const bf16*)(WSP + WS_WQKV) + (size_t)jl * NQKV * D, T, NQKV, D, F.G, F.blk);
                pg8::EpiQKV E{R1Z, (const float*)(WSP + WS_ROT)};
                pg8::gemm_phase<pg8::EpiQKV, pg8::StaticOrder, true, true>(F.lds, D, S, E, F.tid); }
        }
        SEAM(base + 1);
        if (IN(base + 2)) { if (even) { if (EN_MIXA) REPEAT(REP_MIX) mix_phase<false>(F, jl); } else { if (EN_ATT) REPEAT(REP_ATT) attn_phase(F); } }
        SEAM(base + 2);
        if (IN(base + 3)) { if (even) carry_phase(F); }
        if (even) SEAM(base + 3);
        if (EN_MIXB && IN(base + 4)) { if (even) REPEAT(REP_MIX) mix_phase<true>(F, jl); }
        if (even) SEAM(base + 4);
        if (EN_G2 && IN(base + 5)) REPEAT(REP_G2) {
            pg8::StaticOrder S; S.init(HB, even ? (const bf16*)(WSP + WS_WOUT) + (size_t)jl * D * D : (const bf16*)(WSP + WS_WO) + (size_t)jl * D * D, T, D, D, F.G, F.blk);
            pg8::EpiStore E{DELTA, D};
            pg8::gemm_phase<pg8::EpiStore, pg8::StaticOrder, true, true>(F.lds, D, S, E, F.tid);
        }
        SEAM(base + 5);
        if (EN_N2 && IN(base + 6)) norm_phase<1, true, false>(F, X, X, DELTA, modl + 2048, (const float*)F.in[6] + (size_t)l * D, modl + 3072, modl + 4096, HB, nullptr, gcnt);
#if defined(PROBE_NORM)
        if (EN_N2 && IN(base + 6)) norm_phase<1, false, false>(F, X, (float*)(WSP + WS_R1 + 32 * MiB), DELTA, modl + 2048, (const float*)F.in[6] + (size_t)l * D, modl + 3072, modl + 4096, (bf16*)(WSP + WS_R1 + 96 * MiB), nullptr, nullptr);
#endif
        SEAM(base + 6);
        if (EN_DISP && IN(base + 7)) REPEAT(REP_DISP) dispatch_phase(F, gcnt);
        SEAM(base + 7);
        if (EN_GU && IN(base + 8)) REPEAT(REP_GU) {
            compute_tpre(F, gcnt);
            pg8::MoeOrder S; S.A = (const char*)XS; S.Bt = (const char*)((const bf16*)(WSP + WS_WGU) + (size_t)l * NE * 1024 * 1024); S.tstep = (size_t)256 * 1024 * 2; S.estride = (size_t)1024 * 1024 * 2; S.G = F.G; S.c = F.blk;
            S.tp = F.MISC + 16;
            pg8::EpiGU E{ACT};
            pg8::gemm_phase<pg8::EpiGU, pg8::MoeOrder, true, true>(F.lds, 1024, S, E, F.tid);
        }
        SEAM(base + 8);
        if (EN_DN && IN(base + 9)) REPEAT(REP_DN) {
            compute_tpre(F, gcnt);
            pg8::MoeOrder S; S.A = (const char*)ACT; S.Bt = (const char*)((const bf16*)(WSP + WS_WDN) + (size_t)l * NE * 1024 * 512); S.tstep = (size_t)256 * 512 * 2; S.estride = (size_t)1024 * 512 * 2; S.G = F.G; S.c = F.blk;
            S.tp = F.MISC + 16;
            pg8::EpiDN E{YW, (const int*)(WSP + WS_SLOTI), (const float*)(WSP + WS_SLOTW)};
            pg8::gemm_phase<pg8::EpiDN, pg8::MoeOrder, true, true>(F.lds, 512, S, E, F.tid);
        }
        SEAM(base + 9);
    }
    if (EN_FIN && IN(NPHASE - 1)) norm_phase<2, false, true>(F, X, nullptr, YW, MOD + (size_t)3 * 8 * 6144 + 5120, (const float*)F.in[7], nullptr, nullptr, nullptr, args.out, nullptr);
#undef IN
#undef SEAM
#undef WSP
#undef MOD
#undef X
#undef HB
#undef R1Z
#undef DELTA
#undef XS
#undef ACT
#undef YW
#undef modl
#undef gcnt
}

extern "C" void kernel_launch(void* const* d_in, const int* in_sizes, int n_in, void* d_out, int out_size, void* d_ws, size_t ws_size, hipStream_t stream) {
    static int grid = 0;
    if (grid == 0) {
        if (n_in != 25 || in_sizes[0] != T * D || out_size != T * D || ws_size < WS_END) { fprintf(stderr, "kernel_launch: unexpected shapes / workspace (n_in %d, ws %zu); nothing launched\n", n_in, ws_size); grid = -1; return; }
        int dev = 0, cus = 0, per_cu = 0;
        if (hipGetDevice(&dev) != hipSuccess || hipDeviceGetAttribute(&cus, hipDeviceAttributeMultiprocessorCount, dev) != hipSuccess) { grid = -1; return; }
        if (hipFuncSetAttribute((const void*)fwd, hipFuncAttributeMaxDynamicSharedMemorySize, LDS_BYTES) != hipSuccess) { fprintf(stderr, "kernel_launch: hipFuncSetAttribute failed\n"); grid = -1; return; }
        if (hipOccupancyMaxActiveBlocksPerMultiprocessor(&per_cu, (const void*)fwd, NTHR, LDS_BYTES) != hipSuccess || per_cu < 1) { fprintf(stderr, "kernel_launch: occupancy query reports %d\n", per_cu); }
        (void)hipGetLastError();
        grid = cus;
    }
    if (grid < 0) return;
    if (hipMemsetAsync((char*)d_ws + WS_CTL, 0, CTL_ZERO_BYTES, stream) != hipSuccess) return;
    Args a{};
    for (int i = 0; i < 25; ++i) a.in[i] = d_in[i];
    a.out = (float*)d_out; a.ws = (unsigned char*)d_ws;
#if MK_ONE_LAUNCH
    a.ph_lo = 0; a.ph_hi = NPHASE;
    hipLaunchKernelGGL(fwd, dim3(grid), dim3(NTHR), LDS_BYTES, stream, a);
#else
    for (int p = 0; p < NPHASE; ++p) {
        if (p >= 1 && p < NPHASE - 1) { const int l = (p - 1) / 10, s = (p - 1) % 10; if ((l & 1) == 1 && (s == 3 || s == 4)) continue; }
        a.ph_lo = p; a.ph_hi = p + 1;
        hipLaunchKernelGGL(fwd, dim3(grid), dim3(NTHR), LDS_BYTES, stream, a);
    }
#endif
}
```

```cpp
#include <hip/hip_runtime.h>
#include <cstdio>
#include <cstdint>

#ifndef MK_ONE_LAUNCH
#define MK_ONE_LAUNCH 1
#endif

namespace pg8 {
#define PG8_LAS __attribute__((address_space(3)))
typedef unsigned short bf16_t;
typedef short bf16x8 __attribute__((ext_vector_type(8)));
typedef float f32x4 __attribute__((ext_vector_type(4)));
typedef unsigned u32x4 __attribute__((ext_vector_type(4)));
constexpr int BM = 256, BK = 64, HALF = 128, HTB = HALF * BK * 2  , STAGE_BYTES = 8 * HTB, NXCD = 8, WGM = 8;

__host__ __device__ __forceinline__ int lds_byte(int r, int c) { const int st = (r >> 4) * 2 + (c >> 5), rr = r & 15, cc = c & 31, ob = rr * 64 + cc * 2; return st * 1024 + (ob ^ (((ob >> 9) & 1) << 5)); }
__host__ __device__ __forceinline__ void stage_rc(int b, int& R, int& C) { const int st = b / 1024, sb = b % 1024, swz = sb ^ (((sb >> 9) & 1) << 5); R = (st >> 1) * 16 + swz / 64; C = (st & 1) * 32 + (swz % 64) / 2; }
__host__ __device__ __forceinline__ int perm32(int rho) { const int n = rho >> 4, i = rho & 15; return 8 * (i >> 2) + 4 * n + (i & 3); }

struct Unit { int pm, pn, e; };

struct StaticOrder {
    static constexpr bool GATHER = false;
    const char* A; const char* Bt; size_t tstep;
    int nM, nN, nwg, G, c;
    __device__ void init(const void* A_, const void* Bt_, int M, int N, int K, int G_, int c_) { A = (const char*)A_; Bt = (const char*)Bt_; tstep = (size_t)256 * K * 2; nM = M / BM; nN = N / BM; nwg = nM * nN; G = G_; c = c_; }
    __device__ bool next(int i, Unit& u) const {
        const long L = (long)i * G + c; if (L >= nwg) return false;
        int wgid = (int)L; { const int q = nwg / NXCD, r = nwg % NXCD, xcd = wgid % NXCD, off = wgid / NXCD; wgid = (xcd < r ? xcd * (q + 1) : r * (q + 1) + (xcd - r) * q) + off; }
        const int nig = WGM * nN, gid = wgid / nig, fm = gid * WGM, gsz = (nM - fm) < WGM ? (nM - fm) : WGM;
        u.pm = fm + ((wgid % nig) % gsz); u.pn = (wgid % nig) / gsz; u.e = 0; return true;
    }
    __device__ __forceinline__ const char* a_base(const Unit& u) const { return A + (size_t)u.pm * tstep; }
    __device__ __forceinline__ unsigned a_off(int, int, int, int) const { return 0u; }
    __device__ __forceinline__ const char* b_base(const Unit& u) const { return Bt + (size_t)u.pn * tstep; }
    __device__ __forceinline__ void a_ready(const Unit&) const {}
    __device__ __forceinline__ void done(const Unit&) const {}
};
struct MoeOrder {
    static constexpr bool GATHER = false;
    const char* A; const char* Bt; size_t tstep, estride;
    const volatile PG8_LAS unsigned* tp; int G, c;
    __device__ bool next(int i, Unit& u) const {
        const int L = i * G + c; if (L >= (int)tp[16] * 4) return false;
        const int pt = L >> 2; int e = 0;
#pragma unroll
        for (int j = 1; j < 16; ++j) e += (pt >= (int)tp[j]) ? 1 : 0;
        e = __builtin_amdgcn_readfirstlane(e);
        u.pm = pt; u.pn = L & 3; u.e = e; return true;
    }
    __device__ __forceinline__ const char* a_base(const Unit& u) const { return A + (size_t)u.pm * tstep; }
    __device__ __forceinline__ unsigned a_off(int, int, int, int) const { return 0u; }
    __device__ __forceinline__ const char* b_base(const Unit& u) const { return Bt + (size_t)u.e * estride + (size_t)u.pn * tstep; }
    __device__ __forceinline__ void a_ready(const Unit&) const {}
    __device__ __forceinline__ void done(const Unit&) const {}
};

struct MoeGatherOrder : MoeOrder {
    static constexpr bool GATHER = true;
    const volatile PG8_LAS unsigned* tok; unsigned rowbytes;
    __device__ __forceinline__ const char* a_base(const Unit&) const { return A; }
    __device__ __forceinline__ unsigned a_off(int ui, int hf, int R, int C) const { return tok[ui * 256 + hf * 128 + R] * rowbytes + (unsigned)C * 2u; }
};
__device__ __forceinline__ unsigned cvt_pk_bf16(float lo, float hi) { unsigned r; asm volatile("v_cvt_pk_bf16_f32 %0, %1, %2" : "=v"(r) : "v"(lo), "v"(hi)); return r; }
__device__ __forceinline__ void st16_wt(void* p, const u32x4 v) { asm volatile("global_store_dwordx4 %0, %1, off sc1\n\ts_nop 1" :: "v"(p), "v"(v) : "memory"); }
__device__ __forceinline__ u32x4 pack8(const f32x4 v0, const f32x4 v1) { u32x4 w; w.x = cvt_pk_bf16(v0[0], v0[1]); w.y = cvt_pk_bf16(v0[2], v0[3]); w.z = cvt_pk_bf16(v1[0], v1[1]); w.w = cvt_pk_bf16(v1[2], v1[3]); return w; }

struct EpiStore {
    static constexpr bool PERM = true, AFTER_DRAIN = false;
    bf16_t* O; int ldc;
    __device__ __forceinline__ void operator()(const f32x4 (&acc)[2][2][4][2], const Unit& u, int wr, int wc, int fr, int fq) const {
        const int row0 = u.pm * BM + wr * 64 + fr, col0 = u.pn * BM + wc * 32 + 8 * fq;
#pragma unroll
        for (int ai = 0; ai < 2; ++ai)
#pragma unroll
            for (int m = 0; m < 4; ++m) { bf16_t* rowp = O + (size_t)(row0 + ai * HALF + m * 16) * ldc + col0;
#pragma unroll
                for (int bj = 0; bj < 2; ++bj) st16_wt(rowp + bj * HALF, pack8(acc[ai][bj][m][0], acc[ai][bj][m][1])); }
    }
};
struct EpiQKV {
    static constexpr bool PERM = true, AFTER_DRAIN = false;
    bf16_t* O; const float* rot;
    __device__ __forceinline__ void operator()(const f32x4 (&acc)[2][2][4][2], const Unit& u, int wr, int wc, int fr, int fq) const {
        const int row0 = u.pm * BM + wr * 64 + fr, col0 = u.pn * BM + wc * 32 + 8 * fq;
        const bool rotw = (u.pn < 8) && ((wc & 1) == 0);
#pragma unroll
        for (int ai = 0; ai < 2; ++ai)
#pragma unroll
            for (int m = 0; m < 4; ++m) { const int row = row0 + ai * HALF + m * 16; bf16_t* rowp = O + (size_t)row * 3072 + col0;
                f32x4 cs[4];
                if (rotw) {
#pragma unroll
                    for (int q = 0; q < 4; ++q) cs[q] = *(const f32x4*)(rot + (size_t)row * 16 + q * 4); }
#pragma unroll
                for (int bj = 0; bj < 2; ++bj) { f32x4 v0 = acc[ai][bj][m][0], v1 = acc[ai][bj][m][1];
                    if (rotw) {
                        f32x4 p0, p1;
#pragma unroll
                        for (int j = 0; j < 4; ++j) { p0[j] = __shfl_xor(v0[j], 16); p1[j] = __shfl_xor(v1[j], 16); }
                        if (fq < 2) { const float sg = (fq == 0) ? -1.f : 1.f;
                            v0[0] = v0[0] * cs[0][0] + sg * p0[0] * cs[0][1]; v0[1] = v0[1] * cs[0][2] + sg * p0[1] * cs[0][3];
                            v0[2] = v0[2] * cs[1][0] + sg * p0[2] * cs[1][1]; v0[3] = v0[3] * cs[1][2] + sg * p0[3] * cs[1][3];
                            v1[0] = v1[0] * cs[2][0] + sg * p1[0] * cs[2][1]; v1[1] = v1[1] * cs[2][2] + sg * p1[1] * cs[2][3];
                            v1[2] = v1[2] * cs[3][0] + sg * p1[2] * cs[3][1]; v1[3] = v1[3] * cs[3][2] + sg * p1[3] * cs[3][3]; }
                    }
                    st16_wt(rowp + bj * HALF, pack8(v0, v1)); } }
    }
};
struct EpiX {
    static constexpr bool PERM = true, AFTER_DRAIN = false;
    const float* xsrc; float* xdst; const bf16_t* yw; const float* g1; const float* g2p;
    __device__ __forceinline__ void operator()(const f32x4 (&acc)[2][2][4][2], const Unit& u, int wr, int wc, int fr, int fq) const {
        const int row0 = u.pm * BM + wr * 64 + fr, col0 = u.pn * BM + wc * 32 + 8 * fq, b = u.pm >> 3;
        f32x4 ga[2][2], gb[2][2];
#pragma unroll
        for (int bj = 0; bj < 2; ++bj)
#pragma unroll
            for (int n = 0; n < 2; ++n) { ga[bj][n] = *(const f32x4*)(g1 + (size_t)b * 6144 + col0 + bj * HALF + 4 * n);
                gb[bj][n] = yw ? *(const f32x4*)(g2p + (size_t)b * 6144 + col0 + bj * HALF + 4 * n) : (f32x4){0.f, 0.f, 0.f, 0.f}; }
#pragma unroll
        for (int ai = 0; ai < 2; ++ai)
#pragma unroll
            for (int m = 0; m < 4; ++m) { const int row = row0 + ai * HALF + m * 16;
#pragma unroll
                for (int bj = 0; bj < 2; ++bj) { const size_t off = (size_t)row * 1024 + col0 + bj * HALF;
                    f32x4 v0 = *(const f32x4*)(xsrc + off) + ga[bj][0] * acc[ai][bj][m][0], v1 = *(const f32x4*)(xsrc + off + 4) + ga[bj][1] * acc[ai][bj][m][1];
                    if (yw) { const u32x4 y0 = *(const u32x4*)(yw + (size_t)(2 * row) * 1024 + col0 + bj * HALF), y1 = *(const u32x4*)(yw + (size_t)(2 * row + 1) * 1024 + col0 + bj * HALF);
                        f32x4 s0, s1;
                        s0[0] = __builtin_bit_cast(float, y0.x << 16) + __builtin_bit_cast(float, y1.x << 16); s0[1] = __builtin_bit_cast(float, y0.x & 0xffff0000u) + __builtin_bit_cast(float, y1.x & 0xffff0000u);
                        s0[2] = __builtin_bit_cast(float, y0.y << 16) + __builtin_bit_cast(float, y1.y << 16); s0[3] = __builtin_bit_cast(float, y0.y & 0xffff0000u) + __builtin_bit_cast(float, y1.y & 0xffff0000u);
                        s1[0] = __builtin_bit_cast(float, y0.z << 16) + __builtin_bit_cast(float, y1.z << 16); s1[1] = __builtin_bit_cast(float, y0.z & 0xffff0000u) + __builtin_bit_cast(float, y1.z & 0xffff0000u);
                        s1[2] = __builtin_bit_cast(float, y0.w << 16) + __builtin_bit_cast(float, y1.w << 16); s1[3] = __builtin_bit_cast(float, y0.w & 0xffff0000u) + __builtin_bit_cast(float, y1.w & 0xffff0000u);
                        v0 = v0 + gb[bj][0] * s0; v1 = v1 + gb[bj][1] * s1; }
                    *(f32x4*)(xdst + off) = v0; *(f32x4*)(xdst + off + 4) = v1; } }
    }
};
struct EpiGU {
    static constexpr bool PERM = true, AFTER_DRAIN = false;
    bf16_t* O;
    __device__ __forceinline__ void operator()(const f32x4 (&acc)[2][2][4][2], const Unit& u, int wr, int wc, int fr, int fq) const {
        const int row0 = u.pm * BM + wr * 64 + fr, col0 = u.pn * 128 + wc * 32 + 8 * fq;
#pragma unroll
        for (int ai = 0; ai < 2; ++ai)
#pragma unroll
            for (int m = 0; m < 4; ++m) { bf16_t* rowp = O + (size_t)(row0 + ai * HALF + m * 16) * 512 + col0;
                f32x4 o[2];
#pragma unroll
                for (int n = 0; n < 2; ++n)
#pragma unroll
                    for (int j = 0; j < 4; ++j) { const float g = acc[ai][0][m][n][j], up = acc[ai][1][m][n][j]; o[n][j] = g / (1.f + __expf(-g)) * up; }
                st16_wt(rowp, pack8(o[0], o[1])); }
    }
};
struct EpiDN {
    static constexpr bool PERM = true, AFTER_DRAIN = false;
    bf16_t* O; const int* sloti; const float* slotw;
    __device__ __forceinline__ void operator()(const f32x4 (&acc)[2][2][4][2], const Unit& u, int wr, int wc, int fr, int fq) const {
        const int row0 = u.pm * BM + wr * 64 + fr, col0 = u.pn * BM + wc * 32 + 8 * fq;
#pragma unroll
        for (int ai = 0; ai < 2; ++ai)
#pragma unroll
            for (int m = 0; m < 4; ++m) { const int row = row0 + ai * HALF + m * 16; const int info = sloti[row]; const float w = slotw[row];
                if (info >= 0) { bf16_t* rowp = O + (size_t)info * 1024 + col0;
#pragma unroll
                    for (int bj = 0; bj < 2; ++bj) st16_wt(rowp + bj * HALF, pack8(acc[ai][bj][m][0] * w, acc[ai][bj][m][1] * w)); } }
    }
};

template <class Epi, class Sched, bool ALIGN_EPI = false, bool SP2 = false>
__device__ __forceinline__ void gemm_phase(PG8_LAS unsigned char* lds, const int K, const Sched& S, const Epi& E, const int tid) {
    const int wid = __builtin_amdgcn_readfirstlane(tid >> 6), lane = tid & 63, wr = wid >> 2, wc = wid & 3, fr = lane & 15, fq = lane >> 4;
    static_assert(SP2 || !Sched::GATHER, "gathered A rows are wired into the SP2 loop only");
    const int nt = K / BK;
    unsigned voffA[2], voffB[2];
#pragma unroll
    for (int i = 0; i < 2; ++i) { int R, C; stage_rc(tid * 16 + i * 8192, R, C); const int Rb = Epi::PERM ? ((R & ~31) + perm32(R & 31)) : R;
        voffA[i] = (unsigned)(R * K + C) * 2u; voffB[i] = (unsigned)(Rb * K + C) * 2u; }
    unsigned cv[2][2], nv[2][2]; int rA[2], cAc[2];
#pragma unroll
    for (int i = 0; i < 2; ++i) { int R, C; stage_rc(tid * 16 + i * 8192, R, C); rA[i] = R; cAc[i] = C; }
#pragma unroll
    for (int hf = 0; hf < 2; ++hf)
#pragma unroll
        for (int i = 0; i < 2; ++i) { cv[hf][i] = 0u; nv[hf][i] = 0u; }
    const size_t kstep = (size_t)(BK * 2);
    const size_t hstep = (size_t)HALF * K * 2;
    const unsigned ldsw = (unsigned)wid * 1024u;
    const int aoff = lds_byte(wr * 64 + fr, fq * 8), boff = lds_byte(wc * 32 + fr, fq * 8);
#define PG8_SA(b, h) (((b) * 2 + (h)) * HTB)
#define PG8_SB(b, h) ((4 + (b) * 2 + (h)) * HTB)
#define PG8_STAGE(bufoff, gbase, voff) do { _Pragma("unroll") for (int _i = 0; _i < 2; ++_i) \
        __builtin_amdgcn_global_load_lds((const unsigned*)((const char*)(gbase) + (voff)[_i]), (PG8_LAS unsigned*)(lds + (bufoff) + ldsw + _i * 8192), 16, 0, 0); } while (0)
#define PG8_STAGE_A(bufoff, aptr, hf, usenext) do { if constexpr (Sched::GATHER) { _Pragma("unroll") for (int _i = 0; _i < 2; ++_i) \
        __builtin_amdgcn_global_load_lds((const unsigned*)((const char*)(aptr) + ((usenext) ? nv[hf][_i] : cv[hf][_i])), (PG8_LAS unsigned*)(lds + (bufoff) + ldsw + _i * 8192), 16, 0, 0); } \
        else { PG8_STAGE(bufoff, (aptr) + (hf) * hstep, voffA); } } while (0)
#define PG8_LDA(dst, b, h) do { _Pragma("unroll") for (int m = 0; m < 4; ++m) _Pragma("unroll") for (int k = 0; k < 2; ++k) dst[m][k] = *(const PG8_LAS bf16x8*)(lds + PG8_SA(b, h) + aoff + m * 2048 + k * 1024); } while (0)
#define PG8_LDB(dst, b, h) do { _Pragma("unroll") for (int n = 0; n < 2; ++n) _Pragma("unroll") for (int k = 0; k < 2; ++k) dst[n][k] = *(const PG8_LAS bf16x8*)(lds + PG8_SB(b, h) + boff + n * 2048 + k * 1024); } while (0)
#define PG8_MMA(ai, bj, At, Bt) do { __builtin_amdgcn_s_setprio(1); _Pragma("unroll") for (int m = 0; m < 4; ++m) _Pragma("unroll") for (int n = 0; n < 2; ++n) _Pragma("unroll") for (int k = 0; k < 2; ++k) \
        acc[ai][bj][m][n] = __builtin_amdgcn_mfma_f32_16x16x32_bf16(Bt[n][k], At[m][k], acc[ai][bj][m][n], 0, 0, 0); __builtin_amdgcn_s_setprio(0); } while (0)
#define PG8_WAIT_V(n) asm volatile("s_waitcnt vmcnt(" #n ")" ::: "memory")
#define PG8_WAIT_L(n) asm volatile("s_waitcnt lgkmcnt(" #n ")" ::: "memory")
#define PG8_BAR __builtin_amdgcn_s_barrier()
#define PG8_SCHED __builtin_amdgcn_sched_barrier(0)
    Unit cur, nxt; int ui = 0;
    if (!S.next(0, cur)) return;
    f32x4 acc[2][2][4][2];
#pragma unroll
    for (int a = 0; a < 2; ++a)
#pragma unroll
        for (int b = 0; b < 2; ++b)
#pragma unroll
            for (int m = 0; m < 4; ++m)
#pragma unroll
                for (int n = 0; n < 2; ++n) acc[a][b][m][n] = (f32x4){0.f, 0.f, 0.f, 0.f};
    bf16x8 At[4][2], B0[2][2], B1[2][2];
    const char* cA = S.a_base(cur); const char* cB = S.b_base(cur);
    S.a_ready(cur);
    if constexpr (Sched::GATHER) {
#pragma unroll
        for (int hf = 0; hf < 2; ++hf)
#pragma unroll
            for (int i = 0; i < 2; ++i) cv[hf][i] = S.a_off(0, hf, rA[i], cAc[i]); }
    if constexpr (SP2) {
        PG8_STAGE(PG8_SB(0, 0), cB, voffB); PG8_STAGE(PG8_SB(0, 1), cB + hstep, voffB); PG8_STAGE_A(PG8_SA(0, 0), cA, 0, false); PG8_STAGE_A(PG8_SA(0, 1), cA, 1, false);
        if (wr == 1) PG8_BAR;
        PG8_WAIT_V(2); PG8_BAR;
        PG8_STAGE(PG8_SB(1, 0), cB + kstep, voffB); PG8_STAGE_A(PG8_SA(1, 0), cA + kstep, 0, false); PG8_STAGE(PG8_SB(1, 1), cB + hstep + kstep, voffB);
        PG8_WAIT_V(6); PG8_BAR;
    } else {
        PG8_STAGE(PG8_SB(0, 0), cB, voffB); PG8_STAGE(PG8_SA(0, 0), cA, voffA); PG8_STAGE(PG8_SB(0, 1), cB + hstep, voffB); PG8_STAGE(PG8_SA(0, 1), cA + hstep, voffA);
        if (wr == 1) PG8_BAR;
        PG8_WAIT_V(4); PG8_BAR;
        PG8_STAGE(PG8_SB(1, 0), cB + kstep, voffB); PG8_STAGE(PG8_SA(1, 0), cA + kstep, voffA); PG8_STAGE(PG8_SB(1, 1), cB + hstep + kstep, voffB);
        PG8_WAIT_V(6); PG8_BAR;
    }
    for (;;) {
        const bool has_next = S.next(ui + 1, nxt);
        if constexpr (Sched::GATHER) { if (has_next) {
#pragma unroll
            for (int hf = 0; hf < 2; ++hf)
#pragma unroll
                for (int i = 0; i < 2; ++i) nv[hf][i] = S.a_off(ui + 1, hf, rA[i], cAc[i]); } }
        const char* nA = has_next ? S.a_base(nxt) : cA; const char* nB = has_next ? S.b_base(nxt) : cB;
        for (int t = 0; t < nt; t += 2) {
            const bool last = (t == nt - 2);
            const char* a1 = cA + (size_t)(t + 1) * kstep;
            const char* a2 = last ? nA : cA + (size_t)(t + 2) * kstep; const char* b2 = last ? nB : cB + (size_t)(t + 2) * kstep;
            const char* a3 = a2 + kstep; const char* b3 = b2 + kstep;
            if (last && has_next) S.a_ready(nxt);
            const bool usen = last && has_next;
            if constexpr (SP2) {
            PG8_LDB(B0, 0, 0); PG8_LDB(B1, 0, 1); PG8_SCHED; PG8_LDA(At, 0, 0); PG8_STAGE_A(PG8_SA(1, 1), a1, 1, false);
            PG8_WAIT_V(8); PG8_WAIT_L(0); PG8_BAR; PG8_MMA(0, 0, At, B0); PG8_MMA(0, 1, At, B1); PG8_BAR; PG8_SCHED;
            PG8_LDA(At, 0, 1); PG8_STAGE(PG8_SB(0, 0), b2, voffB); PG8_STAGE(PG8_SB(0, 1), b2 + hstep, voffB); PG8_STAGE_A(PG8_SA(0, 0), a2, 0, usen);
            PG8_WAIT_V(8); PG8_WAIT_L(0); PG8_BAR; PG8_MMA(1, 0, At, B0); PG8_MMA(1, 1, At, B1); PG8_BAR; PG8_SCHED;
            PG8_LDB(B0, 1, 0); PG8_LDB(B1, 1, 1); PG8_SCHED; PG8_LDA(At, 1, 0); PG8_STAGE_A(PG8_SA(0, 1), a2, 1, usen);
            PG8_WAIT_V(8); PG8_WAIT_L(0); PG8_BAR; PG8_MMA(0, 0, At, B0); PG8_MMA(0, 1, At, B1); PG8_BAR; PG8_SCHED;
            PG8_LDA(At, 1, 1); PG8_STAGE(PG8_SB(1, 0), b3, voffB); PG8_STAGE(PG8_SB(1, 1), b3 + hstep, voffB); PG8_STAGE_A(PG8_SA(1, 0), a3, 0, usen);
            PG8_WAIT_V(8); PG8_WAIT_L(0); PG8_BAR; PG8_MMA(1, 0, At, B0); PG8_MMA(1, 1, At, B1); PG8_BAR; PG8_SCHED;
            } else {
            PG8_LDB(B0, 0, 0); PG8_SCHED; PG8_LDA(At, 0, 0); PG8_STAGE(PG8_SA(1, 1), a1 + hstep, voffA);
            PG8_WAIT_L(8); PG8_BAR; PG8_WAIT_L(0); PG8_MMA(0, 0, At, B0); PG8_BAR; PG8_SCHED;
            PG8_LDB(B1, 0, 1); PG8_STAGE(PG8_SB(0, 0), b2, voffB);
            PG8_BAR; PG8_WAIT_L(0); PG8_MMA(0, 1, At, B1); PG8_BAR;
            PG8_LDA(At, 0, 1); PG8_STAGE(PG8_SA(0, 0), a2, voffA);
            PG8_BAR; PG8_WAIT_L(0); PG8_MMA(1, 0, At, B0); PG8_BAR; PG8_SCHED;
            PG8_STAGE(PG8_SB(0, 1), b2 + hstep, voffB);
            PG8_WAIT_V(6); PG8_BAR; PG8_MMA(1, 1, At, B1); PG8_BAR;
            PG8_LDB(B0, 1, 0); PG8_SCHED; PG8_LDA(At, 1, 0); PG8_STAGE(PG8_SA(0, 1), a2 + hstep, voffA);
            PG8_WAIT_L(8); PG8_BAR; PG8_WAIT_L(0); PG8_MMA(0, 0, At, B0); PG8_BAR; PG8_SCHED;
            PG8_LDB(B1, 1, 1); PG8_STAGE(PG8_SB(1, 0), b3, voffB);
            PG8_BAR; PG8_WAIT_L(0); PG8_MMA(0, 1, At, B1); PG8_BAR;
            PG8_LDA(At, 1, 1); PG8_STAGE(PG8_SA(1, 0), a3, voffA);
            PG8_BAR; PG8_WAIT_L(0); PG8_MMA(1, 0, At, B0); PG8_BAR; PG8_SCHED;
            PG8_STAGE(PG8_SB(1, 1), b3 + hstep, voffB);
            PG8_WAIT_V(6); PG8_BAR; PG8_MMA(1, 1, At, B1); PG8_BAR;
            }
        }
        if constexpr (ALIGN_EPI) { if (wr == 0) PG8_BAR; }
        if constexpr (!Epi::AFTER_DRAIN) { E(acc, cur, wr, wc, fr, fq); S.done(cur); }
        if (!has_next) break;
#pragma unroll
        for (int a = 0; a < 2; ++a)
#pragma unroll
            for (int b = 0; b < 2; ++b)
#pragma unroll
                for (int m = 0; m < 4; ++m)
#pragma unroll
                    for (int n = 0; n < 2; ++n) acc[a][b][m][n] = (f32x4){0.f, 0.f, 0.f, 0.f};
        cur = nxt; cA = nA; cB = nB; ++ui;
        if constexpr (Sched::GATHER) {
#pragma unroll
            for (int hf = 0; hf < 2; ++hf)
#pragma unroll
                for (int i = 0; i < 2; ++i) cv[hf][i] = nv[hf][i]; }
        if constexpr (ALIGN_EPI) { if (wr == 1) PG8_BAR; }
    }
    PG8_WAIT_V(0);
    if constexpr (!ALIGN_EPI) { if (wr == 0) PG8_BAR; }
    PG8_BAR;
    if constexpr (Epi::AFTER_DRAIN) { E.fused(acc, cur, wr, wc, fr, fq, lds, wid, lane); S.done(cur); }
#undef PG8_SA
#undef PG8_SB
#undef PG8_STAGE
#undef PG8_LDA
#undef PG8_STAGE_A
#undef PG8_LDB
#undef PG8_MMA
#undef PG8_WAIT_V
#undef PG8_WAIT_L
#undef PG8_BAR
#undef PG8_SCHED
}
}

constexpr int NB = 8, SEQ = 2048, T = NB * SEQ, D = 1024, DEPTH = 4;
constexpr int IN_AB = 2560, NQKV = 3072, NE = 16, FF = 512;
constexpr int MAXTILES = 144, MPAD = MAXTILES * 256;
constexpr int NWAVES = 8, NTHR = 512;

constexpr size_t MiB = 1u << 20;
constexpr size_t WS_CTL = 0, CTL_ZERO_BYTES = 1 * MiB;
constexpr int CW_TMO = 0, CW_BAR = 64, CW_CNT = 8192;
constexpr size_t WS_MOD = 1 * MiB;
constexpr size_t WS_ROT = 2 * MiB;
constexpr size_t WS_AGG = 3 * MiB;
constexpr size_t WS_LIST = 5 * MiB;
constexpr size_t WS_TOPW = 6 * MiB;
constexpr size_t WS_SLOTI = 6 * MiB + 512 * 1024;
constexpr size_t WS_SLOTW = 7 * MiB;
constexpr size_t WS_LRUW = 7 * MiB + 512 * 1024;
constexpr size_t WS_WIN = 8 * MiB;
constexpr size_t WS_WOUT = 18 * MiB;
constexpr size_t WS_WQKV = 22 * MiB;
constexpr size_t WS_WO = 34 * MiB;
constexpr size_t WS_WGU = 38 * MiB;
constexpr size_t WS_WDN = 166 * MiB;
constexpr size_t WS_X = 230 * MiB;
constexpr size_t WS_HB = 294 * MiB;
constexpr size_t WS_R1 = 326 * MiB;
constexpr size_t R1_Z = 0;
constexpr size_t R1_DELTA = 0;
constexpr size_t R1_XS = 0;
constexpr size_t R1_ACT = 72 * MiB;
constexpr size_t R1_YW = 108 * MiB;
constexpr size_t R1_AGG = 96 * MiB, R1_CARRY = 100 * MiB;
constexpr size_t WS_MCST = 6 * MiB + 256 * 1024;
constexpr size_t WS_END = 526 * MiB;

constexpr int RING_BYTES = 131072;
constexpr int MISC_OFF = 150528;
constexpr int ENT_OFF = RING_BYTES;
constexpr int LDS_BYTES = 147456 + 4096;

#define GAS __attribute__((address_space(1)))
#define LAS __attribute__((address_space(3)))
typedef unsigned short bf16;
typedef unsigned v4u __attribute__((ext_vector_type(4)));
typedef unsigned v2u __attribute__((ext_vector_type(2)));
typedef float f32x4 __attribute__((ext_vector_type(4)));
typedef float f32x2 __attribute__((ext_vector_type(2)));
#define RLX_AGENT __ATOMIC_RELAXED, __HIP_MEMORY_SCOPE_AGENT
#define LDS_WAIT() asm volatile("s_waitcnt lgkmcnt(0)" ::: "memory")
#define VM_WAIT() asm volatile("s_waitcnt vmcnt(0)" ::: "memory")
__device__ __forceinline__ unsigned f2bf(float f) { unsigned u = __builtin_bit_cast(unsigned, f); return (u + 0x7fffu + ((u >> 16) & 1u)) >> 16; }
__device__ __forceinline__ unsigned pk2(float lo, float hi) { return f2bf(lo) | (f2bf(hi) << 16); }
__device__ __forceinline__ float bf2f(unsigned short b) { return __builtin_bit_cast(float, (unsigned)b << 16); }
__device__ __forceinline__ float bflo(unsigned w) { return __builtin_bit_cast(float, w << 16); }
__device__ __forceinline__ float bfhi(unsigned w) { return __builtin_bit_cast(float, w & 0xffff0000u); }

#define XB_TMO      128
#define XB_XCNT(j)  (256  + 64 * (j))
#define XB_XSUB(j)  (1280 + 64 * (j))
#define XB_XGEN(j)  (2304 + 64 * (j))
#define XB_TOP      3328
#define XB_TOPGEN   3392
#define XCD_BAR_WORDS 3456
#define XB_SPIN_CAP (1u << 18)

__device__ __forceinline__ unsigned xb_ld(unsigned* p)              { return __hip_atomic_load(p, __ATOMIC_RELAXED, __HIP_MEMORY_SCOPE_AGENT); }
__device__ __forceinline__ unsigned xb_add(unsigned* p, unsigned v) { return __hip_atomic_fetch_add(p, v, __ATOMIC_RELAXED, __HIP_MEMORY_SCOPE_AGENT); }
__device__ __forceinline__ unsigned xb_xcc_id() { return (unsigned)__builtin_amdgcn_s_getreg((3 << 11) | 20) & 0xFu; }
#define XB_SPIN(cond, bar) do { unsigned _sp = 0; while (cond) { __builtin_amdgcn_s_sleep(1); \
    if ((++_sp & 255u) == 0u) { if (xb_ld(&(bar)[XB_TMO])) break; if (_sp > XB_SPIN_CAP) { atomicAdd(&(bar)[XB_TMO], 1u); break; } } } } while (0)

struct XcdBarrier {
    unsigned* bar; unsigned x;
    volatile LAS unsigned* st;
};

__device__ __forceinline__ XcdBarrier xcd_barrier_post(unsigned* bar, volatile LAS unsigned* st) {
    XcdBarrier b; b.bar = bar; b.x = xb_xcc_id(); b.st = st;
    if (threadIdx.x == 0) (void)xb_add(&bar[XB_XCNT(b.x)], 1u);
    return b;
}
__device__ __forceinline__ void xcd_barrier_complete(unsigned* bar, unsigned x, unsigned& nloc, unsigned& nx) {
    const unsigned G = gridDim.x * gridDim.y * gridDim.z;
    unsigned sum, cnt, mine, sp = 0u;
    for (;;) {
        sum = 0u; cnt = 0u; mine = 0u;
#pragma unroll
        for (unsigned j = 0; j < 16; ++j) { const unsigned c = xb_ld(&bar[XB_XCNT(j)]); sum += c; cnt += (c > 0u) ? 1u : 0u; mine = (j == x) ? c : mine; }
        if (sum == G) break;
        __builtin_amdgcn_s_sleep(1);
        if ((++sp & 255u) == 0u) { if (xb_ld(&bar[XB_TMO])) break; if (sp > XB_SPIN_CAP) { atomicAdd(&bar[XB_TMO], 1u); break; } }
    }
    nloc = mine > 0u ? mine : 1u; nx = cnt > 0u ? cnt : 1u;
}

__device__ __forceinline__ void xcd_barrier(const XcdBarrier& b) {
    asm volatile("s_waitcnt vmcnt(0)" ::: "memory");
    __syncthreads();
    if (threadIdx.x == 0) {
        unsigned* bar = b.bar;
        __builtin_amdgcn_s_waitcnt(0);
        unsigned nloc = b.st[0], nx = b.st[1];
        if (nloc == 0u) { xcd_barrier_complete(bar, b.x, nloc, nx); b.st[0] = nloc; b.st[1] = nx; }
        const unsigned old = xb_add(&bar[XB_XSUB(b.x)], 1u);
        const unsigned gen = old / nloc;
        if (old + 1u == (gen + 1u) * nloc) {
            __builtin_amdgcn_fence(__ATOMIC_RELEASE, "agent");
            asm volatile("s_waitcnt vmcnt(0)" ::: "memory");
            const unsigned og = xb_add(&bar[XB_TOP], 1u);
            const unsigned tg = og / nx;
            if (og + 1u == (tg + 1u) * nx) xb_add(&bar[XB_TOPGEN], 1u);
            else XB_SPIN(xb_ld(&bar[XB_TOPGEN]) == tg, bar);
            __builtin_amdgcn_fence(__ATOMIC_ACQUIRE, "agent");
            xb_add(&bar[XB_XGEN(b.x)], 1u);
            asm volatile("s_waitcnt vmcnt(0)" ::: "memory");
        } else {
            XB_SPIN(xb_ld(&bar[XB_XGEN(b.x)]) == gen, bar);
            __builtin_amdgcn_fence(__ATOMIC_ACQUIRE, "agent");
            asm volatile("s_waitcnt vmcnt(0)" ::: "memory");
        }
    }
    __syncthreads();
}


__device__ __forceinline__ float wave_sum(float v) {
#pragma unroll
    for (int o = 1; o < 64; o <<= 1) v += __shfl_xor(v, o);
    return v;
}
template <int PAT> __device__ __forceinline__ float swz_f(float v) { return __builtin_bit_cast(float, __builtin_amdgcn_ds_swizzle(__builtin_bit_cast(int, v), PAT)); }
__device__ __forceinline__ float wave_max(float v) {
#pragma unroll
    for (int o = 1; o < 64; o <<= 1) v = fmaxf(v, __shfl_xor(v, o));
    return v;
}
typedef __bf16 bf16x2_t __attribute__((ext_vector_type(2)));
__device__ __forceinline__ unsigned cvtpk(float lo, float hi) { f32x2 v = {lo, hi}; bf16x2_t b = __builtin_convertvector(v, bf16x2_t); return __builtin_bit_cast(unsigned, b); }
__device__ __forceinline__ float sigmoidf_(float x) { return 1.f / (1.f + expf(-x)); }
__device__ __forceinline__ float gelu_tanh(float x) { const float u = 0.7978845608028654f * (x + 0.044715f * x * x * x); return 0.5f * x * (1.f + tanhf(u)); }
__device__ __forceinline__ void sincos_acc(float ang, float& c, float& s) {
    const double x = (double)ang, q = rint(x * 0.63661977236758134), r = x - q * 1.5707963267948966;
    const int qi = ((int)q) & 3; const float rf = (float)r, r2 = rf * rf;
    const float sp = rf * (1.f + r2 * (-1.6666667e-1f + r2 * (8.3333333e-3f + r2 * (-1.9841270e-4f + r2 * 2.7557319e-6f))));
    const float cp = 1.f + r2 * (-0.5f + r2 * (4.1666667e-2f + r2 * (-1.3888889e-3f + r2 * (2.4801587e-5f - r2 * 2.7557319e-7f))));
    c = (qi == 0) ? cp : (qi == 1) ? -sp : (qi == 2) ? -cp : sp;
    s = (qi == 0) ? sp : (qi == 1) ? cp : (qi == 2) ? -sp : -cp;
}

#define AS4 __attribute__((address_space(4)))
typedef const void* cvp_t;
struct Ctx {
    LAS unsigned char* lds; volatile LAS unsigned* MISC; LAS unsigned char* lds0;
    unsigned* ctl; unsigned char* ws;
    int tid, lane, wave, G, blk, lo, hi;
    const AS4 cvp_t* in;
};

__device__ __forceinline__ bool launder(Ctx& F) { int t = threadIdx.x; asm volatile("" : "+v"(t)); F.tid = t; F.lane = t & 63; F.wave = __builtin_amdgcn_readfirstlane(t >> 6);
    int z = 0; asm volatile("" : "+s"(z));
    const AS4 char* ka = (const AS4 char*)__builtin_amdgcn_kernarg_segment_ptr() + z;
    F.in = (const AS4 cvp_t*)ka; F.ws = *(unsigned char* const AS4*)(ka + 25 * 8 + 8); F.ctl = (unsigned*)(F.ws + WS_CTL);
    F.lds = F.lds0 + z; F.MISC = (volatile LAS unsigned*)(F.lds + MISC_OFF);
    F.G = (int)gridDim.x + z; F.blk = (int)blockIdx.x + z; F.lo = *(const AS4 int*)(ka + 25 * 8 + 16); F.hi = *(const AS4 int*)(ka + 25 * 8 + 20); return true; }

__device__ __forceinline__ void p0_transpose_item(const float* W, int K, int N, bf16* WT, int dstrow0, LAS float* scr, int k0, int n0, int lane) {
    f32x4 ld[8];
#pragma unroll
    for (int i = 0; i < 8; ++i) ld[i] = *(const f32x4*)(W + (size_t)(k0 + (lane >> 3) + 8 * i) * N + n0 + 4 * (lane & 7));
#pragma unroll
    for (int i = 0; i < 8; ++i) { LAS float* s = scr + ((lane >> 3) + 8 * i) * 33 + 4 * (lane & 7); s[0] = ld[i][0]; s[1] = ld[i][1]; s[2] = ld[i][2]; s[3] = ld[i][3]; }
    LDS_WAIT(); asm volatile("" ::: "memory");
    const int c = lane & 7;
#pragma unroll
    for (int j = 0; j < 4; ++j) { const int n = (lane >> 3) + 8 * j; const LAS float* s = scr + (8 * c) * 33 + n;
        v4u o; o.x = pk2(s[0 * 33], s[1 * 33]); o.y = pk2(s[2 * 33], s[3 * 33]); o.z = pk2(s[4 * 33], s[5 * 33]); o.w = pk2(s[6 * 33], s[7 * 33]);
        *(GAS v4u*)(WT + (size_t)(dstrow0 + n) * K + k0 + 8 * c) = o; }
    LDS_WAIT(); asm volatile("" ::: "memory");
}
__device__ __forceinline__ void p0_prologue(const Ctx& F) {
    const float* c_in = (const float*)F.in[1]; const int* pos_in = (const int*)F.in[2];
    const float* mod_w = (const float*)F.in[3]; const float* mod_b = (const float*)F.in[4];
    {
        __syncthreads();
        LAS float* cs_s = (LAS float*)F.lds;
        LAS float* red = (LAS float*)(F.lds + 32768);
        for (int i = F.tid; i < 8192; i += NTHR) { const int b = i >> 10, k = i & 1023; const float v = c_in[i]; cs_s[k * 8 + b] = v / (1.f + expf(-v)); }
        __syncthreads();
        float* MOD = (float*)(F.ws + WS_MOD);
        const int kq = F.tid >> 6, col = F.tid & 63;
        for (int it = F.blk; it < 4 * 96; it += F.G) {
            const int l = it / 96, nb = it % 96;
            float acc[8];
#pragma unroll
            for (int b = 0; b < 8; ++b) acc[b] = 0.f;
            const float* wp = mod_w + ((size_t)l * 1024 + kq * 128) * 6144 + nb * 64 + col;
#pragma unroll 16
            for (int k = 0; k < 128; ++k) { const float w = wp[(size_t)k * 6144];
                const f32x4 c0 = *(const LAS f32x4*)(cs_s + (kq * 128 + k) * 8), c1 = *(const LAS f32x4*)(cs_s + (kq * 128 + k) * 8 + 4);
                acc[0] += c0[0] * w; acc[1] += c0[1] * w; acc[2] += c0[2] * w; acc[3] += c0[3] * w; acc[4] += c1[0] * w; acc[5] += c1[1] * w; acc[6] += c1[2] * w; acc[7] += c1[3] * w; }
#pragma unroll
            for (int b = 0; b < 8; ++b) red[(kq * 8 + b) * 64 + col] = acc[b];
            __syncthreads();
            { const int b = F.tid >> 6; float s = mod_b[l * 6144 + nb * 64 + col];
#pragma unroll
              for (int q = 0; q < 8; ++q) s += red[(q * 8 + b) * 64 + col];
              MOD[((size_t)l * 8 + b) * 6144 + nb * 64 + col] = s; }
            __syncthreads();
        }
    }
    {
        float* ROT = (float*)(F.ws + WS_ROT);
        for (int idx = F.blk * NTHR + F.tid; idx < T * 8; idx += F.G * NTHR) { const int row = idx >> 3, i = idx & 7;
            const float invf = exp2f(-(float)i * (18.931568569324174f / 8.0f));
            const float ang = (float)pos_in[row] * invf; float c, s; sincos_acc(ang, c, s);
            *(f32x2*)(ROT + (size_t)idx * 2) = (f32x2){c, s}; }
    }
    {
        bf16* WG = (bf16*)(F.ws + WS_LRUW);
        for (int idx = F.blk * NTHR + F.tid; idx < 2 * 2 * 2 * 8 * 4096; idx += F.G * NTHR) { const int jj = idx & 7, hq = (idx >> 3) & 1, s = (idx >> 4) & 3, out = (idx >> 6) & 63, hd = (idx >> 12) & 7, dr = (idx >> 15) & 1, ty = (idx >> 16) & 1, jl = idx >> 17;
            const int in_ = 16 * s + 8 * (jj >> 2) + 4 * hq + (jj & 3);
            const float* src = (const float*)F.in[ty ? 14 : 12]; WG[idx] = (bf16)f2bf(src[((size_t)((jl * 2 + dr) * 8 + hd) * 64 + in_) * 64 + out]); }
        float* MC = (float*)(F.ws + WS_MCST);
        for (int idx = F.blk * NTHR + F.tid; idx < 2 * 2 * 3 * 512; idx += F.G * NTHR) { const int cc = idx & 511, k = (idx >> 9) % 3, jd = idx / 1536;
            const float* src = (const float*)F.in[k == 0 ? 13 : (k == 1 ? 15 : 16)]; float v = src[jd * 512 + cc]; if (k == 2) v = log1pf(expf(-v)); MC[idx] = v; }
    }
    {
        LAS float* scr = (LAS float*)(F.lds + F.wave * 16384);
        const int gw = F.blk * NWAVES + F.wave, NGW = F.G * NWAVES;
        constexpr int I_IN = 2 * 16 * 80, I_OUT = 2 * 16 * 32, I_QKV = 2 * 16 * 96, I_O = 2 * 16 * 32, I_G = 64 * 256, I_U = 64 * 256, I_D = 64 * 256;
        constexpr int NITEMS = I_IN + I_OUT + I_QKV + I_O + I_G + I_U + I_D;
        for (int it = gw; it < NITEMS; it += NGW) {
            int r = it;
            if (r < I_IN) { const int mt = r / 1280, q = r % 1280, kb = q / 80, nb = q % 80;
                p0_transpose_item((const float*)F.in[8] + (size_t)mt * 1024 * 2560, 1024, 2560, (bf16*)(F.ws + WS_WIN) + (size_t)mt * 2560 * 1024, nb * 32, scr, kb * 64, nb * 32, F.lane); continue; } r -= I_IN;
            if (r < I_OUT) { const int mt = r / 512, q = r % 512, kb = q / 32, nb = q % 32;
                p0_transpose_item((const float*)F.in[17] + (size_t)mt * 1024 * 1024, 1024, 1024, (bf16*)(F.ws + WS_WOUT) + (size_t)mt * 1024 * 1024, nb * 32, scr, kb * 64, nb * 32, F.lane); continue; } r -= I_OUT;
            if (r < I_QKV) { const int mt = r / 1536, q = r % 1536, kb = q / 96, nb = q % 96;
                p0_transpose_item((const float*)F.in[18] + (size_t)mt * 1024 * 3072, 1024, 3072, (bf16*)(F.ws + WS_WQKV) + (size_t)mt * 3072 * 1024, nb * 32, scr, kb * 64, nb * 32, F.lane); continue; } r -= I_QKV;
            if (r < I_O) { const int mt = r / 512, q = r % 512, kb = q / 32, nb = q % 32;
                p0_transpose_item((const float*)F.in[19] + (size_t)mt * 1024 * 1024, 1024, 1024, (bf16*)(F.ws + WS_WO) + (size_t)mt * 1024 * 1024, nb * 32, scr, kb * 64, nb * 32, F.lane); continue; } r -= I_O;
            if (r < I_G + I_U) { const int up = (r >= I_G) ? 1 : 0; r -= up * I_G; const int mt = r / 256, q = r % 256, kb = q / 16, nb = q % 16, n0 = nb * 32;
                p0_transpose_item((const float*)F.in[22 + up] + (size_t)mt * 1024 * 512, 1024, 512, (bf16*)(F.ws + WS_WGU) + (size_t)mt * 1024 * 1024, (n0 >> 7) * 256 + (n0 & 127) + up * 128, scr, kb * 64, n0, F.lane); continue; } r -= I_G + I_U;
            { const int mt = r / 256, q = r % 256, kb = q / 32, nb = q % 32;
                p0_transpose_item((const float*)F.in[24] + (size_t)mt * 512 * 1024, 512, 1024, (bf16*)(F.ws + WS_WDN) + (size_t)mt * 1024 * 512, nb * 32, scr, kb * 64, nb * 32, F.lane); }
        }
    }
}

template <int NDELTA, bool ROUTE, bool FINAL, bool WRITEX = true>
__device__ __forceinline__ void norm_phase(const Ctx& F, const float* xin, float* xout, const bf16* delta, const float* gate, const float* gvec, const float* shift, const float* scale,
                                           bf16* hout, float* fout, unsigned* gcnt) {
    LAS float* rw_s = (LAS float*)F.lds;
    volatile LAS unsigned* lcnt = F.MISC + 40; volatile LAS unsigned* lbase = F.MISC + 56; volatile LAS unsigned* nent = F.MISC + 72;
    LAS unsigned* ent = (LAS unsigned*)(F.lds + ENT_OFF);
    if (ROUTE) {
        const float* rw = (const float*)F.in[20];
        for (int i = F.tid; i < 16384; i += NTHR) { const int k = i >> 4, e = i & 15; rw_s[e * 1024 + k] = rw[i]; }
        if (F.tid < 16) lcnt[F.tid] = 0u; if (F.tid == 16) nent[0] = 0u;
        __syncthreads();
    }
    const float* rbias = (const float*)F.in[21];
    const int ngrp = T / NWAVES;
    constexpr int RPW = 4;
    for (int rg0 = F.blk; rg0 < ngrp; rg0 += RPW * F.G) {
        f32x4 v[RPW][4]; float ss[RPW];
#pragma unroll
        for (int u = 0; u < RPW; ++u) { const int rg = rg0 + u * F.G; const int row = (rg < ngrp ? rg : rg0) * NWAVES + F.wave, b = row >> 11;
            ss[u] = 0.f;
#pragma unroll
            for (int j = 0; j < 4; ++j) { const int col = 4 * F.lane + 256 * j;
                v[u][j] = *(const f32x4*)(xin + (size_t)row * D + col);
                if (NDELTA >= 1) {
                    const f32x4 g4 = *(const f32x4*)(gate + (size_t)b * 6144 + col);
                    f32x4 dl;
                    if (NDELTA == 1) { const v2u w = *(const v2u*)(delta + (size_t)row * D + col); dl = (f32x4){bflo(w.x), bfhi(w.x), bflo(w.y), bfhi(w.y)}; }
                    else { const v2u w0 = *(const v2u*)(delta + (size_t)row * 2 * D + col), w1 = *(const v2u*)(delta + (size_t)row * 2 * D + D + col);
                        dl = (f32x4){bflo(w0.x) + bflo(w1.x), bfhi(w0.x) + bfhi(w1.x), bflo(w0.y) + bflo(w1.y), bfhi(w0.y) + bfhi(w1.y)}; }
                    v[u][j] = v[u][j] + g4 * dl;
                }
                ss[u] += (v[u][j][0] * v[u][j][0] + v[u][j][1] * v[u][j][1]) + (v[u][j][2] * v[u][j][2] + v[u][j][3] * v[u][j][3]);
            }
        }
#pragma unroll
        for (int u = 0; u < RPW; ++u) { const int rg = rg0 + u * F.G; if (rg >= ngrp) continue;
            const int row = rg * NWAVES + F.wave, b = row >> 11;
            if (!FINAL && WRITEX) {
#pragma unroll
                for (int j = 0; j < 4; ++j) *(f32x4*)(xout + (size_t)row * D + 4 * F.lane + 256 * j) = v[u][j]; }
            const float rstd = 1.0f / sqrtf(wave_sum(ss[u]) * (1.0f / D) + 1e-6f);
#pragma unroll
            for (int j = 0; j < 4; ++j) { const int col = 4 * F.lane + 256 * j;
                const f32x4 g4 = *(const f32x4*)(gvec + col);
                f32x4 y = v[u][j] * rstd * g4;
                if (FINAL) { *(f32x4*)(fout + (size_t)row * D + col) = y; }
                else { const f32x4 sc = *(const f32x4*)(scale + (size_t)b * 6144 + col), sh = *(const f32x4*)(shift + (size_t)b * 6144 + col);
                    y = y * (1.0f + sc) + sh; v[u][j] = y;
                    v2u w; w.x = pk2(y[0], y[1]); w.y = pk2(y[2], y[3]); *(v2u*)(hout + (size_t)row * D + col) = w; }
            }
        }
        if (ROUTE) {
            const bool b5 = (F.lane & 32) != 0, b4 = (F.lane & 16) != 0, b3 = (F.lane & 8) != 0, b2 = (F.lane & 4) != 0;
            float t8[RPW][8];
#pragma unroll
            for (int k = 0; k < 8; ++k) {
                __builtin_amdgcn_sched_barrier(0);
                float aA[RPW], aB[RPW];
#pragma unroll
                for (int u = 0; u < RPW; ++u) { aA[u] = 0.f; aB[u] = 0.f; }
#pragma unroll
                for (int j = 0; j < 4; ++j) { const f32x4 wA = *(const LAS f32x4*)(rw_s + (2 * k) * 1024 + 256 * j + 4 * F.lane), wB = *(const LAS f32x4*)(rw_s + (2 * k + 1) * 1024 + 256 * j + 4 * F.lane);
#pragma unroll
                    for (int u = 0; u < RPW; ++u) { aA[u] += (v[u][j][0] * wA[0] + v[u][j][1] * wA[1]) + (v[u][j][2] * wA[2] + v[u][j][3] * wA[3]); aB[u] += (v[u][j][0] * wB[0] + v[u][j][1] * wB[1]) + (v[u][j][2] * wB[2] + v[u][j][3] * wB[3]); } }
#pragma unroll
                for (int u = 0; u < RPW; ++u) { const float keep = b5 ? aB[u] : aA[u], send = b5 ? aA[u] : aB[u]; t8[u][k] = keep + __shfl_xor(send, 32); }
            }
            __builtin_amdgcn_sched_barrier(0);
#pragma unroll
            for (int u = 0; u < RPW; ++u) { const int rg = rg0 + u * F.G; if (rg >= ngrp) continue;
                __builtin_amdgcn_sched_barrier(0);
                const int row = rg * NWAVES + F.wave;
                float t4[4], t2[2], t1;
#pragma unroll
                for (int k = 0; k < 4; ++k) { const float keep = b4 ? t8[u][k + 4] : t8[u][k], send = b4 ? t8[u][k] : t8[u][k + 4]; t4[k] = keep + swz_f<(16 << 10) | 0x1F>(send); }
#pragma unroll
                for (int k = 0; k < 2; ++k) { const float keep = b3 ? t4[k + 2] : t4[k], send = b3 ? t4[k] : t4[k + 2]; t2[k] = keep + swz_f<(8 << 10) | 0x1F>(send); }
                { const float keep = b2 ? t2[1] : t2[0], send = b2 ? t2[0] : t2[1]; t1 = keep + swz_f<(4 << 10) | 0x1F>(send); }
                t1 += swz_f<(2 << 10) | 0x1F>(t1); t1 += swz_f<(1 << 10) | 0x1F>(t1);
                float sc[16], bi[16];
#pragma unroll
                for (int e = 0; e < 16; ++e) { const int src = (e & 1) * 32 + ((e >> 1) & 1) * 4 + ((e >> 2) & 1) * 8 + ((e >> 3) & 1) * 16;
                    const float lgv = __builtin_bit_cast(float, __builtin_amdgcn_readlane(__builtin_bit_cast(int, t1), src)); sc[e] = sigmoidf_(lgv); bi[e] = sc[e] + rbias[e]; }
                float bestgs = -1e30f, s1 = 0.f, s2 = 0.f; int e1 = 0, e2 = 1;
#pragma unroll
                for (int g = 0; g < 4; ++g) {
                    float m1 = bi[4 * g], t1s = sc[4 * g]; int i1 = 0;
#pragma unroll
                    for (int k = 1; k < 4; ++k) if (bi[4 * g + k] > m1) { m1 = bi[4 * g + k]; t1s = sc[4 * g + k]; i1 = k; }
                    float m2 = -1e30f, t2s = 0.f; int i2 = 0;
#pragma unroll
                    for (int k = 0; k < 4; ++k) if (k != i1 && bi[4 * g + k] > m2) { m2 = bi[4 * g + k]; t2s = sc[4 * g + k]; i2 = k; }
                    const float gs = m1 + m2;
                    if (gs > bestgs) { bestgs = gs; e1 = 4 * g + i1; e2 = 4 * g + i2; s1 = t1s; s2 = t2s; }
                }
                if (F.lane == 0) {
                    const float inv = 1.0f / (s1 + s2);
                    float* topw = (float*)(F.ws + WS_TOPW);
                    topw[row * 2] = s1 * inv; topw[row * 2 + 1] = s2 * inv;
                    const unsigned p1 = __hip_atomic_fetch_add((LAS unsigned*)&lcnt[e1], 1u, __ATOMIC_RELAXED, __HIP_MEMORY_SCOPE_WORKGROUP), p2 = __hip_atomic_fetch_add((LAS unsigned*)&lcnt[e2], 1u, __ATOMIC_RELAXED, __HIP_MEMORY_SCOPE_WORKGROUP), n = __hip_atomic_fetch_add((LAS unsigned*)&nent[0], 2u, __ATOMIC_RELAXED, __HIP_MEMORY_SCOPE_WORKGROUP);
                    ent[2 * n] = ((unsigned)e1 << 16) | p1; ent[2 * n + 1] = (unsigned)(row * 2);
                    ent[2 * n + 2] = ((unsigned)e2 << 16) | p2; ent[2 * n + 3] = (unsigned)(row * 2 + 1);
                }
            }
        }
    }
    if (ROUTE) {
        __syncthreads();
        if (F.tid < 16) lbase[F.tid] = __hip_atomic_fetch_add(gcnt + 64 * F.tid, lcnt[F.tid], RLX_AGENT);
        __syncthreads();
        int* list = (int*)(F.ws + WS_LIST); const unsigned n = nent[0];
        for (unsigned i = F.tid; i < n; i += NTHR) { const unsigned key = ent[2 * i], val = ent[2 * i + 1], e = key >> 16, p = key & 0xffffu; list[(size_t)e * T + lbase[e] + p] = (int)val; }
        __syncthreads();
    }
}

__device__ __forceinline__ void compute_tpre(const Ctx& F, unsigned* gcnt) {
    if (F.tid < 16) F.MISC[40 + F.tid] = __hip_atomic_load(gcnt + 64 * F.tid, RLX_AGENT);
    __syncthreads();
    if (F.tid == 0) { unsigned acc = 0;
        for (int e = 0; e < 16; ++e) { F.MISC[16 + e] = acc; acc += (F.MISC[40 + e] + 255u) >> 8; }
        F.MISC[32] = acc; }
    __syncthreads();
}
__device__ __forceinline__ void dispatch_phase(const Ctx& F, unsigned* gcnt) {
    compute_tpre(F, gcnt);
    const int gw = F.blk * NWAVES + F.wave, NGW = F.G * NWAVES;
    const int nrows = (int)F.MISC[32] * 256;
    const bf16* H = (const bf16*)(F.ws + WS_HB); bf16* XS = (bf16*)(F.ws + WS_R1 + R1_XS);
    const int* list = (const int*)(F.ws + WS_LIST); const float* topw = (const float*)(F.ws + WS_TOPW);
    int* sloti = (int*)(F.ws + WS_SLOTI); float* slotw = (float*)(F.ws + WS_SLOTW);
    for (int r0 = gw; r0 < nrows; r0 += 4 * NGW) {
        v4u a[4], bq[4]; int info[4]; float w[4];
#pragma unroll
        for (int u = 0; u < 4; ++u) { const int r = r0 + u * NGW; a[u] = (v4u){0u, 0u, 0u, 0u}; bq[u] = a[u]; info[u] = -1; w[u] = 0.f;
            if (r < nrows) { const int pt = r >> 8; int e = 0;
#pragma unroll
                for (int j = 1; j < 16; ++j) e += (pt >= (int)F.MISC[16 + j]) ? 1 : 0;
                const int pos = r - (int)F.MISC[16 + e] * 256, cnt = (int)F.MISC[40 + e];
                if (pos < cnt) info[u] = list[(size_t)e * T + pos]; } }
#pragma unroll
        for (int u = 0; u < 4; ++u) if (info[u] >= 0) { w[u] = topw[info[u]]; const v4u* src = (const v4u*)(H + (size_t)(info[u] >> 1) * D); a[u] = src[F.lane]; bq[u] = src[64 + F.lane]; }
#pragma unroll
        for (int u = 0; u < 4; ++u) { const int r = r0 + u * NGW; if (r < nrows) { v4u* dst = (v4u*)(XS + (size_t)r * D); dst[F.lane] = a[u]; dst[64 + F.lane] = bq[u];
            if (F.lane == 0) { sloti[r] = info[u]; slotw[r] = w[u]; } } }
    }
}

typedef short mx_bf16x8 __attribute__((ext_vector_type(8)));
typedef float mx_f32x16 __attribute__((ext_vector_type(16)));
__device__ __forceinline__ float fgelu_tanh(float x);
__device__ __forceinline__ float fsigmoid(float x) { return __builtin_amdgcn_rcpf(1.f + __builtin_amdgcn_exp2f(-1.4426950408889634f * x)); }
__device__ __forceinline__ float fgelu_tanh(float x) { return x * fsigmoid(1.5957691216057308f * x * (1.0f + 0.044715f * x * x)); }
template <int CTRL> __device__ __forceinline__ float dpp_f(float old, float src) { return __builtin_bit_cast(float, __builtin_amdgcn_update_dpp(__builtin_bit_cast(int, old), __builtin_bit_cast(int, src), CTRL, 0xF, 0xF, false)); }
template <int CTRL> __device__ __forceinline__ void scan_step(float (&a)[16], float (&b)[16]) {
#pragma unroll
    for (int i = 0; i < 16; ++i) { const float ap = dpp_f<CTRL>(1.0f, a[i]), bp = dpp_f<CTRL>(0.0f, b[i]); b[i] = a[i] * bp + b[i]; a[i] = a[i] * ap; }
}
constexpr int MXL_WG = 0, MXL_MC = 36864, MXL_CB = 38400, MXL_CA = 39680;
template <bool OUT>
__device__ __forceinline__ void mix_phase(const Ctx& F, int jl) {
    const char* Zc = (const char*)(F.ws + WS_R1 + R1_Z); char* Yc = (char*)(F.ws + WS_HB);
    f32x2* AGG = (f32x2*)(F.ws + WS_R1 + R1_AGG); const float* CARRY = (const float*)(F.ws + WS_R1 + R1_CARRY);
    const int lane = F.lane, r32 = lane & 31, hh = lane >> 5;
    const int h = F.blk & 7, nhb = F.G >> 3, bi = F.blk >> 3;
    LAS unsigned char* wgl = F.lds + MXL_WG; LAS float* mcl = (LAS float*)(F.lds + MXL_MC); LAS float* cbl = (LAS float*)(F.lds + MXL_CB); LAS float* cal = (LAS float*)(F.lds + MXL_CA);
    {
        const bf16* WG = (const bf16*)(F.ws + WS_LRUW) + (size_t)jl * 2 * 2 * 8 * 4096;
        for (int i = F.tid; i < 4 * 64 * 8; i += NTHR) { const int td = i >> 9, out = (i >> 3) & 63, ck = i & 7;
            *(LAS v4u*)(wgl + (td * 64 + out) * 144 + ck * 16) = *(const v4u*)(WG + ((size_t)(td * 8 + h) * 64 + out) * 64 + ck * 8); }
        const float* MC = (const float*)(F.ws + WS_MCST) + (size_t)jl * 2 * 3 * 512;
        for (int i = F.tid; i < 384; i += NTHR) mcl[i] = MC[(i >> 6) * 512 + h * 64 + (i & 63)];
        const float* conv_b_w = (const float*)F.in[10] + (size_t)jl * 4 * 512; const float* conv_b_b = (const float*)F.in[11] + (size_t)jl * 512; const float* conv_a_w = (const float*)F.in[9] + (size_t)jl * 3 * 512;
        for (int i = F.tid; i < 320; i += NTHR) cbl[i] = (i < 256) ? conv_b_w[(i >> 6) * 512 + h * 64 + (i & 63)] : conv_b_b[h * 64 + (i & 63)];
        for (int i = F.tid; i < 192; i += NTHR) cal[i] = conv_a_w[(i >> 6) * 512 + h * 64 + (i & 63)];
        __syncthreads();
    }
    if (bi >= nhb) return;
    for (int pi = bi * 8 + F.wave; pi < 8 * 64; pi += nhb * 8) {
        const int c = pi & 63, b = pi >> 6, t0 = c * 32, t = t0 + r32, rbi = b * SEQ;
        float xr[2][16];
#pragma unroll
        for (int g = 0; g < 2; ++g) {
            __builtin_amdgcn_sched_barrier(0);
#pragma unroll
            for (int q = 0; q < 4; ++q) { const int cq = 32 * g + 8 * q + 4 * hh, chq = h * 64 + cq;
                f32x4 a4 = *(const LAS f32x4*)(cbl + 256 + cq);
#pragma unroll
                for (int k = 0; k < 4; ++k) { const int ts = t + k - 1; const bool ok = ts >= 0 && ts < SEQ; const int tc = ok ? ts : t;
                    const v2u w = *(const v2u*)(Zc + ((unsigned)(rbi + tc) * IN_AB + 2048u + chq) * 2u); f32x4 w4 = *(const LAS f32x4*)(cbl + k * 64 + cq);
                    if (!ok) w4 = (f32x4){0.f, 0.f, 0.f, 0.f};
                    a4 = a4 + w4 * (f32x4){bflo(w.x), bfhi(w.x), bflo(w.y), bfhi(w.y)}; }
                xr[g][4 * q] = a4[0]; xr[g][4 * q + 1] = a4[1]; xr[g][4 * q + 2] = a4[2]; xr[g][4 * q + 3] = a4[3]; } }
        __builtin_amdgcn_sched_barrier(0);
        mx_bf16x8 xb[4];
#pragma unroll
        for (int s = 0; s < 4; ++s) { const int g = s >> 1, o = 8 * (s & 1); v4u p; p.x = cvtpk(xr[g][o], xr[g][o + 1]); p.y = cvtpk(xr[g][o + 2], xr[g][o + 3]); p.z = cvtpk(xr[g][o + 4], xr[g][o + 5]); p.w = cvtpk(xr[g][o + 6], xr[g][o + 7]);
            xb[s] = __builtin_bit_cast(mx_bf16x8, p); }
#pragma nounroll
        for (int mt = 0; mt < 2; ++mt) {
            float hrec[16];
#pragma unroll
            for (int i = 0; i < 16; ++i) hrec[i] = 0.f;
            const v4u pa = mt ? __builtin_bit_cast(v4u, xb[2]) : __builtin_bit_cast(v4u, xb[0]), pb = mt ? __builtin_bit_cast(v4u, xb[3]) : __builtin_bit_cast(v4u, xb[1]);
#pragma unroll
            for (int dir = 0; dir < 2; ++dir) {
                __builtin_amdgcn_sched_barrier(0);
                mx_f32x16 accr, acci;
#pragma unroll
                for (int i = 0; i < 16; ++i) { accr[i] = 0.f; acci[i] = 0.f; }
                const unsigned wro = (unsigned)((0 * 2 + dir) * 64 + 32 * mt + r32) * 144u + 16u * hh, wxo = wro + 2u * 64u * 144u;
#pragma unroll
                for (int s = 0; s < 4; ++s) { const mx_bf16x8 ar = *(const LAS mx_bf16x8*)(wgl + wro + 32u * s), ax = *(const LAS mx_bf16x8*)(wgl + wxo + 32u * s);
                    accr = __builtin_amdgcn_mfma_f32_32x32x16_bf16(ar, xb[s], accr, 0, 0, 0); acci = __builtin_amdgcn_mfma_f32_32x32x16_bf16(ax, xb[s], acci, 0, 0, 0); }
                float av[16], bv[16];
#pragma unroll
                for (int q = 0; q < 4; ++q) { const int cl = 32 * mt + 8 * q + 4 * hh;
                    const f32x4 ba = *(const LAS f32x4*)(mcl + (dir * 3 + 0) * 64 + cl), bx = *(const LAS f32x4*)(mcl + (dir * 3 + 1) * 64 + cl), sp = *(const LAS f32x4*)(mcl + (dir * 3 + 2) * 64 + cl);
#pragma unroll
                    for (int e = 0; e < 4; ++e) { const int i = 4 * q + e;
                        const float r = fsigmoid(accr[i] + ba[e]), ig = fsigmoid(acci[i] + bx[e]);
                        const float a = __builtin_amdgcn_exp2f(-8.0f * 1.4426950408889634f * r * sp[e]);
                        const unsigned xw = (i < 8) ? pa[(i & 7) >> 1] : pb[(i & 7) >> 1];
                        av[i] = a; bv[i] = ((i & 1) ? bfhi(xw) : bflo(xw)) * ig * __builtin_amdgcn_sqrtf(fmaxf(1.0f - a * a, 0.f)); } }
                if (dir == 0) { scan_step<0x111>(av, bv); scan_step<0x112>(av, bv); scan_step<0x114>(av, bv); scan_step<0x118>(av, bv);
#pragma unroll
                    for (int i = 0; i < 16; ++i) { const float ap = swz_f<0x1E0>(av[i]), bp = swz_f<0x1E0>(bv[i]); if (r32 >= 16) { bv[i] = av[i] * bp + bv[i]; av[i] = av[i] * ap; } } }
                else { scan_step<0x101>(av, bv); scan_step<0x102>(av, bv); scan_step<0x104>(av, bv); scan_step<0x108>(av, bv);
#pragma unroll
                    for (int i = 0; i < 16; ++i) { const float ap = swz_f<0x200>(av[i]), bp = swz_f<0x200>(bv[i]); if (r32 < 16) { bv[i] = av[i] * bp + bv[i]; av[i] = av[i] * ap; } } }
                const unsigned gb = ((unsigned)(b * 2 + dir) * 64u + c) * 512u + h * 64 + 32 * mt + 4 * hh;
                if (!OUT) {
                    if (r32 == (dir ? 0 : 31)) {
#pragma unroll
                        for (int i = 0; i < 16; ++i) *(f32x2*)((char*)AGG + (gb + (i & 3) + 8 * (i >> 2)) * 8u) = (f32x2){av[i], bv[i]}; }
                } else {
#pragma unroll
                    for (int q = 0; q < 4; ++q) { const f32x4 cin = *(const f32x4*)((const char*)CARRY + (gb + 8 * q) * 4u);
#pragma unroll
                        for (int e = 0; e < 4; ++e) hrec[4 * q + e] += av[4 * q + e] * cin[e] + bv[4 * q + e]; }
                }
            }
            if (OUT) {
#pragma unroll
                for (int q = 0; q < 4; ++q) { const int chq = h * 64 + 32 * mt + 8 * q + 4 * hh;
                    const v2u w = *(const v2u*)(Zc + ((unsigned)(rbi + t) * IN_AB + 1536u + chq) * 2u);
                    v2u o; o.x = cvtpk(fgelu_tanh(bflo(w.x)) * hrec[4 * q], fgelu_tanh(bfhi(w.x)) * hrec[4 * q + 1]); o.y = cvtpk(fgelu_tanh(bflo(w.y)) * hrec[4 * q + 2], fgelu_tanh(bfhi(w.y)) * hrec[4 * q + 3]);
                    *(v2u*)(Yc + ((unsigned)(rbi + t) * D + 512u + chq) * 2u) = o; }
            }
        }
        if (!OUT) {
            const int ch = h * 64 + lane; const unsigned zl = (unsigned)ch * 2u;
            float wA[3];
#pragma unroll
            for (int k = 0; k < 3; ++k) wA[k] = cal[k * 64 + lane];
            float prod[34];
#pragma unroll
            for (int u = 0; u < 34; ++u) { const int ts = t0 + u - 1; const bool ok = ts >= 0 && ts < SEQ; const int tc = ok ? ts : t0; const unsigned zk = zl + (unsigned)(rbi + tc) * (IN_AB * 2u);
                const float p = bf2f(*(const bf16*)(Zc + zk + 2048u)) * bf2f(*(const bf16*)(Zc + zk)); prod[u] = ok ? p : 0.f; }
#pragma unroll
            for (int u = 0; u < 32; ++u) { const unsigned zr = zl + (unsigned)(rbi + t0 + u) * (IN_AB * 2u);
                const float ya = bf2f(*(const bf16*)(Zc + zr + 1024u)) * (wA[0] * prod[u] + wA[1] * prod[u + 1] + wA[2] * prod[u + 2]);
                *(bf16*)(Yc + ((unsigned)(rbi + t0 + u) * D + ch) * 2u) = (bf16)f2bf(ya); }
        }
    }
}
__device__ __forceinline__ void carry_phase(const Ctx& F) {
    const f32x2* AGG = (const f32x2*)(F.ws + WS_R1 + R1_AGG); float* CARRY = (float*)(F.ws + WS_R1 + R1_CARRY);
    const int gw = F.blk * NWAVES + F.wave, NGW = F.G * NWAVES;
    for (int item = gw; item < 128; item += NGW) { const int bd = item >> 3, ch = (item & 7) * 64 + F.lane, dir = bd & 1;
        f32x2 pg[64];
#pragma unroll
        for (int cc = 0; cc < 64; ++cc) pg[cc] = AGG[((size_t)bd * 64 + cc) * 512 + ch];
        float hsv = 0.f;
        if (dir == 0) {
#pragma unroll
            for (int cc = 0; cc < 64; ++cc) { CARRY[((size_t)bd * 64 + cc) * 512 + ch] = hsv; hsv = pg[cc].x * hsv + pg[cc].y; } }
        else {
#pragma unroll
            for (int cc = 63; cc >= 0; --cc) { CARRY[((size_t)bd * 64 + cc) * 512 + ch] = hsv; hsv = pg[cc].x * hsv + pg[cc].y; } }
    }
}

__device__ __forceinline__ void attn_naive_phase(const Ctx& F) {
    const bf16* QKV = (const bf16*)(F.ws + WS_R1 + R1_Z); bf16* Y = (bf16*)(F.ws + WS_HB);
    LAS float* qs = (LAS float*)(F.lds + F.wave * 4096);
    LAS float* ps = qs + 64;
    const int gw = F.blk * NWAVES + F.wave, NGW = F.G * NWAVES;
    for (int unit = gw; unit < T * 16; unit += NGW) {
        const int row = unit >> 4, hd = unit & 15, b = row >> 11, t = row & 2047; const size_t rb = (size_t)b * SEQ;
        qs[F.lane] = bf2f(QKV[(size_t)row * NQKV + hd * 64 + F.lane]) * 0.125f;
        LDS_WAIT(); asm volatile("" ::: "memory");
        float sc[7]; float mx = -1e30f;
#pragma unroll
        for (int i = 0; i < 7; ++i) { const int n = F.lane + 64 * i, p = n / 129, jj = n - p * 129 - 64, dd = (p == 0) ? 1 : (p == 1) ? 4 : 16, tk = t + dd * jj;
            const bool valid = (n < 387) && tk >= 0 && tk < SEQ; float dot = -1e30f;
            if (valid) { const v4u* kp = (const v4u*)(QKV + (rb + tk) * NQKV + 1024 + hd * 64); dot = 0.f;
#pragma unroll
                for (int q = 0; q < 8; ++q) { const v4u w = kp[q]; const LAS float* qq = qs + q * 8;
                    dot += qq[0] * bflo(w.x) + qq[1] * bfhi(w.x) + qq[2] * bflo(w.y) + qq[3] * bfhi(w.y) + qq[4] * bflo(w.z) + qq[5] * bfhi(w.z) + qq[6] * bflo(w.w) + qq[7] * bfhi(w.w); } }
            sc[i] = dot; mx = fmaxf(mx, dot); }
        mx = wave_max(mx); float sum = 0.f;
#pragma unroll
        for (int i = 0; i < 7; ++i) { const float pr = (sc[i] > -1e29f) ? expf(sc[i] - mx) : 0.f; ps[F.lane + 64 * i] = pr; sum += pr; }
        sum = wave_sum(sum);
        LDS_WAIT(); asm volatile("" ::: "memory");
        float o = 0.f;
#pragma unroll
        for (int p = 0; p < 3; ++p) { const int dd = (p == 0) ? 1 : (p == 1) ? 4 : 16;
#pragma unroll 4
            for (int jj = -64; jj <= 64; ++jj) { const int tk = t + dd * jj; if (tk < 0 || tk >= SEQ) continue;
                o += ps[p * 129 + jj + 64] * bf2f(QKV[(rb + tk) * NQKV + 2048 + hd * 64 + F.lane]); } }
        Y[(size_t)row * D + hd * 64 + F.lane] = (bf16)f2bf(o / sum);
        LDS_WAIT(); asm volatile("" ::: "memory");
    }
}

typedef short bf16x8 __attribute__((ext_vector_type(8)));
typedef short s16x4 __attribute__((ext_vector_type(4)));
typedef float f32x16 __attribute__((ext_vector_type(16)));
typedef short v4i16_t __attribute__((ext_vector_type(4)));
constexpr int ATT_STO = 69632, ATT_STM = 69632 + 65536;
template <int MODE> __device__ __forceinline__ bool attn_tile_info(int ti, int w, int r16, int qt0, int& d, int& ktok0) {
    if (MODE == 0) {
        if (ti < 5) { const int tt = (ti == 0) ? 2 : (ti <= 2 ? ti - 1 : ti); const int jt = 32 * w - 64 + 32 * tt; d = 16; ktok0 = r16 + 16 * jt; return jt >= 0 && jt < 128; }
        const int jt = 128 * w - 64 + 32 * (ti - 5); d = 4; ktok0 = (r16 & 3) + 4 * jt; return jt >= 0 && jt < 512;
    }
    d = 1; ktok0 = qt0 - 64 + 32 * ti; return ktok0 >= 0 && ktok0 < SEQ;
}
template <int MODE, int NT>
__device__ __forceinline__ void attn_run(const bf16* kbase, LAS unsigned char* kl, LAS unsigned char* vl, int lane, int w, int r16, int qt0, int qtok, const bf16x8 (&qf)[4],
                                         f32x16& o0, f32x16& o1, float& mrun, float& lrun) {
    const int h = lane >> 5, r = lane & 31;
    const int srow = lane >> 3, sch = lane & 7;
    const unsigned kst = srow * 144 + sch * 16, vst = (sch >> 2) * 2048 + srow * 64 + (sch & 3) * 16;
    const unsigned krd = r * 144 + h * 16;
    const int gi = (lane >> 4) & 1, i16 = lane & 15;
    const unsigned vrd = (4 * h + (i16 >> 2)) * 64 + gi * 32 + (i16 & 3) * 8;
    const float cexp = 0.125f * 1.4426950408889634f;
    int d = 1, ktok0 = 0; bool inr = attn_tile_info<MODE>(0, w, r16, qt0, d, ktok0);
    v4u kg[4], vg[4];
#pragma unroll
    for (int i = 0; i < 4; ++i) { int tok = ktok0 + d * (srow + 8 * i); tok = tok < 0 ? 0 : (tok > SEQ - 1 ? SEQ - 1 : tok); const bf16* p = kbase + (size_t)tok * NQKV; kg[i] = *(const v4u*)p; vg[i] = *(const v4u*)(p + 1024); }
#pragma nounroll
    for (int ti = 0; ti < NT; ++ti) {
        const int dcur = d, kcur = ktok0; const bool inrcur = inr;
#pragma unroll
        for (int i = 0; i < 4; ++i) { *(LAS v4u*)(kl + kst + i * 8 * 144) = kg[i]; *(LAS v4u*)(vl + vst + i * 8 * 64) = vg[i]; }
        if (ti + 1 < NT) {
            inr = attn_tile_info<MODE>(ti + 1, w, r16, qt0, d, ktok0);
#pragma unroll
            for (int i = 0; i < 4; ++i) { int tok = ktok0 + d * (srow + 8 * i); tok = tok < 0 ? 0 : (tok > SEQ - 1 ? SEQ - 1 : tok); const bf16* p = kbase + (size_t)tok * NQKV; kg[i] = *(const v4u*)p; vg[i] = *(const v4u*)(p + 1024); }
        }
        f32x16 s;
#pragma unroll
        for (int i = 0; i < 16; ++i) s[i] = 0.f;
#pragma unroll
        for (int kk = 0; kk < 4; ++kk) { const bf16x8 kf = *(const LAS bf16x8*)(kl + krd + 32 * kk); s = __builtin_amdgcn_mfma_f32_32x32x16_bf16(kf, qf[kk], s, 0, 0, 0); }
        const int lim = 64 * dcur; const unsigned ub = (unsigned)(inrcur ? (kcur - qtok + dcur * 4 * h + lim) : 0x40000000), ul = 2u * (unsigned)lim; float mx = -1e30f;
#pragma unroll
        for (int i = 0; i < 16; ++i) { const unsigned u = ub + (unsigned)(dcur * ((i & 3) + 8 * (i >> 2))); s[i] = (u <= ul) ? s[i] : -1e30f; mx = fmaxf(mx, s[i]); }
        mx = fmaxf(mx, __shfl_xor(mx, 32));
        const float mnew = fmaxf(mrun, mx), alpha = __builtin_amdgcn_exp2f((mrun - mnew) * cexp), mc = mnew * cexp; mrun = mnew;
        float ps = 0.f;
#pragma unroll
        for (int i = 0; i < 16; ++i) { s[i] = __builtin_amdgcn_exp2f(s[i] * cexp - mc); ps += s[i]; }
        ps += __shfl_xor(ps, 32);
        lrun = lrun * alpha + ps;
#pragma unroll
        for (int i = 0; i < 16; ++i) { o0[i] *= alpha; o1[i] *= alpha; }
#pragma unroll
        for (int sx = 0; sx < 2; ++sx) {
            v4u pw; pw.x = cvtpk(s[8 * sx + 0], s[8 * sx + 1]); pw.y = cvtpk(s[8 * sx + 2], s[8 * sx + 3]); pw.z = cvtpk(s[8 * sx + 4], s[8 * sx + 5]); pw.w = cvtpk(s[8 * sx + 6], s[8 * sx + 7]);
            const bf16x8 pf = __builtin_bit_cast(bf16x8, pw);
#pragma unroll
            for (int dt = 0; dt < 2; ++dt) {
                const s16x4 va = __builtin_bit_cast(s16x4, __builtin_amdgcn_ds_read_tr16_b64_v4i16((LAS v4i16_t*)(vl + vrd + dt * 2048 + (16 * sx) * 64)));
                const s16x4 vb = __builtin_bit_cast(s16x4, __builtin_amdgcn_ds_read_tr16_b64_v4i16((LAS v4i16_t*)(vl + vrd + dt * 2048 + (16 * sx + 8) * 64)));
                const bf16x8 vf = {va[0], va[1], va[2], va[3], vb[0], vb[1], vb[2], vb[3]};
                if (dt == 0) o0 = __builtin_amdgcn_mfma_f32_32x32x16_bf16(vf, pf, o0, 0, 0, 0); else o1 = __builtin_amdgcn_mfma_f32_32x32x16_bf16(vf, pf, o1, 0, 0, 0);
            }
        }
    }
}
__device__ __forceinline__ void attn_phase(const Ctx& F) {
    const bf16* QKV = (const bf16*)(F.ws + WS_R1 + R1_Z); bf16* Y = (bf16*)(F.ws + WS_HB);
    LAS unsigned char* kl = F.lds + F.wave * 8704;
    LAS unsigned char* vl = kl + 4608;
    LAS unsigned char* sto = F.lds + ATT_STO; LAS f32x2* stm = (LAS f32x2*)(F.lds + ATT_STM);
    const int lane = F.lane, r = lane & 31, h = lane >> 5;
    for (int bu = F.blk; bu < 512; bu += F.G) {
        const int w = bu & 3, hd = (bu >> 2) & 15, b = bu >> 6; const size_t rb = (size_t)b * SEQ;
        const bf16* kbase = QKV + rb * NQKV + 1024 + hd * 64 + (lane & 7) * 8;
#pragma nounroll
        for (int sub = 0; sub < 2; ++sub) {
            const int r16 = 2 * F.wave + sub, tl = 16 * r + r16, qtok = w * 512 + tl;
            bf16x8 qf[4];
            { const bf16* qp = QKV + (rb + qtok) * NQKV + hd * 64 + 8 * h;
#pragma unroll
              for (int kk = 0; kk < 4; ++kk) qf[kk] = *(const bf16x8*)(qp + 16 * kk); }
            f32x16 o0, o1;
#pragma unroll
            for (int i = 0; i < 16; ++i) { o0[i] = 0.f; o1[i] = 0.f; }
            float mrun = -1e30f, lrun = 0.f;
            attn_run<0, 13>(kbase, kl, vl, lane, w, r16, 0, qtok, qf, o0, o1, mrun, lrun);
#pragma unroll
            for (int g = 0; g < 4; ++g) {
                v2u w0; w0.x = cvtpk(o0[4 * g], o0[4 * g + 1]); w0.y = cvtpk(o0[4 * g + 2], o0[4 * g + 3]); *(LAS v2u*)(sto + tl * 128 + (8 * g + 4 * h) * 2) = w0;
                v2u w1; w1.x = cvtpk(o1[4 * g], o1[4 * g + 1]); w1.y = cvtpk(o1[4 * g + 2], o1[4 * g + 3]); *(LAS v2u*)(sto + tl * 128 + (32 + 8 * g + 4 * h) * 2) = w1; }
            if (h == 0) stm[tl] = (f32x2){mrun, lrun};
        }
        __syncthreads();
#pragma nounroll
        for (int sub = 0; sub < 2; ++sub) {
            const int g32 = 2 * F.wave + sub, tl = 32 * g32 + r, qt0 = w * 512 + 32 * g32, qtok = qt0 + r;
            bf16x8 qf[4];
            { const bf16* qp = QKV + (rb + qtok) * NQKV + hd * 64 + 8 * h;
#pragma unroll
              for (int kk = 0; kk < 4; ++kk) qf[kk] = *(const bf16x8*)(qp + 16 * kk); }
            f32x16 o0, o1;
#pragma unroll
            for (int g = 0; g < 4; ++g) { const v2u w0 = *(const LAS v2u*)(sto + tl * 128 + (8 * g + 4 * h) * 2), w1 = *(const LAS v2u*)(sto + tl * 128 + (32 + 8 * g + 4 * h) * 2);
                o0[4 * g] = bflo(w0.x); o0[4 * g + 1] = bfhi(w0.x); o0[4 * g + 2] = bflo(w0.y); o0[4 * g + 3] = bfhi(w0.y);
                o1[4 * g] = bflo(w1.x); o1[4 * g + 1] = bfhi(w1.x); o1[4 * g + 2] = bflo(w1.y); o1[4 * g + 3] = bfhi(w1.y); }
            const f32x2 ml = stm[tl]; float mrun = ml.x, lrun = ml.y;
            attn_run<1, 5>(kbase, kl, vl, lane, w, 0, qt0, qtok, qf, o0, o1, mrun, lrun);
            const float inv = 1.0f / lrun;
            bf16* yp = Y + (rb + qtok) * D + hd * 64 + 4 * h;
#pragma unroll
            for (int g = 0; g < 4; ++g) {
                v2u w0; w0.x = cvtpk(o0[4 * g] * inv, o0[4 * g + 1] * inv); w0.y = cvtpk(o0[4 * g + 2] * inv, o0[4 * g + 3] * inv); *(v2u*)(yp + 8 * g) = w0;
                v2u w1; w1.x = cvtpk(o1[4 * g] * inv, o1[4 * g + 1] * inv); w1.y = cvtpk(o1[4 * g + 2] * inv, o1[4 * g + 3] * inv); *(v2u*)(yp + 32 + 8 * g) = w1; }
        }
        __syncthreads();
    }
}
#ifndef REP_P0
#define REP_P0 1
#endif
#ifndef REP_G1
#define REP_G1 1
#endif
#ifndef REP_MIX
#define REP_MIX 1
#endif
#ifndef REP_ATT
#define REP_ATT 1
#endif
#ifndef REP_G2
#define REP_G2 1
#endif
#ifndef REP_DISP
#define REP_DISP 1
#endif
#ifndef REP_GU
#define REP_GU 1
#endif
#ifndef REP_DN
#define REP_DN 1
#endif
#define REPEAT(n) _Pragma("unroll") for (int rep_ = 0; rep_ < (n); ++rep_)
#ifndef EN_P0
#define EN_P0 1
#endif
#ifndef EN_N1
#define EN_N1 1
#endif
#ifndef EN_G1E
#define EN_G1E 1
#endif
#ifndef EN_G1O
#define EN_G1O 1
#endif
#ifndef EN_MIXA
#define EN_MIXA 1
#endif
#ifndef EN_MIXB
#define EN_MIXB 1
#endif
#ifndef EN_ATT
#define EN_ATT 1
#endif
#ifndef EN_G2
#define EN_G2 1
#endif
#ifndef EN_N2
#define EN_N2 1
#endif
#ifndef EN_DISP
#define EN_DISP 1
#endif
#ifndef EN_GU
#define EN_GU 1
#endif
#ifndef EN_DN
#define EN_DN 1
#endif
#ifndef EN_FIN
#define EN_FIN 1
#endif

struct Args { const void* in[25]; float* out; unsigned char* ws; int ph_lo, ph_hi; };
constexpr int NPHASE = 2 + 10 * DEPTH;

__global__ void __launch_bounds__(NTHR, 2) fwd(Args args) {
    extern __shared__ __attribute__((aligned(16))) unsigned char lds[];
    Ctx F;
    F.lds0 = (LAS unsigned char*)lds; F.lds = F.lds0; F.MISC = (volatile LAS unsigned*)(F.lds + MISC_OFF);
    F.tid = threadIdx.x; F.lane = F.tid & 63; F.wave = __builtin_amdgcn_readfirstlane(F.tid >> 6);
    F.G = gridDim.x; F.blk = blockIdx.x; launder(F);
    for (int u = F.tid; u < 256; u += NTHR) ((LAS unsigned*)(F.lds + MISC_OFF))[u] = 0u;
    __syncthreads();
#if MK_ONE_LAUNCH
    XcdBarrier bar = xcd_barrier_post(F.ctl + CW_BAR, F.MISC + 8);
#ifndef REP_BAR
#define REP_BAR 1
#endif
#define GRID_BAR() do { _Pragma("unroll") for (int rb_ = 0; rb_ < REP_BAR; ++rb_) xcd_barrier(bar); } while (0)
#else
#define GRID_BAR() do { } while (0)
#endif
#define IN(k) (launder(F) && F.lo <= (k) && (k) < F.hi)
#ifndef PROBE_TMASK
#define PROBE_TMASK 0
#endif
    unsigned long long t_prev = 0ull, t_acc = 0ull; int t_cls = -1;
#define TCLS(c) do { if (PROBE_TMASK) { const unsigned long long now_ = wall_clock64(); if (t_cls >= 0 && ((PROBE_TMASK >> t_cls) & 1)) t_acc += now_ - t_prev; t_prev = now_; t_cls = (c); } } while (0)
#define SEAM(k) do { if (IN(k) && IN((k) + 1)) GRID_BAR(); } while (0)
#define WSP (F.ws)
#define MOD ((const float*)(F.ws + WS_MOD))
#define X ((float*)(F.ws + WS_X))
#define HB ((bf16*)(F.ws + WS_HB))
#define R1Z ((bf16*)(F.ws + WS_R1 + R1_Z))
#define DELTA ((bf16*)(F.ws + WS_R1 + R1_DELTA))
#define XS ((bf16*)(F.ws + WS_R1 + R1_XS))
#define ACT ((bf16*)(F.ws + WS_R1 + R1_ACT))
#define YW ((bf16*)(F.ws + WS_R1 + R1_YW))

    TCLS(0);
    if (EN_P0 && IN(0)) { REPEAT(REP_P0) p0_prologue(F); } SEAM(0);

    for (int l = 0; l < DEPTH; ++l) {
        const int base = 1 + 10 * l, jl = l >> 1; const bool even = (l & 1) == 0;
#define modl (MOD + (size_t)l * 8 * 6144)
#define gcnt (F.ctl + CW_CNT + 1024 * l)
        TCLS(1);
        if (EN_N1 && IN(base + 0)) {
            const float* gv = (const float*)F.in[5] + (size_t)l * D;
            if (l == 0) norm_phase<0, false, false, false>(F, (const float*)F.in[0], nullptr, nullptr, nullptr, gv, modl + 0, modl + 1024, HB, nullptr, nullptr);
            else norm_phase<2, false, false, false>(F, X, nullptr, YW, MOD + (size_t)(l - 1) * 8 * 6144 + 5120, gv, modl + 0, modl + 1024, HB, nullptr, nullptr);
        }
        SEAM(base + 0);
        TCLS(2);
        if (IN(base + 1)) REPEAT(REP_G1) {
            if (!EN_G1E && even) {} else if (even) { pg8::StaticOrder S; S.init(HB, (const bf16*)(WSP + WS_WIN) + (size_t)jl * IN_AB * D, T, IN_AB, D, F.G, F.blk);
                pg8::EpiStore E{R1Z, IN_AB};
                pg8::gemm_phase<pg8::EpiStore, pg8::StaticOrder, true, true>(F.lds, D, S, E, F.tid); }
            else if (EN_G1O) { pg8::StaticOrder S; S.init(HB, (const bf16*)(WSP + WS_WQKV) + (size_t)jl * NQKV * D, T, NQKV, D, F.G, F.blk);
                pg8::EpiQKV E{R1Z, (const float*)(WSP + WS_ROT)};
                pg8::gemm_phase<pg8::EpiQKV, pg8::StaticOrder, true, true>(F.lds, D, S, E, F.tid); }
        }
        SEAM(base + 1);
        TCLS(even ? 3 : 6);
        if (IN(base + 2)) { if (even) { if (EN_MIXA) REPEAT(REP_MIX) mix_phase<false>(F, jl); } else { if (EN_ATT) REPEAT(REP_ATT) attn_phase(F); } }
        SEAM(base + 2);
        TCLS(4);
        if (IN(base + 3)) { if (even) carry_phase(F); }
        if (even) SEAM(base + 3);
        TCLS(5);
        if (EN_MIXB && IN(base + 4)) { if (even) REPEAT(REP_MIX) mix_phase<true>(F, jl); }
        if (even) SEAM(base + 4);
        TCLS(7);
        if (EN_G2 && IN(base + 5)) REPEAT(REP_G2) {
            pg8::StaticOrder S; S.init(HB, even ? (const bf16*)(WSP + WS_WOUT) + (size_t)jl * D * D : (const bf16*)(WSP + WS_WO) + (size_t)jl * D * D, T, D, D, F.G, F.blk);
            pg8::EpiX E{l == 0 ? (const float*)F.in[0] : (const float*)X, X, l == 0 ? (const bf16*)nullptr : (const bf16*)YW, modl + 2048, MOD + (size_t)(l > 0 ? l - 1 : 0) * 8 * 6144 + 5120};
            pg8::gemm_phase<pg8::EpiX, pg8::StaticOrder, true, true>(F.lds, D, S, E, F.tid);
        }
        SEAM(base + 5);
        TCLS(8);
        if (EN_N2 && IN(base + 6)) norm_phase<0, true, false, false>(F, X, nullptr, nullptr, nullptr, (const float*)F.in[6] + (size_t)l * D, modl + 3072, modl + 4096, HB, nullptr, gcnt);
        SEAM(base + 6);
        TCLS(9);
        if (EN_GU && IN(base + 8)) REPEAT(REP_GU) {
            compute_tpre(F, gcnt);
            { volatile LAS unsigned* TOK = (volatile LAS unsigned*)(F.lds + ENT_OFF);
              const int* list = (const int*)(WSP + WS_LIST); const float* topw = (const float*)(WSP + WS_TOPW); int* sloti = (int*)(WSP + WS_SLOTI); float* slotw = (float*)(WSP + WS_SLOTW);
              const int total = (int)F.MISC[32] * 4;
              for (int ui = 0; ui < 4; ++ui) { const int L = ui * F.G + F.blk; if (L >= total) break;
                  if (F.tid < 256) { const int pt = L >> 2; int e = 0;
#pragma unroll
                      for (int j = 1; j < 16; ++j) e += (pt >= (int)F.MISC[16 + j]) ? 1 : 0;
                      const int pos = (pt - (int)F.MISC[16 + e]) * 256 + F.tid, cnt = (int)F.MISC[40 + e];
                      const int info = (pos < cnt) ? list[(size_t)e * T + pos] : -1;
                      TOK[ui * 256 + F.tid] = info >= 0 ? (unsigned)(info >> 1) : 0u;
                      if ((L & 3) == 0) { sloti[pt * 256 + F.tid] = info; slotw[pt * 256 + F.tid] = info >= 0 ? topw[info] : 0.f; } } }
              __syncthreads(); }
            pg8::MoeGatherOrder S; S.A = (const char*)HB; S.Bt = (const char*)((const bf16*)(WSP + WS_WGU) + (size_t)l * NE * 1024 * 1024); S.tstep = (size_t)256 * 1024 * 2; S.estride = (size_t)1024 * 1024 * 2; S.G = F.G; S.c = F.blk;
            S.tp = F.MISC + 16; S.tok = (const volatile LAS unsigned*)(F.lds + ENT_OFF); S.rowbytes = 2048u;
            pg8::EpiGU E{ACT};
            pg8::gemm_phase<pg8::EpiGU, pg8::MoeGatherOrder, true, true>(F.lds, 1024, S, E, F.tid);
        }
        SEAM(base + 8);
        TCLS(10);
        if (EN_DN && IN(base + 9)) REPEAT(REP_DN) {
            compute_tpre(F, gcnt);
            pg8::MoeOrder S; S.A = (const char*)ACT; S.Bt = (const char*)((const bf16*)(WSP + WS_WDN) + (size_t)l * NE * 1024 * 512); S.tstep = (size_t)256 * 512 * 2; S.estride = (size_t)1024 * 512 * 2; S.G = F.G; S.c = F.blk;
            S.tp = F.MISC + 16;
            pg8::EpiDN E{YW, (const int*)(WSP + WS_SLOTI), (const float*)(WSP + WS_SLOTW)};
            pg8::gemm_phase<pg8::EpiDN, pg8::MoeOrder, true, true>(F.lds, 512, S, E, F.tid);
        }
        SEAM(base + 9);
    }
    TCLS(11);
    if (EN_FIN && IN(NPHASE - 1)) norm_phase<2, false, true>(F, X, nullptr, YW, MOD + (size_t)3 * 8 * 6144 + 5120, (const float*)F.in[7], nullptr, nullptr, nullptr, args.out, nullptr);
    TCLS(12);
    if (PROBE_TMASK) { if (blockIdx.x == 0 && threadIdx.x == 0) { const unsigned long long s0 = wall_clock64(); while (wall_clock64() - s0 < 8ull * t_acc) __builtin_amdgcn_s_sleep(8); } }
#undef IN
#undef SEAM
#undef WSP
#undef MOD
#undef X
#undef HB
#undef R1Z
#undef DELTA
#undef XS
#undef ACT
#undef YW
#undef modl
#undef gcnt
}

extern "C" void kernel_launch(void* const* d_in, const int* in_sizes, int n_in, void* d_out, int out_size, void* d_ws, size_t ws_size, hipStream_t stream) {
    static int grid = 0;
    if (grid == 0) {
        if (n_in != 25 || in_sizes[0] != T * D || out_size != T * D || ws_size < WS_END) { fprintf(stderr, "kernel_launch: unexpected shapes / workspace (n_in %d, ws %zu); nothing launched\n", n_in, ws_size); grid = -1; return; }
        int dev = 0, cus = 0, per_cu = 0;
        if (hipGetDevice(&dev) != hipSuccess || hipDeviceGetAttribute(&cus, hipDeviceAttributeMultiprocessorCount, dev) != hipSuccess) { grid = -1; return; }
        if (hipFuncSetAttribute((const void*)fwd, hipFuncAttributeMaxDynamicSharedMemorySize, LDS_BYTES) != hipSuccess) { fprintf(stderr, "kernel_launch: hipFuncSetAttribute failed\n"); grid = -1; return; }
        if (hipOccupancyMaxActiveBlocksPerMultiprocessor(&per_cu, (const void*)fwd, NTHR, LDS_BYTES) != hipSuccess || per_cu < 1) { fprintf(stderr, "kernel_launch: occupancy query reports %d\n", per_cu); }
        (void)hipGetLastError();
        grid = cus;
    }
    if (grid < 0) return;
    if (hipMemsetAsync((char*)d_ws + WS_CTL, 0, CTL_ZERO_BYTES, stream) != hipSuccess) return;
    Args a{};
    for (int i = 0; i < 25; ++i) a.in[i] = d_in[i];
    a.out = (float*)d_out; a.ws = (unsigned char*)d_ws;
#if MK_ONE_LAUNCH
    a.ph_lo = 0; a.ph_hi = NPHASE;
    hipLaunchKernelGGL(fwd, dim3(grid), dim3(NTHR), LDS_BYTES, stream, a);
#else
    for (int p = 0; p < NPHASE; ++p) {
        if (p >= 1 && p < NPHASE - 1) { const int l = (p - 1) / 10, s = (p - 1) % 10; if (s == 7 || ((l & 1) == 1 && (s == 3 || s == 4))) continue; }
        a.ph_lo = p; a.ph_hi = p + 1;
        hipLaunchKernelGGL(fwd, dim3(grid), dim3(NTHR), LDS_BYTES, stream, a);
    }
#endif
}
```

```cpp
#include <hip/hip_runtime.h>
#include <cstdio>
#include <cstdint>

#ifndef MK_ONE_LAUNCH
#define MK_ONE_LAUNCH 1
#endif

namespace pg8 {
#define PG8_LAS __attribute__((address_space(3)))
typedef unsigned short bf16_t;
typedef short bf16x8 __attribute__((ext_vector_type(8)));
typedef float f32x4 __attribute__((ext_vector_type(4)));
typedef unsigned u32x4 __attribute__((ext_vector_type(4)));
constexpr int BM = 256, BK = 64, HALF = 128, HTB = HALF * BK * 2  , STAGE_BYTES = 8 * HTB, NXCD = 8, WGM = 8;

__host__ __device__ __forceinline__ int lds_byte(int r, int c) { const int st = (r >> 4) * 2 + (c >> 5), rr = r & 15, cc = c & 31, ob = rr * 64 + cc * 2; return st * 1024 + (ob ^ (((ob >> 9) & 1) << 5)); }
__host__ __device__ __forceinline__ void stage_rc(int b, int& R, int& C) { const int st = b / 1024, sb = b % 1024, swz = sb ^ (((sb >> 9) & 1) << 5); R = (st >> 1) * 16 + swz / 64; C = (st & 1) * 32 + (swz % 64) / 2; }
__host__ __device__ __forceinline__ int perm32(int rho) { const int n = rho >> 4, i = rho & 15; return 8 * (i >> 2) + 4 * n + (i & 3); }

struct Unit { int pm, pn, e; };

struct StaticOrder {
    static constexpr bool GATHER = false;
    const char* A; const char* Bt; size_t tstep;
    int nM, nN, nwg, G, c;
    __device__ void init(const void* A_, const void* Bt_, int M, int N, int K, int G_, int c_) { A = (const char*)A_; Bt = (const char*)Bt_; tstep = (size_t)256 * K * 2; nM = M / BM; nN = N / BM; nwg = nM * nN; G = G_; c = c_; }
    __device__ bool next(int i, Unit& u) const {
        const long L = (long)i * G + c; if (L >= nwg) return false;
        int wgid = (int)L; { const int q = nwg / NXCD, r = nwg % NXCD, xcd = wgid % NXCD, off = wgid / NXCD; wgid = (xcd < r ? xcd * (q + 1) : r * (q + 1) + (xcd - r) * q) + off; }
        const int nig = WGM * nN, gid = wgid / nig, fm = gid * WGM, gsz = (nM - fm) < WGM ? (nM - fm) : WGM;
        u.pm = fm + ((wgid % nig) % gsz); u.pn = (wgid % nig) / gsz; u.e = 0; return true;
    }
    __device__ __forceinline__ const char* a_base(const Unit& u) const { return A + (size_t)u.pm * tstep; }
    __device__ __forceinline__ unsigned a_off(int, int, int, int) const { return 0u; }
    __device__ __forceinline__ const char* b_base(const Unit& u) const { return Bt + (size_t)u.pn * tstep; }
    __device__ __forceinline__ void a_ready(const Unit&) const {}
    __device__ __forceinline__ void done(const Unit&) const {}
};
struct MoeOrder {
    static constexpr bool GATHER = false;
    const char* A; const char* Bt; size_t tstep, estride;
    const volatile PG8_LAS unsigned* tp; int G, c;
    __device__ bool next(int i, Unit& u) const {
        const int L = i * G + c; if (L >= (int)tp[16] * 4) return false;
        const int pt = L >> 2; int e = 0;
#pragma unroll
        for (int j = 1; j < 16; ++j) e += (pt >= (int)tp[j]) ? 1 : 0;
        e = __builtin_amdgcn_readfirstlane(e);
        u.pm = pt; u.pn = L & 3; u.e = e; return true;
    }
    __device__ __forceinline__ const char* a_base(const Unit& u) const { return A + (size_t)u.pm * tstep; }
    __device__ __forceinline__ unsigned a_off(int, int, int, int) const { return 0u; }
    __device__ __forceinline__ const char* b_base(const Unit& u) const { return Bt + (size_t)u.e * estride + (size_t)u.pn * tstep; }
    __device__ __forceinline__ void a_ready(const Unit&) const {}
    __device__ __forceinline__ void done(const Unit&) const {}
};

struct MoeGatherOrder : MoeOrder {
    static constexpr bool GATHER = true;
    const volatile PG8_LAS unsigned* tok; unsigned rowbytes;
    __device__ __forceinline__ const char* a_base(const Unit&) const { return A; }
    __device__ __forceinline__ unsigned a_off(int ui, int hf, int R, int C) const { return tok[ui * 256 + hf * 128 + R] * rowbytes + (unsigned)C * 2u; }
};
__device__ __forceinline__ unsigned cvt_pk_bf16(float lo, float hi) { unsigned r; asm volatile("v_cvt_pk_bf16_f32 %0, %1, %2" : "=v"(r) : "v"(lo), "v"(hi)); return r; }
__device__ __forceinline__ void st16_wt(void* p, const u32x4 v) { asm volatile("global_store_dwordx4 %0, %1, off sc1\n\ts_nop 1" :: "v"(p), "v"(v) : "memory"); }
__device__ __forceinline__ u32x4 pack8(const f32x4 v0, const f32x4 v1) { u32x4 w; w.x = cvt_pk_bf16(v0[0], v0[1]); w.y = cvt_pk_bf16(v0[2], v0[3]); w.z = cvt_pk_bf16(v1[0], v1[1]); w.w = cvt_pk_bf16(v1[2], v1[3]); return w; }

struct EpiStore {
    static constexpr bool PERM = true, AFTER_DRAIN = false;
    bf16_t* O; int ldc;
    __device__ __forceinline__ void operator()(const f32x4 (&acc)[2][2][4][2], const Unit& u, int wr, int wc, int fr, int fq) const {
        const int row0 = u.pm * BM + wr * 64 + fr, col0 = u.pn * BM + wc * 32 + 8 * fq;
#pragma unroll
        for (int ai = 0; ai < 2; ++ai)
#pragma unroll
            for (int m = 0; m < 4; ++m) { bf16_t* rowp = O + (size_t)(row0 + ai * HALF + m * 16) * ldc + col0;
#pragma unroll
                for (int bj = 0; bj < 2; ++bj) st16_wt(rowp + bj * HALF, pack8(acc[ai][bj][m][0], acc[ai][bj][m][1])); }
    }
};
struct EpiQKV {
    static constexpr bool PERM = true, AFTER_DRAIN = false;
    bf16_t* O; const float* rot;
    __device__ __forceinline__ void operator()(const f32x4 (&acc)[2][2][4][2], const Unit& u, int wr, int wc, int fr, int fq) const {
        const int row0 = u.pm * BM + wr * 64 + fr, col0 = u.pn * BM + wc * 32 + 8 * fq;
        const bool rotw = (u.pn < 8) && ((wc & 1) == 0);
#pragma unroll
        for (int ai = 0; ai < 2; ++ai)
#pragma unroll
            for (int m = 0; m < 4; ++m) { const int row = row0 + ai * HALF + m * 16; bf16_t* rowp = O + (size_t)row * 3072 + col0;
                f32x4 cs[4];
                if (rotw) {
#pragma unroll
                    for (int q = 0; q < 4; ++q) cs[q] = *(const f32x4*)(rot + (size_t)row * 16 + q * 4); }
#pragma unroll
                for (int bj = 0; bj < 2; ++bj) { f32x4 v0 = acc[ai][bj][m][0], v1 = acc[ai][bj][m][1];
                    if (rotw) {
                        f32x4 p0, p1;
#pragma unroll
                        for (int j = 0; j < 4; ++j) { p0[j] = __shfl_xor(v0[j], 16); p1[j] = __shfl_xor(v1[j], 16); }
                        if (fq < 2) { const float sg = (fq == 0) ? -1.f : 1.f;
                            v0[0] = v0[0] * cs[0][0] + sg * p0[0] * cs[0][1]; v0[1] = v0[1] * cs[0][2] + sg * p0[1] * cs[0][3];
                            v0[2] = v0[2] * cs[1][0] + sg * p0[2] * cs[1][1]; v0[3] = v0[3] * cs[1][2] + sg * p0[3] * cs[1][3];
                            v1[0] = v1[0] * cs[2][0] + sg * p1[0] * cs[2][1]; v1[1] = v1[1] * cs[2][2] + sg * p1[1] * cs[2][3];
                            v1[2] = v1[2] * cs[3][0] + sg * p1[2] * cs[3][1]; v1[3] = v1[3] * cs[3][2] + sg * p1[3] * cs[3][3]; }
                    }
                    st16_wt(rowp + bj * HALF, pack8(v0, v1)); } }
    }
};
struct EpiX {
    static constexpr bool PERM = true, AFTER_DRAIN = false;
    const float* xsrc; float* xdst; const bf16_t* yw; const float* g1; const float* g2p;
    __device__ __forceinline__ void operator()(const f32x4 (&acc)[2][2][4][2], const Unit& u, int wr, int wc, int fr, int fq) const {
        const int row0 = u.pm * BM + wr * 64 + fr, col0 = u.pn * BM + wc * 32 + 8 * fq, b = u.pm >> 3;
        f32x4 ga[2][2], gb[2][2];
#pragma unroll
        for (int bj = 0; bj < 2; ++bj)
#pragma unroll
            for (int n = 0; n < 2; ++n) { ga[bj][n] = *(const f32x4*)(g1 + (size_t)b * 6144 + col0 + bj * HALF + 4 * n);
                gb[bj][n] = yw ? *(const f32x4*)(g2p + (size_t)b * 6144 + col0 + bj * HALF + 4 * n) : (f32x4){0.f, 0.f, 0.f, 0.f}; }
#pragma unroll
        for (int ai = 0; ai < 2; ++ai)
#pragma unroll
            for (int m = 0; m < 4; ++m) { const int row = row0 + ai * HALF + m * 16;
#pragma unroll
                for (int bj = 0; bj < 2; ++bj) { const size_t off = (size_t)row * 1024 + col0 + bj * HALF;
                    f32x4 v0 = *(const f32x4*)(xsrc + off) + ga[bj][0] * acc[ai][bj][m][0], v1 = *(const f32x4*)(xsrc + off + 4) + ga[bj][1] * acc[ai][bj][m][1];
                    if (yw) { const u32x4 y0 = *(const u32x4*)(yw + (size_t)(2 * row) * 1024 + col0 + bj * HALF), y1 = *(const u32x4*)(yw + (size_t)(2 * row + 1) * 1024 + col0 + bj * HALF);
                        f32x4 s0, s1;
                        s0[0] = __builtin_bit_cast(float, y0.x << 16) + __builtin_bit_cast(float, y1.x << 16); s0[1] = __builtin_bit_cast(float, y0.x & 0xffff0000u) + __builtin_bit_cast(float, y1.x & 0xffff0000u);
                        s0[2] = __builtin_bit_cast(float, y0.y << 16) + __builtin_bit_cast(float, y1.y << 16); s0[3] = __builtin_bit_cast(float, y0.y & 0xffff0000u) + __builtin_bit_cast(float, y1.y & 0xffff0000u);
                        s1[0] = __builtin_bit_cast(float, y0.z << 16) + __builtin_bit_cast(float, y1.z << 16); s1[1] = __builtin_bit_cast(float, y0.z & 0xffff0000u) + __builtin_bit_cast(float, y1.z & 0xffff0000u);
                        s1[2] = __builtin_bit_cast(float, y0.w << 16) + __builtin_bit_cast(float, y1.w << 16); s1[3] = __builtin_bit_cast(float, y0.w & 0xffff0000u) + __builtin_bit_cast(float, y1.w & 0xffff0000u);
                        v0 = v0 + gb[bj][0] * s0; v1 = v1 + gb[bj][1] * s1; }
                    *(f32x4*)(xdst + off) = v0; *(f32x4*)(xdst + off + 4) = v1; } }
    }
};
struct EpiGU {
    static constexpr bool PERM = true, AFTER_DRAIN = false;
    bf16_t* O;
    __device__ __forceinline__ void operator()(const f32x4 (&acc)[2][2][4][2], const Unit& u, int wr, int wc, int fr, int fq) const {
        const int row0 = u.pm * BM + wr * 64 + fr, col0 = u.pn * 128 + wc * 32 + 8 * fq;
#pragma unroll
        for (int ai = 0; ai < 2; ++ai)
#pragma unroll
            for (int m = 0; m < 4; ++m) { bf16_t* rowp = O + (size_t)(row0 + ai * HALF + m * 16) * 512 + col0;
                f32x4 o[2];
#pragma unroll
                for (int n = 0; n < 2; ++n)
#pragma unroll
                    for (int j = 0; j < 4; ++j) { const float g = acc[ai][0][m][n][j], up = acc[ai][1][m][n][j]; o[n][j] = g / (1.f + __expf(-g)) * up; }
                st16_wt(rowp, pack8(o[0], o[1])); }
    }
};
struct EpiDN {
    static constexpr bool PERM = true, AFTER_DRAIN = false;
    bf16_t* O; const int* sloti; const float* slotw;
    __device__ __forceinline__ void operator()(const f32x4 (&acc)[2][2][4][2], const Unit& u, int wr, int wc, int fr, int fq) const {
        const int row0 = u.pm * BM + wr * 64 + fr, col0 = u.pn * BM + wc * 32 + 8 * fq;
#pragma unroll
        for (int ai = 0; ai < 2; ++ai)
#pragma unroll
            for (int m = 0; m < 4; ++m) { const int row = row0 + ai * HALF + m * 16; const int info = sloti[row]; const float w = slotw[row];
                if (info >= 0) { bf16_t* rowp = O + (size_t)info * 1024 + col0;
#pragma unroll
                    for (int bj = 0; bj < 2; ++bj) st16_wt(rowp + bj * HALF, pack8(acc[ai][bj][m][0] * w, acc[ai][bj][m][1] * w)); } }
    }
};

template <class Epi, class Sched, bool ALIGN_EPI = false, bool SP2 = false>
__device__ __forceinline__ void gemm_phase(PG8_LAS unsigned char* lds, const int K, const Sched& S, const Epi& E, const int tid) {
    const int wid = __builtin_amdgcn_readfirstlane(tid >> 6), lane = tid & 63, wr = wid >> 2, wc = wid & 3, fr = lane & 15, fq = lane >> 4;
    static_assert(SP2 || !Sched::GATHER, "gathered A rows are wired into the SP2 loop only");
    const int nt = K / BK;
    unsigned voffA[2], voffB[2];
#pragma unroll
    for (int i = 0; i < 2; ++i) { int R, C; stage_rc(tid * 16 + i * 8192, R, C); const int Rb = Epi::PERM ? ((R & ~31) + perm32(R & 31)) : R;
        voffA[i] = (unsigned)(R * K + C) * 2u; voffB[i] = (unsigned)(Rb * K + C) * 2u; }
    unsigned cv[2][2], nv[2][2]; int rA[2], cAc[2];
#pragma unroll
    for (int i = 0; i < 2; ++i) { int R, C; stage_rc(tid * 16 + i * 8192, R, C); rA[i] = R; cAc[i] = C; }
#pragma unroll
    for (int hf = 0; hf < 2; ++hf)
#pragma unroll
        for (int i = 0; i < 2; ++i) { cv[hf][i] = 0u; nv[hf][i] = 0u; }
    const size_t kstep = (size_t)(BK * 2);
    const size_t hstep = (size_t)HALF * K * 2;
    const unsigned ldsw = (unsigned)wid * 1024u;
    const int aoff = lds_byte(wr * 64 + fr, fq * 8), boff = lds_byte(wc * 32 + fr, fq * 8);
#define PG8_SA(b, h) (((b) * 2 + (h)) * HTB)
#define PG8_SB(b, h) ((4 + (b) * 2 + (h)) * HTB)
#define PG8_STAGE(bufoff, gbase, voff) do { _Pragma("unroll") for (int _i = 0; _i < 2; ++_i) \
        __builtin_amdgcn_global_load_lds((const unsigned*)((const char*)(gbase) + (voff)[_i]), (PG8_LAS unsigned*)(lds + (bufoff) + ldsw + _i * 8192), 16, 0, 0); } while (0)
#define PG8_STAGE_A(bufoff, aptr, hf, usenext) do { if constexpr (Sched::GATHER) { _Pragma("unroll") for (int _i = 0; _i < 2; ++_i) \
        __builtin_amdgcn_global_load_lds((const unsigned*)((const char*)(aptr) + ((usenext) ? nv[hf][_i] : cv[hf][_i])), (PG8_LAS unsigned*)(lds + (bufoff) + ldsw + _i * 8192), 16, 0, 0); } \
        else { PG8_STAGE(bufoff, (aptr) + (hf) * hstep, voffA); } } while (0)
#define PG8_LDA(dst, b, h) do { _Pragma("unroll") for (int m = 0; m < 4; ++m) _Pragma("unroll") for (int k = 0; k < 2; ++k) dst[m][k] = *(const PG8_LAS bf16x8*)(lds + PG8_SA(b, h) + aoff + m * 2048 + k * 1024); } while (0)
#define PG8_LDB(dst, b, h) do { _Pragma("unroll") for (int n = 0; n < 2; ++n) _Pragma("unroll") for (int k = 0; k < 2; ++k) dst[n][k] = *(const PG8_LAS bf16x8*)(lds + PG8_SB(b, h) + boff + n * 2048 + k * 1024); } while (0)
#define PG8_MMA(ai, bj, At, Bt) do { __builtin_amdgcn_s_setprio(1); _Pragma("unroll") for (int m = 0; m < 4; ++m) _Pragma("unroll") for (int n = 0; n < 2; ++n) _Pragma("unroll") for (int k = 0; k < 2; ++k) \
        acc[ai][bj][m][n] = __builtin_amdgcn_mfma_f32_16x16x32_bf16(Bt[n][k], At[m][k], acc[ai][bj][m][n], 0, 0, 0); __builtin_amdgcn_s_setprio(0); } while (0)
#define PG8_WAIT_V(n) asm volatile("s_waitcnt vmcnt(" #n ")" ::: "memory")
#define PG8_WAIT_L(n) asm volatile("s_waitcnt lgkmcnt(" #n ")" ::: "memory")
#define PG8_BAR __builtin_amdgcn_s_barrier()
#define PG8_SCHED __builtin_amdgcn_sched_barrier(0)
    Unit cur, nxt; int ui = 0;
    if (!S.next(0, cur)) return;
    f32x4 acc[2][2][4][2];
#pragma unroll
    for (int a = 0; a < 2; ++a)
#pragma unroll
        for (int b = 0; b < 2; ++b)
#pragma unroll
            for (int m = 0; m < 4; ++m)
#pragma unroll
                for (int n = 0; n < 2; ++n) acc[a][b][m][n] = (f32x4){0.f, 0.f, 0.f, 0.f};
    bf16x8 At[4][2], B0[2][2], B1[2][2];
    const char* cA = S.a_base(cur); const char* cB = S.b_base(cur);
    S.a_ready(cur);
    if constexpr (Sched::GATHER) {
#pragma unroll
        for (int hf = 0; hf < 2; ++hf)
#pragma unroll
            for (int i = 0; i < 2; ++i) cv[hf][i] = S.a_off(0, hf, rA[i], cAc[i]); }
    if constexpr (SP2) {
        PG8_STAGE(PG8_SB(0, 0), cB, voffB); PG8_STAGE(PG8_SB(0, 1), cB + hstep, voffB); PG8_STAGE_A(PG8_SA(0, 0), cA, 0, false); PG8_STAGE_A(PG8_SA(0, 1), cA, 1, false);
        if (wr == 1) PG8_BAR;
        PG8_WAIT_V(2); PG8_BAR;
        PG8_STAGE(PG8_SB(1, 0), cB + kstep, voffB); PG8_STAGE_A(PG8_SA(1, 0), cA + kstep, 0, false); PG8_STAGE(PG8_SB(1, 1), cB + hstep + kstep, voffB);
        PG8_WAIT_V(6); PG8_BAR;
    } else {
        PG8_STAGE(PG8_SB(0, 0), cB, voffB); PG8_STAGE(PG8_SA(0, 0), cA, voffA); PG8_STAGE(PG8_SB(0, 1), cB + hstep, voffB); PG8_STAGE(PG8_SA(0, 1), cA + hstep, voffA);
        if (wr == 1) PG8_BAR;
        PG8_WAIT_V(4); PG8_BAR;
        PG8_STAGE(PG8_SB(1, 0), cB + kstep, voffB); PG8_STAGE(PG8_SA(1, 0), cA + kstep, voffA); PG8_STAGE(PG8_SB(1, 1), cB + hstep + kstep, voffB);
        PG8_WAIT_V(6); PG8_BAR;
    }
    for (;;) {
        const bool has_next = S.next(ui + 1, nxt);
        if constexpr (Sched::GATHER) { if (has_next) {
#pragma unroll
            for (int hf = 0; hf < 2; ++hf)
#pragma unroll
                for (int i = 0; i < 2; ++i) nv[hf][i] = S.a_off(ui + 1, hf, rA[i], cAc[i]); } }
        const char* nA = has_next ? S.a_base(nxt) : cA; const char* nB = has_next ? S.b_base(nxt) : cB;
        for (int t = 0; t < nt; t += 2) {
            const bool last = (t == nt - 2);
            const char* a1 = cA + (size_t)(t + 1) * kstep;
            const char* a2 = last ? nA : cA + (size_t)(t + 2) * kstep; const char* b2 = last ? nB : cB + (size_t)(t + 2) * kstep;
            const char* a3 = a2 + kstep; const char* b3 = b2 + kstep;
            if (last && has_next) S.a_ready(nxt);
            const bool usen = last && has_next;
            if constexpr (SP2) {
            PG8_LDB(B0, 0, 0); PG8_LDB(B1, 0, 1); PG8_SCHED; PG8_LDA(At, 0, 0); PG8_STAGE_A(PG8_SA(1, 1), a1, 1, false);
            PG8_WAIT_V(8); PG8_WAIT_L(0); PG8_BAR; PG8_MMA(0, 0, At, B0); PG8_MMA(0, 1, At, B1); PG8_BAR; PG8_SCHED;
            PG8_LDA(At, 0, 1); PG8_STAGE(PG8_SB(0, 0), b2, voffB); PG8_STAGE(PG8_SB(0, 1), b2 + hstep, voffB); PG8_STAGE_A(PG8_SA(0, 0), a2, 0, usen);
            PG8_WAIT_V(8); PG8_WAIT_L(0); PG8_BAR; PG8_MMA(1, 0, At, B0); PG8_MMA(1, 1, At, B1); PG8_BAR; PG8_SCHED;
            PG8_LDB(B0, 1, 0); PG8_LDB(B1, 1, 1); PG8_SCHED; PG8_LDA(At, 1, 0); PG8_STAGE_A(PG8_SA(0, 1), a2, 1, usen);
            PG8_WAIT_V(8); PG8_WAIT_L(0); PG8_BAR; PG8_MMA(0, 0, At, B0); PG8_MMA(0, 1, At, B1); PG8_BAR; PG8_SCHED;
            PG8_LDA(At, 1, 1); PG8_STAGE(PG8_SB(1, 0), b3, voffB); PG8_STAGE(PG8_SB(1, 1), b3 + hstep, voffB); PG8_STAGE_A(PG8_SA(1, 0), a3, 0, usen);
            PG8_WAIT_V(8); PG8_WAIT_L(0); PG8_BAR; PG8_MMA(1, 0, At, B0); PG8_MMA(1, 1, At, B1); PG8_BAR; PG8_SCHED;
            } else {
            PG8_LDB(B0, 0, 0); PG8_SCHED; PG8_LDA(At, 0, 0); PG8_STAGE(PG8_SA(1, 1), a1 + hstep, voffA);
            PG8_WAIT_L(8); PG8_BAR; PG8_WAIT_L(0); PG8_MMA(0, 0, At, B0); PG8_BAR; PG8_SCHED;
            PG8_LDB(B1, 0, 1); PG8_STAGE(PG8_SB(0, 0), b2, voffB);
            PG8_BAR; PG8_WAIT_L(0); PG8_MMA(0, 1, At, B1); PG8_BAR;
            PG8_LDA(At, 0, 1); PG8_STAGE(PG8_SA(0, 0), a2, voffA);
            PG8_BAR; PG8_WAIT_L(0); PG8_MMA(1, 0, At, B0); PG8_BAR; PG8_SCHED;
            PG8_STAGE(PG8_SB(0, 1), b2 + hstep, voffB);
            PG8_WAIT_V(6); PG8_BAR; PG8_MMA(1, 1, At, B1); PG8_BAR;
            PG8_LDB(B0, 1, 0); PG8_SCHED; PG8_LDA(At, 1, 0); PG8_STAGE(PG8_SA(0, 1), a2 + hstep, voffA);
            PG8_WAIT_L(8); PG8_BAR; PG8_WAIT_L(0); PG8_MMA(0, 0, At, B0); PG8_BAR; PG8_SCHED;
            PG8_LDB(B1, 1, 1); PG8_STAGE(PG8_SB(1, 0), b3, voffB);
            PG8_BAR; PG8_WAIT_L(0); PG8_MMA(0, 1, At, B1); PG8_BAR;
            PG8_LDA(At, 1, 1); PG8_STAGE(PG8_SA(1, 0), a3, voffA);
            PG8_BAR; PG8_WAIT_L(0); PG8_MMA(1, 0, At, B0); PG8_BAR; PG8_SCHED;
            PG8_STAGE(PG8_SB(1, 1), b3 + hstep, voffB);
            PG8_WAIT_V(6); PG8_BAR; PG8_MMA(1, 1, At, B1); PG8_BAR;
            }
        }
        if constexpr (ALIGN_EPI) { if (wr == 0) PG8_BAR; }
        if constexpr (!Epi::AFTER_DRAIN) { E(acc, cur, wr, wc, fr, fq); S.done(cur); }
        if (!has_next) break;
#pragma unroll
        for (int a = 0; a < 2; ++a)
#pragma unroll
            for (int b = 0; b < 2; ++b)
#pragma unroll
                for (int m = 0; m < 4; ++m)
#pragma unroll
                    for (int n = 0; n < 2; ++n) acc[a][b][m][n] = (f32x4){0.f, 0.f, 0.f, 0.f};
        cur = nxt; cA = nA; cB = nB; ++ui;
        if constexpr (Sched::GATHER) {
#pragma unroll
            for (int hf = 0; hf < 2; ++hf)
#pragma unroll
                for (int i = 0; i < 2; ++i) cv[hf][i] = nv[hf][i]; }
        if constexpr (ALIGN_EPI) { if (wr == 1) PG8_BAR; }
    }
    PG8_WAIT_V(0);
    if constexpr (!ALIGN_EPI) { if (wr == 0) PG8_BAR; }
    PG8_BAR;
    if constexpr (Epi::AFTER_DRAIN) { E.fused(acc, cur, wr, wc, fr, fq, lds, wid, lane); S.done(cur); }
#undef PG8_SA
#undef PG8_SB
#undef PG8_STAGE
#undef PG8_LDA
#undef PG8_STAGE_A
#undef PG8_LDB
#undef PG8_MMA
#undef PG8_WAIT_V
#undef PG8_WAIT_L
#undef PG8_BAR
#undef PG8_SCHED
}
}

constexpr int NB = 8, SEQ = 2048, T = NB * SEQ, D = 1024, DEPTH = 4;
constexpr int IN_AB = 2560, NQKV = 3072, NE = 16, FF = 512;
constexpr int MAXTILES = 144, MPAD = MAXTILES * 256;
constexpr int NWAVES = 8, NTHR = 512;

constexpr size_t MiB = 1u << 20;
constexpr size_t WS_CTL = 0, CTL_ZERO_BYTES = 1 * MiB;
constexpr int CW_TMO = 0, CW_BAR = 64, CW_CNT = 8192;
constexpr size_t WS_MOD = 1 * MiB;
constexpr size_t WS_ROT = 2 * MiB;
constexpr size_t WS_AGG = 3 * MiB;
constexpr size_t WS_LIST = 5 * MiB;
constexpr size_t WS_TOPW = 6 * MiB;
constexpr size_t WS_SLOTI = 6 * MiB + 512 * 1024;
constexpr size_t WS_SLOTW = 7 * MiB;
constexpr size_t WS_LRUW = 7 * MiB + 512 * 1024;
constexpr size_t WS_WIN = 8 * MiB;
constexpr size_t WS_WOUT = 18 * MiB;
constexpr size_t WS_WQKV = 22 * MiB;
constexpr size_t WS_WO = 34 * MiB;
constexpr size_t WS_WGU = 38 * MiB;
constexpr size_t WS_WDN = 166 * MiB;
constexpr size_t WS_X = 230 * MiB;
constexpr size_t WS_HB = 294 * MiB;
constexpr size_t WS_R1 = 326 * MiB;
constexpr size_t R1_Z = 0;
constexpr size_t R1_DELTA = 0;
constexpr size_t R1_XS = 0;
constexpr size_t R1_ACT = 72 * MiB;
constexpr size_t R1_YW = 108 * MiB;
constexpr size_t R1_AGG = 96 * MiB, R1_CARRY = 100 * MiB;
constexpr size_t WS_MCST = 6 * MiB + 256 * 1024;
constexpr size_t WS_RWT = 6 * MiB + 320 * 1024;
constexpr size_t WS_END = 526 * MiB;

constexpr int RING_BYTES = 131072;
constexpr int MISC_OFF = 150528;
constexpr int ENT_OFF = RING_BYTES;
constexpr int LDS_BYTES = 147456 + 4096;

#define GAS __attribute__((address_space(1)))
#define LAS __attribute__((address_space(3)))
typedef unsigned short bf16;
typedef unsigned v4u __attribute__((ext_vector_type(4)));
typedef unsigned v2u __attribute__((ext_vector_type(2)));
typedef float f32x4 __attribute__((ext_vector_type(4)));
typedef float f32x2 __attribute__((ext_vector_type(2)));
#define RLX_AGENT __ATOMIC_RELAXED, __HIP_MEMORY_SCOPE_AGENT
#define LDS_WAIT() asm volatile("s_waitcnt lgkmcnt(0)" ::: "memory")
#define VM_WAIT() asm volatile("s_waitcnt vmcnt(0)" ::: "memory")
__device__ __forceinline__ unsigned f2bf(float f) { unsigned u = __builtin_bit_cast(unsigned, f); return (u + 0x7fffu + ((u >> 16) & 1u)) >> 16; }
__device__ __forceinline__ unsigned pk2(float lo, float hi) { return f2bf(lo) | (f2bf(hi) << 16); }
__device__ __forceinline__ float bf2f(unsigned short b) { return __builtin_bit_cast(float, (unsigned)b << 16); }
__device__ __forceinline__ float bflo(unsigned w) { return __builtin_bit_cast(float, w << 16); }
__device__ __forceinline__ float bfhi(unsigned w) { return __builtin_bit_cast(float, w & 0xffff0000u); }

#define XB_TMO      128
#define XB_XCNT(j)  (256  + 64 * (j))
#define XB_XSUB(j)  (1280 + 64 * (j))
#define XB_XGEN(j)  (2304 + 64 * (j))
#define XB_TOP      3328
#define XB_TOPGEN   3392
#define XCD_BAR_WORDS 3456
#define XB_SPIN_CAP (1u << 18)

__device__ __forceinline__ unsigned xb_ld(unsigned* p)              { return __hip_atomic_load(p, __ATOMIC_RELAXED, __HIP_MEMORY_SCOPE_AGENT); }
__device__ __forceinline__ unsigned xb_add(unsigned* p, unsigned v) { return __hip_atomic_fetch_add(p, v, __ATOMIC_RELAXED, __HIP_MEMORY_SCOPE_AGENT); }
__device__ __forceinline__ unsigned xb_xcc_id() { return (unsigned)__builtin_amdgcn_s_getreg((3 << 11) | 20) & 0xFu; }
#define XB_SPIN(cond, bar) do { unsigned _sp = 0; while (cond) { __builtin_amdgcn_s_sleep(1); \
    if ((++_sp & 255u) == 0u) { if (xb_ld(&(bar)[XB_TMO])) break; if (_sp > XB_SPIN_CAP) { atomicAdd(&(bar)[XB_TMO], 1u); break; } } } } while (0)

struct XcdBarrier {
    unsigned* bar; unsigned x;
    volatile LAS unsigned* st;
};

__device__ __forceinline__ XcdBarrier xcd_barrier_post(unsigned* bar, volatile LAS unsigned* st) {
    XcdBarrier b; b.bar = bar; b.x = xb_xcc_id(); b.st = st;
    if (threadIdx.x == 0) (void)xb_add(&bar[XB_XCNT(b.x)], 1u);
    return b;
}
__device__ __forceinline__ void xcd_barrier_complete(unsigned* bar, unsigned x, unsigned& nloc, unsigned& nx) {
    const unsigned G = gridDim.x * gridDim.y * gridDim.z;
    unsigned sum, cnt, mine, sp = 0u;
    for (;;) {
        sum = 0u; cnt = 0u; mine = 0u;
#pragma unroll
        for (unsigned j = 0; j < 16; ++j) { const unsigned c = xb_ld(&bar[XB_XCNT(j)]); sum += c; cnt += (c > 0u) ? 1u : 0u; mine = (j == x) ? c : mine; }
        if (sum == G) break;
        __builtin_amdgcn_s_sleep(1);
        if ((++sp & 255u) == 0u) { if (xb_ld(&bar[XB_TMO])) break; if (sp > XB_SPIN_CAP) { atomicAdd(&bar[XB_TMO], 1u); break; } }
    }
    nloc = mine > 0u ? mine : 1u; nx = cnt > 0u ? cnt : 1u;
}

__device__ __forceinline__ void xcd_barrier(const XcdBarrier& b) {
    asm volatile("s_waitcnt vmcnt(0)" ::: "memory");
    __syncthreads();
    if (threadIdx.x == 0) {
        unsigned* bar = b.bar;
        __builtin_amdgcn_s_waitcnt(0);
        unsigned nloc = b.st[0], nx = b.st[1];
        if (nloc == 0u) { xcd_barrier_complete(bar, b.x, nloc, nx); b.st[0] = nloc; b.st[1] = nx; }
        const unsigned old = xb_add(&bar[XB_XSUB(b.x)], 1u);
        const unsigned gen = old / nloc;
        if (old + 1u == (gen + 1u) * nloc) {
            __builtin_amdgcn_fence(__ATOMIC_RELEASE, "agent");
            asm volatile("s_waitcnt vmcnt(0)" ::: "memory");
            const unsigned og = xb_add(&bar[XB_TOP], 1u);
            const unsigned tg = og / nx;
            if (og + 1u == (tg + 1u) * nx) xb_add(&bar[XB_TOPGEN], 1u);
            else XB_SPIN(xb_ld(&bar[XB_TOPGEN]) == tg, bar);
            __builtin_amdgcn_fence(__ATOMIC_ACQUIRE, "agent");
            xb_add(&bar[XB_XGEN(b.x)], 1u);
            asm volatile("s_waitcnt vmcnt(0)" ::: "memory");
        } else {
            XB_SPIN(xb_ld(&bar[XB_XGEN(b.x)]) == gen, bar);
            __builtin_amdgcn_fence(__ATOMIC_ACQUIRE, "agent");
            asm volatile("s_waitcnt vmcnt(0)" ::: "memory");
        }
    }
    __syncthreads();
}


__device__ __forceinline__ float wave_sum(float v) {
#pragma unroll
    for (int o = 1; o < 64; o <<= 1) v += __shfl_xor(v, o);
    return v;
}
template <int PAT> __device__ __forceinline__ float swz_f(float v) { return __builtin_bit_cast(float, __builtin_amdgcn_ds_swizzle(__builtin_bit_cast(int, v), PAT)); }
__device__ __forceinline__ float wave_max(float v) {
#pragma unroll
    for (int o = 1; o < 64; o <<= 1) v = fmaxf(v, __shfl_xor(v, o));
    return v;
}
typedef __bf16 bf16x2_t __attribute__((ext_vector_type(2)));
__device__ __forceinline__ unsigned cvtpk(float lo, float hi) { f32x2 v = {lo, hi}; bf16x2_t b = __builtin_convertvector(v, bf16x2_t); return __builtin_bit_cast(unsigned, b); }
__device__ __forceinline__ float sigmoidf_(float x) { return 1.f / (1.f + expf(-x)); }
__device__ __forceinline__ float gelu_tanh(float x) { const float u = 0.7978845608028654f * (x + 0.044715f * x * x * x); return 0.5f * x * (1.f + tanhf(u)); }
__device__ __forceinline__ void sincos_acc(float ang, float& c, float& s) {
    const double x = (double)ang, q = rint(x * 0.63661977236758134), r = x - q * 1.5707963267948966;
    const int qi = ((int)q) & 3; const float rf = (float)r, r2 = rf * rf;
    const float sp = rf * (1.f + r2 * (-1.6666667e-1f + r2 * (8.3333333e-3f + r2 * (-1.9841270e-4f + r2 * 2.7557319e-6f))));
    const float cp = 1.f + r2 * (-0.5f + r2 * (4.1666667e-2f + r2 * (-1.3888889e-3f + r2 * (2.4801587e-5f - r2 * 2.7557319e-7f))));
    c = (qi == 0) ? cp : (qi == 1) ? -sp : (qi == 2) ? -cp : sp;
    s = (qi == 0) ? sp : (qi == 1) ? cp : (qi == 2) ? -sp : -cp;
}

#define AS4 __attribute__((address_space(4)))
typedef const void* cvp_t;
struct Ctx {
    LAS unsigned char* lds; volatile LAS unsigned* MISC; LAS unsigned char* lds0;
    unsigned* ctl; unsigned char* ws;
    int tid, lane, wave, G, blk, lo, hi;
    const AS4 cvp_t* in;
};

__device__ __forceinline__ bool launder(Ctx& F) { int t = threadIdx.x; asm volatile("" : "+v"(t)); F.tid = t; F.lane = t & 63; F.wave = __builtin_amdgcn_readfirstlane(t >> 6);
    int z = 0; asm volatile("" : "+s"(z));
    const AS4 char* ka = (const AS4 char*)__builtin_amdgcn_kernarg_segment_ptr() + z;
    F.in = (const AS4 cvp_t*)ka; F.ws = *(unsigned char* const AS4*)(ka + 25 * 8 + 8); F.ctl = (unsigned*)(F.ws + WS_CTL);
    F.lds = F.lds0 + z; F.MISC = (volatile LAS unsigned*)(F.lds + MISC_OFF);
    F.G = (int)gridDim.x + z; F.blk = (int)blockIdx.x + z; F.lo = *(const AS4 int*)(ka + 25 * 8 + 16); F.hi = *(const AS4 int*)(ka + 25 * 8 + 20); return true; }

__device__ __forceinline__ void p0_transpose_item(const float* W, int K, int N, bf16* WT, int dstrow0, LAS float* scr, int k0, int n0, int lane) {
    f32x4 ld[8];
#pragma unroll
    for (int i = 0; i < 8; ++i) ld[i] = *(const f32x4*)(W + (size_t)(k0 + (lane >> 3) + 8 * i) * N + n0 + 4 * (lane & 7));
#pragma unroll
    for (int i = 0; i < 8; ++i) { LAS float* s = scr + ((lane >> 3) + 8 * i) * 33 + 4 * (lane & 7); s[0] = ld[i][0]; s[1] = ld[i][1]; s[2] = ld[i][2]; s[3] = ld[i][3]; }
    LDS_WAIT(); asm volatile("" ::: "memory");
    const int c = lane & 7;
#pragma unroll
    for (int j = 0; j < 4; ++j) { const int n = (lane >> 3) + 8 * j; const LAS float* s = scr + (8 * c) * 33 + n;
        v4u o; o.x = pk2(s[0 * 33], s[1 * 33]); o.y = pk2(s[2 * 33], s[3 * 33]); o.z = pk2(s[4 * 33], s[5 * 33]); o.w = pk2(s[6 * 33], s[7 * 33]);
        *(GAS v4u*)(WT + (size_t)(dstrow0 + n) * K + k0 + 8 * c) = o; }
    LDS_WAIT(); asm volatile("" ::: "memory");
}
__device__ __forceinline__ void convert_dense_items(const Ctx& F, int wrank, int nwaves) {
    LAS float* scr = (LAS float*)(F.lds + F.wave * 16384);
    constexpr int I_IN = 2 * 16 * 80, I_OUT = 2 * 16 * 32, I_QKV = 2 * 16 * 96, I_O = 2 * 16 * 32, NITEMS = I_IN + I_OUT + I_QKV + I_O;
    for (int it = wrank; it < NITEMS; it += nwaves) {
        int r = it;
        if (r < I_IN) { const int mt = r / 1280, q = r % 1280, kb = q / 80, nb = q % 80;
            p0_transpose_item((const float*)F.in[8] + (size_t)mt * 1024 * 2560, 1024, 2560, (bf16*)(F.ws + WS_WIN) + (size_t)mt * 2560 * 1024, nb * 32, scr, kb * 64, nb * 32, F.lane); continue; } r -= I_IN;
        if (r < I_OUT) { const int mt = r / 512, q = r % 512, kb = q / 32, nb = q % 32;
            p0_transpose_item((const float*)F.in[17] + (size_t)mt * 1024 * 1024, 1024, 1024, (bf16*)(F.ws + WS_WOUT) + (size_t)mt * 1024 * 1024, nb * 32, scr, kb * 64, nb * 32, F.lane); continue; } r -= I_OUT;
        if (r < I_QKV) { const int mt = r / 1536, q = r % 1536, kb = q / 96, nb = q % 96;
            p0_transpose_item((const float*)F.in[18] + (size_t)mt * 1024 * 3072, 1024, 3072, (bf16*)(F.ws + WS_WQKV) + (size_t)mt * 3072 * 1024, nb * 32, scr, kb * 64, nb * 32, F.lane); continue; } r -= I_QKV;
        { const int mt = r / 512, q = r % 512, kb = q / 32, nb = q % 32;
            p0_transpose_item((const float*)F.in[19] + (size_t)mt * 1024 * 1024, 1024, 1024, (bf16*)(F.ws + WS_WO) + (size_t)mt * 1024 * 1024, nb * 32, scr, kb * 64, nb * 32, F.lane); }
    }
}
__device__ __forceinline__ void convert_expert_items(const Ctx& F, int layer, int wrank, int nwaves, int it_lo = 0, int it_hi = 3 * 16 * 256) {
    LAS float* scr = (LAS float*)(F.lds + F.wave * 16384);
    constexpr int I_G = 16 * 256;
    for (int it = it_lo + wrank; it < it_hi; it += nwaves) {
        int r = it;
        if (r < 2 * I_G) { const int up = (r >= I_G) ? 1 : 0; r -= up * I_G; const int mt = layer * 16 + r / 256, q = r % 256, kb = q / 16, nb = q % 16, n0 = nb * 32;
            p0_transpose_item((const float*)F.in[22 + up] + (size_t)mt * 1024 * 512, 1024, 512, (bf16*)(F.ws + WS_WGU) + (size_t)mt * 1024 * 1024, (n0 >> 7) * 256 + (n0 & 127) + up * 128, scr, kb * 64, n0, F.lane); continue; } r -= 2 * I_G;
        { const int mt = layer * 16 + r / 256, q = r % 256, kb = q / 32, nb = q % 32;
            p0_transpose_item((const float*)F.in[24] + (size_t)mt * 512 * 1024, 512, 1024, (bf16*)(F.ws + WS_WDN) + (size_t)mt * 1024 * 512, nb * 32, scr, kb * 64, nb * 32, F.lane); }
    }
}
__device__ __forceinline__ void p0_prologue(const Ctx& F) {
    const float* c_in = (const float*)F.in[1]; const int* pos_in = (const int*)F.in[2];
    const float* mod_w = (const float*)F.in[3]; const float* mod_b = (const float*)F.in[4];
    {
        __syncthreads();
        LAS float* cs_s = (LAS float*)F.lds;
        LAS float* red = (LAS float*)(F.lds + 32768);
        for (int i = F.tid; i < 8192; i += NTHR) { const int b = i >> 10, k = i & 1023; const float v = c_in[i]; cs_s[k * 8 + b] = v / (1.f + expf(-v)); }
        __syncthreads();
        float* MOD = (float*)(F.ws + WS_MOD);
        const int kq = F.tid >> 6, col = F.tid & 63;
        for (int it = F.blk; it < 4 * 96; it += F.G) {
            const int l = it / 96, nb = it % 96;
            float acc[8];
#pragma unroll
            for (int b = 0; b < 8; ++b) acc[b] = 0.f;
            const float* wp = mod_w + ((size_t)l * 1024 + kq * 128) * 6144 + nb * 64 + col;
#pragma unroll 16
            for (int k = 0; k < 128; ++k) { const float w = wp[(size_t)k * 6144];
                const f32x4 c0 = *(const LAS f32x4*)(cs_s + (kq * 128 + k) * 8), c1 = *(const LAS f32x4*)(cs_s + (kq * 128 + k) * 8 + 4);
                acc[0] += c0[0] * w; acc[1] += c0[1] * w; acc[2] += c0[2] * w; acc[3] += c0[3] * w; acc[4] += c1[0] * w; acc[5] += c1[1] * w; acc[6] += c1[2] * w; acc[7] += c1[3] * w; }
#pragma unroll
            for (int b = 0; b < 8; ++b) red[(kq * 8 + b) * 64 + col] = acc[b];
            __syncthreads();
            { const int b = F.tid >> 6; float s = mod_b[l * 6144 + nb * 64 + col];
#pragma unroll
              for (int q = 0; q < 8; ++q) s += red[(q * 8 + b) * 64 + col];
              MOD[((size_t)l * 8 + b) * 6144 + nb * 64 + col] = s; }
            __syncthreads();
        }
    }
    {
        float* ROT = (float*)(F.ws + WS_ROT);
        for (int idx = F.blk * NTHR + F.tid; idx < T * 8; idx += F.G * NTHR) { const int row = idx >> 3, i = idx & 7;
            const float invf = exp2f(-(float)i * (18.931568569324174f / 8.0f));
            const float ang = (float)pos_in[row] * invf; float c, s; sincos_acc(ang, c, s);
            *(f32x2*)(ROT + (size_t)idx * 2) = (f32x2){c, s}; }
    }
    {
        bf16* WG = (bf16*)(F.ws + WS_LRUW);
        for (int idx = F.blk * NTHR + F.tid; idx < 2 * 2 * 2 * 8 * 4096; idx += F.G * NTHR) { const int jj = idx & 7, hq = (idx >> 3) & 1, s = (idx >> 4) & 3, out = (idx >> 6) & 63, hd = (idx >> 12) & 7, dr = (idx >> 15) & 1, ty = (idx >> 16) & 1, jl = idx >> 17;
            const int in_ = 16 * s + 8 * (jj >> 2) + 4 * hq + (jj & 3);
            const float* src = (const float*)F.in[ty ? 14 : 12]; WG[idx] = (bf16)f2bf(src[((size_t)((jl * 2 + dr) * 8 + hd) * 64 + in_) * 64 + out]); }
        float* MC = (float*)(F.ws + WS_MCST);
        for (int idx = F.blk * NTHR + F.tid; idx < 2 * 2 * 3 * 512; idx += F.G * NTHR) { const int cc = idx & 511, k = (idx >> 9) % 3, jd = idx / 1536;
            const float* src = (const float*)F.in[k == 0 ? 13 : (k == 1 ? 15 : 16)]; float v = src[jd * 512 + cc]; if (k == 2) v = log1pf(expf(-v)); MC[idx] = v; }
    }
    {
        float* RWT = (float*)(F.ws + WS_RWT); const float* rw = (const float*)F.in[20];
        for (int idx = F.blk * NTHR + F.tid; idx < 16384; idx += F.G * NTHR) RWT[idx] = rw[(idx & 1023) * 16 + (idx >> 10)];
    }
    {
        const int gw = F.blk * NWAVES + F.wave, NGW = F.G * NWAVES;
        convert_dense_items(F, gw, NGW);
        convert_expert_items(F, 0, gw, NGW);
    }
}

template <int NDELTA, bool ROUTE, bool FINAL, bool WRITEX = true>
__device__ __forceinline__ void norm_phase(const Ctx& F, const float* xin, float* xout, const bf16* delta, const float* gate, const float* gvec, const float* shift, const float* scale,
                                           bf16* hout, float* fout, unsigned* gcnt) {
    LAS float* rw_s = (LAS float*)F.lds;
    volatile LAS unsigned* lcnt = F.MISC + 40; volatile LAS unsigned* lbase = F.MISC + 56; volatile LAS unsigned* nent = F.MISC + 72;
    LAS unsigned* ent = (LAS unsigned*)(F.lds + ENT_OFF);
    if (ROUTE) {
        const f32x4* rwt = (const f32x4*)(F.ws + WS_RWT);
        for (int i = F.tid; i < 4096; i += NTHR) *(LAS f32x4*)(rw_s + 4 * i) = rwt[i];
        if (F.tid < 16) lcnt[F.tid] = 0u; if (F.tid == 16) nent[0] = 0u;
        __syncthreads();
    }
    const float* rbias = (const float*)F.in[21];
    const int ngrp = T / NWAVES;
    constexpr int RPW = 4;
    for (int rg0 = F.blk; rg0 < ngrp; rg0 += RPW * F.G) {
        f32x4 v[RPW][4]; float ss[RPW];
#pragma unroll
        for (int u = 0; u < RPW; ++u) { const int rg = rg0 + u * F.G; const int row = (rg < ngrp ? rg : rg0) * NWAVES + F.wave, b = row >> 11;
            ss[u] = 0.f;
#pragma unroll
            for (int j = 0; j < 4; ++j) { const int col = 4 * F.lane + 256 * j;
                v[u][j] = *(const f32x4*)(xin + (size_t)row * D + col);
                if (NDELTA >= 1) {
                    const f32x4 g4 = *(const f32x4*)(gate + (size_t)b * 6144 + col);
                    f32x4 dl;
                    if (NDELTA == 1) { const v2u w = *(const v2u*)(delta + (size_t)row * D + col); dl = (f32x4){bflo(w.x), bfhi(w.x), bflo(w.y), bfhi(w.y)}; }
                    else { const v2u w0 = *(const v2u*)(delta + (size_t)row * 2 * D + col), w1 = *(const v2u*)(delta + (size_t)row * 2 * D + D + col);
                        dl = (f32x4){bflo(w0.x) + bflo(w1.x), bfhi(w0.x) + bfhi(w1.x), bflo(w0.y) + bflo(w1.y), bfhi(w0.y) + bfhi(w1.y)}; }
                    v[u][j] = v[u][j] + g4 * dl;
                }
                ss[u] += (v[u][j][0] * v[u][j][0] + v[u][j][1] * v[u][j][1]) + (v[u][j][2] * v[u][j][2] + v[u][j][3] * v[u][j][3]);
            }
        }
#pragma unroll
        for (int u = 0; u < RPW; ++u) { const int rg = rg0 + u * F.G; if (rg >= ngrp) continue;
            const int row = rg * NWAVES + F.wave, b = row >> 11;
            if (!FINAL && WRITEX) {
#pragma unroll
                for (int j = 0; j < 4; ++j) *(f32x4*)(xout + (size_t)row * D + 4 * F.lane + 256 * j) = v[u][j]; }
            const float rstd = 1.0f / sqrtf(wave_sum(ss[u]) * (1.0f / D) + 1e-6f);
#pragma unroll
            for (int j = 0; j < 4; ++j) { const int col = 4 * F.lane + 256 * j;
                const f32x4 g4 = *(const f32x4*)(gvec + col);
                f32x4 y = v[u][j] * rstd * g4;
                if (FINAL) { *(f32x4*)(fout + (size_t)row * D + col) = y; }
                else { const f32x4 sc = *(const f32x4*)(scale + (size_t)b * 6144 + col), sh = *(const f32x4*)(shift + (size_t)b * 6144 + col);
                    y = y * (1.0f + sc) + sh; v[u][j] = y;
                    v2u w; w.x = pk2(y[0], y[1]); w.y = pk2(y[2], y[3]); *(v2u*)(hout + (size_t)row * D + col) = w; }
            }
        }
        if (ROUTE) {
            const bool b5 = (F.lane & 32) != 0, b4 = (F.lane & 16) != 0, b3 = (F.lane & 8) != 0, b2 = (F.lane & 4) != 0;
            float t8[RPW][8];
#pragma unroll
            for (int k = 0; k < 8; ++k) {
                __builtin_amdgcn_sched_barrier(0);
                float aA[RPW], aB[RPW];
#pragma unroll
                for (int u = 0; u < RPW; ++u) { aA[u] = 0.f; aB[u] = 0.f; }
#pragma unroll
                for (int j = 0; j < 4; ++j) { const f32x4 wA = *(const LAS f32x4*)(rw_s + (2 * k) * 1024 + 256 * j + 4 * F.lane), wB = *(const LAS f32x4*)(rw_s + (2 * k + 1) * 1024 + 256 * j + 4 * F.lane);
#pragma unroll
                    for (int u = 0; u < RPW; ++u) { aA[u] += (v[u][j][0] * wA[0] + v[u][j][1] * wA[1]) + (v[u][j][2] * wA[2] + v[u][j][3] * wA[3]); aB[u] += (v[u][j][0] * wB[0] + v[u][j][1] * wB[1]) + (v[u][j][2] * wB[2] + v[u][j][3] * wB[3]); } }
#pragma unroll
                for (int u = 0; u < RPW; ++u) { const float keep = b5 ? aB[u] : aA[u], send = b5 ? aA[u] : aB[u]; t8[u][k] = keep + __shfl_xor(send, 32); }
            }
            __builtin_amdgcn_sched_barrier(0);
#pragma unroll
            for (int u = 0; u < RPW; ++u) { const int rg = rg0 + u * F.G; if (rg >= ngrp) continue;
                __builtin_amdgcn_sched_barrier(0);
                const int row = rg * NWAVES + F.wave;
                float t4[4], t2[2], t1;
#pragma unroll
                for (int k = 0; k < 4; ++k) { const float keep = b4 ? t8[u][k + 4] : t8[u][k], send = b4 ? t8[u][k] : t8[u][k + 4]; t4[k] = keep + swz_f<(16 << 10) | 0x1F>(send); }
#pragma unroll
                for (int k = 0; k < 2; ++k) { const float keep = b3 ? t4[k + 2] : t4[k], send = b3 ? t4[k] : t4[k + 2]; t2[k] = keep + swz_f<(8 << 10) | 0x1F>(send); }
                { const float keep = b2 ? t2[1] : t2[0], send = b2 ? t2[0] : t2[1]; t1 = keep + swz_f<(4 << 10) | 0x1F>(send); }
                t1 += swz_f<(2 << 10) | 0x1F>(t1); t1 += swz_f<(1 << 10) | 0x1F>(t1);
                const int myexp = (b5 ? 1 : 0) + (b2 ? 2 : 0) + (b3 ? 4 : 0) + (b4 ? 8 : 0);
                const float mysc = sigmoidf_(t1), mybi = mysc + rbias[myexp];
                float sc[16], bi[16];
#pragma unroll
                for (int e = 0; e < 16; ++e) { const int src = (e & 1) * 32 + ((e >> 1) & 1) * 4 + ((e >> 2) & 1) * 8 + ((e >> 3) & 1) * 16;
                    sc[e] = __builtin_bit_cast(float, __builtin_amdgcn_readlane(__builtin_bit_cast(int, mysc), src)); bi[e] = __builtin_bit_cast(float, __builtin_amdgcn_readlane(__builtin_bit_cast(int, mybi), src)); }
                float bestgs = -1e30f, s1 = 0.f, s2 = 0.f; int e1 = 0, e2 = 1;
#pragma unroll
                for (int g = 0; g < 4; ++g) {
                    float m1 = bi[4 * g], t1s = sc[4 * g]; int i1 = 0;
#pragma unroll
                    for (int k = 1; k < 4; ++k) if (bi[4 * g + k] > m1) { m1 = bi[4 * g + k]; t1s = sc[4 * g + k]; i1 = k; }
                    float m2 = -1e30f, t2s = 0.f; int i2 = 0;
#pragma unroll
                    for (int k = 0; k < 4; ++k) if (k != i1 && bi[4 * g + k] > m2) { m2 = bi[4 * g + k]; t2s = sc[4 * g + k]; i2 = k; }
                    const float gs = m1 + m2;
                    if (gs > bestgs) { bestgs = gs; e1 = 4 * g + i1; e2 = 4 * g + i2; s1 = t1s; s2 = t2s; }
                }
                if (F.lane == 0) {
                    const float inv = 1.0f / (s1 + s2);
                    float* topw = (float*)(F.ws + WS_TOPW);
                    topw[row * 2] = s1 * inv; topw[row * 2 + 1] = s2 * inv;
                    const unsigned p1 = __hip_atomic_fetch_add((LAS unsigned*)&lcnt[e1], 1u, __ATOMIC_RELAXED, __HIP_MEMORY_SCOPE_WORKGROUP), p2 = __hip_atomic_fetch_add((LAS unsigned*)&lcnt[e2], 1u, __ATOMIC_RELAXED, __HIP_MEMORY_SCOPE_WORKGROUP), n = __hip_atomic_fetch_add((LAS unsigned*)&nent[0], 2u, __ATOMIC_RELAXED, __HIP_MEMORY_SCOPE_WORKGROUP);
                    ent[2 * n] = ((unsigned)e1 << 16) | p1; ent[2 * n + 1] = (unsigned)(row * 2);
                    ent[2 * n + 2] = ((unsigned)e2 << 16) | p2; ent[2 * n + 3] = (unsigned)(row * 2 + 1);
                }
            }
        }
    }
    if (ROUTE) {
        __syncthreads();
        if (F.tid < 16) lbase[F.tid] = __hip_atomic_fetch_add(gcnt + 64 * F.tid, lcnt[F.tid], RLX_AGENT);
        __syncthreads();
        int* list = (int*)(F.ws + WS_LIST); const unsigned n = nent[0];
        for (unsigned i = F.tid; i < n; i += NTHR) { const unsigned key = ent[2 * i], val = ent[2 * i + 1], e = key >> 16, p = key & 0xffffu; list[(size_t)e * T + lbase[e] + p] = (int)val; }
        __syncthreads();
    }
}

__device__ __forceinline__ void compute_tpre(const Ctx& F, unsigned* gcnt) {
    if (F.tid < 16) F.MISC[40 + F.tid] = __hip_atomic_load(gcnt + 64 * F.tid, RLX_AGENT);
    __syncthreads();
    if (F.tid == 0) { unsigned acc = 0;
        for (int e = 0; e < 16; ++e) { F.MISC[16 + e] = acc; acc += (F.MISC[40 + e] + 255u) >> 8; }
        F.MISC[32] = acc; }
    __syncthreads();
}
__device__ __forceinline__ void dispatch_phase(const Ctx& F, unsigned* gcnt) {
    compute_tpre(F, gcnt);
    const int gw = F.blk * NWAVES + F.wave, NGW = F.G * NWAVES;
    const int nrows = (int)F.MISC[32] * 256;
    const bf16* H = (const bf16*)(F.ws + WS_HB); bf16* XS = (bf16*)(F.ws + WS_R1 + R1_XS);
    const int* list = (const int*)(F.ws + WS_LIST); const float* topw = (const float*)(F.ws + WS_TOPW);
    int* sloti = (int*)(F.ws + WS_SLOTI); float* slotw = (float*)(F.ws + WS_SLOTW);
    for (int r0 = gw; r0 < nrows; r0 += 4 * NGW) {
        v4u a[4], bq[4]; int info[4]; float w[4];
#pragma unroll
        for (int u = 0; u < 4; ++u) { const int r = r0 + u * NGW; a[u] = (v4u){0u, 0u, 0u, 0u}; bq[u] = a[u]; info[u] = -1; w[u] = 0.f;
            if (r < nrows) { const int pt = r >> 8; int e = 0;
#pragma unroll
                for (int j = 1; j < 16; ++j) e += (pt >= (int)F.MISC[16 + j]) ? 1 : 0;
                const int pos = r - (int)F.MISC[16 + e] * 256, cnt = (int)F.MISC[40 + e];
                if (pos < cnt) info[u] = list[(size_t)e * T + pos]; } }
#pragma unroll
        for (int u = 0; u < 4; ++u) if (info[u] >= 0) { w[u] = topw[info[u]]; const v4u* src = (const v4u*)(H + (size_t)(info[u] >> 1) * D); a[u] = src[F.lane]; bq[u] = src[64 + F.lane]; }
#pragma unroll
        for (int u = 0; u < 4; ++u) { const int r = r0 + u * NGW; if (r < nrows) { v4u* dst = (v4u*)(XS + (size_t)r * D); dst[F.lane] = a[u]; dst[64 + F.lane] = bq[u];
            if (F.lane == 0) { sloti[r] = info[u]; slotw[r] = w[u]; } } }
    }
}

typedef short mx_bf16x8 __attribute__((ext_vector_type(8)));
typedef float mx_f32x16 __attribute__((ext_vector_type(16)));
__device__ __forceinline__ float fgelu_tanh(float x);
__device__ __forceinline__ float fsigmoid(float x) { return __builtin_amdgcn_rcpf(1.f + __builtin_amdgcn_exp2f(-1.4426950408889634f * x)); }
__device__ __forceinline__ float fgelu_tanh(float x) { return x * fsigmoid(1.5957691216057308f * x * (1.0f + 0.044715f * x * x)); }
template <int CTRL> __device__ __forceinline__ float dpp_f(float old, float src) { return __builtin_bit_cast(float, __builtin_amdgcn_update_dpp(__builtin_bit_cast(int, old), __builtin_bit_cast(int, src), CTRL, 0xF, 0xF, false)); }
template <int CTRL> __device__ __forceinline__ void scan_step(float (&a)[16], float (&b)[16]) {
#pragma unroll
    for (int i = 0; i < 16; ++i) { const float ap = dpp_f<CTRL>(1.0f, a[i]), bp = dpp_f<CTRL>(0.0f, b[i]); b[i] = a[i] * bp + b[i]; a[i] = a[i] * ap; }
}
constexpr int MXL_WG = 0, MXL_MC = 36864, MXL_CB = 38400, MXL_CA = 39680;
template <bool OUT>
__device__ __forceinline__ void mix_phase(const Ctx& F, int jl) {
    const char* Zc = (const char*)(F.ws + WS_R1 + R1_Z); char* Yc = (char*)(F.ws + WS_HB);
    f32x2* AGG = (f32x2*)(F.ws + WS_R1 + R1_AGG); const float* CARRY = (const float*)(F.ws + WS_R1 + R1_CARRY);
    const int lane = F.lane, r32 = lane & 31, hh = lane >> 5;
    const int h = F.blk & 7, nhb = F.G >> 3, bi = F.blk >> 3;
    LAS unsigned char* wgl = F.lds + MXL_WG; LAS float* mcl = (LAS float*)(F.lds + MXL_MC); LAS float* cbl = (LAS float*)(F.lds + MXL_CB); LAS float* cal = (LAS float*)(F.lds + MXL_CA);
    {
        const bf16* WG = (const bf16*)(F.ws + WS_LRUW) + (size_t)jl * 2 * 2 * 8 * 4096;
        for (int i = F.tid; i < 4 * 64 * 8; i += NTHR) { const int td = i >> 9, out = (i >> 3) & 63, ck = i & 7;
            *(LAS v4u*)(wgl + (td * 64 + out) * 144 + ck * 16) = *(const v4u*)(WG + ((size_t)(td * 8 + h) * 64 + out) * 64 + ck * 8); }
        const float* MC = (const float*)(F.ws + WS_MCST) + (size_t)jl * 2 * 3 * 512;
        for (int i = F.tid; i < 384; i += NTHR) mcl[i] = MC[(i >> 6) * 512 + h * 64 + (i & 63)];
        const float* conv_b_w = (const float*)F.in[10] + (size_t)jl * 4 * 512; const float* conv_b_b = (const float*)F.in[11] + (size_t)jl * 512; const float* conv_a_w = (const float*)F.in[9] + (size_t)jl * 3 * 512;
        for (int i = F.tid; i < 320; i += NTHR) cbl[i] = (i < 256) ? conv_b_w[(i >> 6) * 512 + h * 64 + (i & 63)] : conv_b_b[h * 64 + (i & 63)];
        for (int i = F.tid; i < 192; i += NTHR) cal[i] = conv_a_w[(i >> 6) * 512 + h * 64 + (i & 63)];
        __syncthreads();
    }
    if (bi >= nhb) return;
    for (int pi = bi * 8 + F.wave; pi < 8 * 64; pi += nhb * 8) {
        const int c = pi & 63, b = pi >> 6, t0 = c * 32, t = t0 + r32, rbi = b * SEQ;
        float xr[2][16];
#pragma unroll
        for (int g = 0; g < 2; ++g) {
            __builtin_amdgcn_sched_barrier(0);
#pragma unroll
            for (int q = 0; q < 4; ++q) { const int cq = 32 * g + 8 * q + 4 * hh, chq = h * 64 + cq;
                f32x4 a4 = *(const LAS f32x4*)(cbl + 256 + cq);
#pragma unroll
                for (int k = 0; k < 4; ++k) { const int ts = t + k - 1; const bool ok = ts >= 0 && ts < SEQ; const int tc = ok ? ts : t;
                    const v2u w = *(const v2u*)(Zc + ((unsigned)(rbi + tc) * IN_AB + 2048u + chq) * 2u); f32x4 w4 = *(const LAS f32x4*)(cbl + k * 64 + cq);
                    if (!ok) w4 = (f32x4){0.f, 0.f, 0.f, 0.f};
                    a4 = a4 + w4 * (f32x4){bflo(w.x), bfhi(w.x), bflo(w.y), bfhi(w.y)}; }
                xr[g][4 * q] = a4[0]; xr[g][4 * q + 1] = a4[1]; xr[g][4 * q + 2] = a4[2]; xr[g][4 * q + 3] = a4[3]; } }
        __builtin_amdgcn_sched_barrier(0);
        mx_bf16x8 xb[4];
#pragma unroll
        for (int s = 0; s < 4; ++s) { const int g = s >> 1, o = 8 * (s & 1); v4u p; p.x = cvtpk(xr[g][o], xr[g][o + 1]); p.y = cvtpk(xr[g][o + 2], xr[g][o + 3]); p.z = cvtpk(xr[g][o + 4], xr[g][o + 5]); p.w = cvtpk(xr[g][o + 6], xr[g][o + 7]);
            xb[s] = __builtin_bit_cast(mx_bf16x8, p); }
#pragma nounroll
        for (int mt = 0; mt < 2; ++mt) {
            float hrec[16];
#pragma unroll
            for (int i = 0; i < 16; ++i) hrec[i] = 0.f;
            const v4u pa = mt ? __builtin_bit_cast(v4u, xb[2]) : __builtin_bit_cast(v4u, xb[0]), pb = mt ? __builtin_bit_cast(v4u, xb[3]) : __builtin_bit_cast(v4u, xb[1]);
#pragma unroll
            for (int dir = 0; dir < 2; ++dir) {
                __builtin_amdgcn_sched_barrier(0);
                mx_f32x16 accr, acci;
#pragma unroll
                for (int i = 0; i < 16; ++i) { accr[i] = 0.f; acci[i] = 0.f; }
                const unsigned wro = (unsigned)((0 * 2 + dir) * 64 + 32 * mt + r32) * 144u + 16u * hh, wxo = wro + 2u * 64u * 144u;
#pragma unroll
                for (int s = 0; s < 4; ++s) { const mx_bf16x8 ar = *(const LAS mx_bf16x8*)(wgl + wro + 32u * s), ax = *(const LAS mx_bf16x8*)(wgl + wxo + 32u * s);
                    accr = __builtin_amdgcn_mfma_f32_32x32x16_bf16(ar, xb[s], accr, 0, 0, 0); acci = __builtin_amdgcn_mfma_f32_32x32x16_bf16(ax, xb[s], acci, 0, 0, 0); }
                float av[16], bv[16];
#pragma unroll
                for (int q = 0; q < 4; ++q) { const int cl = 32 * mt + 8 * q + 4 * hh;
                    const f32x4 ba = *(const LAS f32x4*)(mcl + (dir * 3 + 0) * 64 + cl), bx = *(const LAS f32x4*)(mcl + (dir * 3 + 1) * 64 + cl), sp = *(const LAS f32x4*)(mcl + (dir * 3 + 2) * 64 + cl);
#pragma unroll
                    for (int e = 0; e < 4; ++e) { const int i = 4 * q + e;
                        const float r = fsigmoid(accr[i] + ba[e]), ig = fsigmoid(acci[i] + bx[e]);
                        const float a = __builtin_amdgcn_exp2f(-8.0f * 1.4426950408889634f * r * sp[e]);
                        const unsigned xw = (i < 8) ? pa[(i & 7) >> 1] : pb[(i & 7) >> 1];
                        av[i] = a; bv[i] = ((i & 1) ? bfhi(xw) : bflo(xw)) * ig * __builtin_amdgcn_sqrtf(fmaxf(1.0f - a * a, 0.f)); } }
                if (dir == 0) { scan_step<0x111>(av, bv); scan_step<0x112>(av, bv); scan_step<0x114>(av, bv); scan_step<0x118>(av, bv);
#pragma unroll
                    for (int i = 0; i < 16; ++i) { const float ap = swz_f<0x1E0>(av[i]), bp = swz_f<0x1E0>(bv[i]); if (r32 >= 16) { bv[i] = av[i] * bp + bv[i]; av[i] = av[i] * ap; } } }
                else { scan_step<0x101>(av, bv); scan_step<0x102>(av, bv); scan_step<0x104>(av, bv); scan_step<0x108>(av, bv);
#pragma unroll
                    for (int i = 0; i < 16; ++i) { const float ap = swz_f<0x200>(av[i]), bp = swz_f<0x200>(bv[i]); if (r32 < 16) { bv[i] = av[i] * bp + bv[i]; av[i] = av[i] * ap; } } }
                const unsigned gb = ((unsigned)(b * 2 + dir) * 64u + c) * 512u + h * 64 + 32 * mt + 4 * hh;
                if (!OUT) {
                    if (r32 == (dir ? 0 : 31)) {
#pragma unroll
                        for (int i = 0; i < 16; ++i) *(f32x2*)((char*)AGG + (gb + (i & 3) + 8 * (i >> 2)) * 8u) = (f32x2){av[i], bv[i]}; }
                } else {
#pragma unroll
                    for (int q = 0; q < 4; ++q) { const f32x4 cin = *(const f32x4*)((const char*)CARRY + (gb + 8 * q) * 4u);
#pragma unroll
                        for (int e = 0; e < 4; ++e) hrec[4 * q + e] += av[4 * q + e] * cin[e] + bv[4 * q + e]; }
                }
            }
            if (OUT) {
#pragma unroll
                for (int q = 0; q < 4; ++q) { const int chq = h * 64 + 32 * mt + 8 * q + 4 * hh;
                    const v2u w = *(const v2u*)(Zc + ((unsigned)(rbi + t) * IN_AB + 1536u + chq) * 2u);
                    v2u o; o.x = cvtpk(fgelu_tanh(bflo(w.x)) * hrec[4 * q], fgelu_tanh(bfhi(w.x)) * hrec[4 * q + 1]); o.y = cvtpk(fgelu_tanh(bflo(w.y)) * hrec[4 * q + 2], fgelu_tanh(bfhi(w.y)) * hrec[4 * q + 3]);
                    *(v2u*)(Yc + ((unsigned)(rbi + t) * D + 512u + chq) * 2u) = o; }
            }
        }
        if (!OUT) {
            const int tq = lane >> 4, cq = (lane & 15) * 4, ch4 = h * 64 + cq, tb = t0 + 8 * tq;
            const f32x4 wa0 = *(const LAS f32x4*)(cal + cq), wa1 = *(const LAS f32x4*)(cal + 64 + cq), wa2 = *(const LAS f32x4*)(cal + 128 + cq);
            f32x4 prod[10];
#pragma unroll
            for (int u = 0; u < 10; ++u) { const int ts = tb + u - 1; const bool ok = ts >= 0 && ts < SEQ; const int tc = ok ? ts : tb; const unsigned zk = ((unsigned)(rbi + tc) * IN_AB + ch4) * 2u;
                const v2u gc = *(const v2u*)(Zc + zk + 2048u), va = *(const v2u*)(Zc + zk);
                const f32x4 p = (f32x4){bflo(gc.x) * bflo(va.x), bfhi(gc.x) * bfhi(va.x), bflo(gc.y) * bflo(va.y), bfhi(gc.y) * bfhi(va.y)};
                prod[u] = ok ? p : (f32x4){0.f, 0.f, 0.f, 0.f}; }
#pragma unroll
            for (int u = 0; u < 8; ++u) { const unsigned zr = ((unsigned)(rbi + tb + u) * IN_AB + ch4) * 2u; const v2u gbv = *(const v2u*)(Zc + zr + 1024u);
                const f32x4 cv = wa0 * prod[u] + wa1 * prod[u + 1] + wa2 * prod[u + 2];
                v2u o; o.x = cvtpk(bflo(gbv.x) * cv[0], bfhi(gbv.x) * cv[1]); o.y = cvtpk(bflo(gbv.y) * cv[2], bfhi(gbv.y) * cv[3]);
                *(v2u*)(Yc + ((unsigned)(rbi + tb + u) * D + ch4) * 2u) = o; }
        }
    }
}
__device__ __forceinline__ void carry_phase(const Ctx& F) {
    const f32x2* AGG = (const f32x2*)(F.ws + WS_R1 + R1_AGG); float* CARRY = (float*)(F.ws + WS_R1 + R1_CARRY);
    const int gw = F.blk * NWAVES + F.wave, NGW = F.G * NWAVES;
    for (int item = gw; item < 128; item += NGW) { const int bd = item >> 3, ch = (item & 7) * 64 + F.lane, dir = bd & 1;
        f32x2 pg[64];
#pragma unroll
        for (int cc = 0; cc < 64; ++cc) pg[cc] = AGG[((size_t)bd * 64 + cc) * 512 + ch];
        float hsv = 0.f;
        if (dir == 0) {
#pragma unroll
            for (int cc = 0; cc < 64; ++cc) { CARRY[((size_t)bd * 64 + cc) * 512 + ch] = hsv; hsv = pg[cc].x * hsv + pg[cc].y; } }
        else {
#pragma unroll
            for (int cc = 63; cc >= 0; --cc) { CARRY[((size_t)bd * 64 + cc) * 512 + ch] = hsv; hsv = pg[cc].x * hsv + pg[cc].y; } }
    }
}

__device__ __forceinline__ void attn_naive_phase(const Ctx& F) {
    const bf16* QKV = (const bf16*)(F.ws + WS_R1 + R1_Z); bf16* Y = (bf16*)(F.ws + WS_HB);
    LAS float* qs = (LAS float*)(F.lds + F.wave * 4096);
    LAS float* ps = qs + 64;
    const int gw = F.blk * NWAVES + F.wave, NGW = F.G * NWAVES;
    for (int unit = gw; unit < T * 16; unit += NGW) {
        const int row = unit >> 4, hd = unit & 15, b = row >> 11, t = row & 2047; const size_t rb = (size_t)b * SEQ;
        qs[F.lane] = bf2f(QKV[(size_t)row * NQKV + hd * 64 + F.lane]) * 0.125f;
        LDS_WAIT(); asm volatile("" ::: "memory");
        float sc[7]; float mx = -1e30f;
#pragma unroll
        for (int i = 0; i < 7; ++i) { const int n = F.lane + 64 * i, p = n / 129, jj = n - p * 129 - 64, dd = (p == 0) ? 1 : (p == 1) ? 4 : 16, tk = t + dd * jj;
            const bool valid = (n < 387) && tk >= 0 && tk < SEQ; float dot = -1e30f;
            if (valid) { const v4u* kp = (const v4u*)(QKV + (rb + tk) * NQKV + 1024 + hd * 64); dot = 0.f;
#pragma unroll
                for (int q = 0; q < 8; ++q) { const v4u w = kp[q]; const LAS float* qq = qs + q * 8;
                    dot += qq[0] * bflo(w.x) + qq[1] * bfhi(w.x) + qq[2] * bflo(w.y) + qq[3] * bfhi(w.y) + qq[4] * bflo(w.z) + qq[5] * bfhi(w.z) + qq[6] * bflo(w.w) + qq[7] * bfhi(w.w); } }
            sc[i] = dot; mx = fmaxf(mx, dot); }
        mx = wave_max(mx); float sum = 0.f;
#pragma unroll
        for (int i = 0; i < 7; ++i) { const float pr = (sc[i] > -1e29f) ? expf(sc[i] - mx) : 0.f; ps[F.lane + 64 * i] = pr; sum += pr; }
        sum = wave_sum(sum);
        LDS_WAIT(); asm volatile("" ::: "memory");
        float o = 0.f;
#pragma unroll
        for (int p = 0; p < 3; ++p) { const int dd = (p == 0) ? 1 : (p == 1) ? 4 : 16;
#pragma unroll 4
            for (int jj = -64; jj <= 64; ++jj) { const int tk = t + dd * jj; if (tk < 0 || tk >= SEQ) continue;
                o += ps[p * 129 + jj + 64] * bf2f(QKV[(rb + tk) * NQKV + 2048 + hd * 64 + F.lane]); } }
        Y[(size_t)row * D + hd * 64 + F.lane] = (bf16)f2bf(o / sum);
        LDS_WAIT(); asm volatile("" ::: "memory");
    }
}

typedef short bf16x8 __attribute__((ext_vector_type(8)));
typedef short s16x4 __attribute__((ext_vector_type(4)));
typedef float f32x16 __attribute__((ext_vector_type(16)));
typedef short v4i16_t __attribute__((ext_vector_type(4)));
constexpr int ATT_STO = 69632, ATT_STM = 69632 + 65536;
template <int MODE> __device__ __forceinline__ bool attn_tile_info(int ti, int w, int r16, int qt0, int& d, int& ktok0) {
    if (MODE == 0) {
        if (ti < 5) { const int tt = (ti == 0) ? 2 : (ti <= 2 ? ti - 1 : ti); const int jt = 32 * w - 64 + 32 * tt; d = 16; ktok0 = r16 + 16 * jt; return jt >= 0 && jt < 128; }
        const int jt = 128 * w - 64 + 32 * (ti - 5); d = 4; ktok0 = (r16 & 3) + 4 * jt; return jt >= 0 && jt < 512;
    }
    d = 1; ktok0 = qt0 - 64 + 32 * ti; return ktok0 >= 0 && ktok0 < SEQ;
}
template <int MODE, int NT>
__device__ __forceinline__ void attn_run(const bf16* kbase, LAS unsigned char* kl, LAS unsigned char* vl, int lane, int w, int r16, int qt0, int qtok, const bf16x8 (&qf)[4],
                                         f32x16& o0, f32x16& o1, float& mrun, float& lrun) {
    const int h = lane >> 5, r = lane & 31;
    const int srow = lane >> 3, sch = lane & 7;
    const unsigned kst = srow * 144 + sch * 16, vst = (sch >> 2) * 2048 + srow * 64 + (sch & 3) * 16;
    const unsigned krd = r * 144 + h * 16;
    const int gi = (lane >> 4) & 1, i16 = lane & 15;
    const unsigned vrd = (4 * h + (i16 >> 2)) * 64 + gi * 32 + (i16 & 3) * 8;
    const float cexp = 0.125f * 1.4426950408889634f;
    int d = 1, ktok0 = 0; bool inr = attn_tile_info<MODE>(0, w, r16, qt0, d, ktok0);
    v4u kg[4], vg[4];
#pragma unroll
    for (int i = 0; i < 4; ++i) { int tok = ktok0 + d * (srow + 8 * i); tok = tok < 0 ? 0 : (tok > SEQ - 1 ? SEQ - 1 : tok); const bf16* p = kbase + (size_t)tok * NQKV; kg[i] = *(const v4u*)p; vg[i] = *(const v4u*)(p + 1024); }
#pragma nounroll
    for (int ti = 0; ti < NT; ++ti) {
        const int dcur = d, kcur = ktok0; const bool inrcur = inr;
#pragma unroll
        for (int i = 0; i < 4; ++i) { *(LAS v4u*)(kl + kst + i * 8 * 144) = kg[i]; *(LAS v4u*)(vl + vst + i * 8 * 64) = vg[i]; }
        if (ti + 1 < NT) {
            inr = attn_tile_info<MODE>(ti + 1, w, r16, qt0, d, ktok0);
#pragma unroll
            for (int i = 0; i < 4; ++i) { int tok = ktok0 + d * (srow + 8 * i); tok = tok < 0 ? 0 : (tok > SEQ - 1 ? SEQ - 1 : tok); const bf16* p = kbase + (size_t)tok * NQKV; kg[i] = *(const v4u*)p; vg[i] = *(const v4u*)(p + 1024); }
        }
        f32x16 s;
#pragma unroll
        for (int i = 0; i < 16; ++i) s[i] = 0.f;
#pragma unroll
        for (int kk = 0; kk < 4; ++kk) { const bf16x8 kf = *(const LAS bf16x8*)(kl + krd + 32 * kk); s = __builtin_amdgcn_mfma_f32_32x32x16_bf16(kf, qf[kk], s, 0, 0, 0); }
        const int lim = 64 * dcur; const unsigned ub = (unsigned)(inrcur ? (kcur - qtok + dcur * 4 * h + lim) : 0x40000000), ul = 2u * (unsigned)lim; float mx = -1e30f;
#pragma unroll
        for (int i = 0; i < 16; ++i) { const unsigned u = ub + (unsigned)(dcur * ((i & 3) + 8 * (i >> 2))); s[i] = (u <= ul) ? s[i] : -1e30f; mx = fmaxf(mx, s[i]); }
        mx = fmaxf(mx, __shfl_xor(mx, 32));
        const float mnew = fmaxf(mrun, mx), alpha = __builtin_amdgcn_exp2f((mrun - mnew) * cexp), mc = mnew * cexp; mrun = mnew;
        float ps = 0.f;
#pragma unroll
        for (int i = 0; i < 16; ++i) { s[i] = __builtin_amdgcn_exp2f(s[i] * cexp - mc); ps += s[i]; }
        ps += __shfl_xor(ps, 32);
        lrun = lrun * alpha + ps;
#pragma unroll
        for (int i = 0; i < 16; ++i) { o0[i] *= alpha; o1[i] *= alpha; }
#pragma unroll
        for (int sx = 0; sx < 2; ++sx) {
            v4u pw; pw.x = cvtpk(s[8 * sx + 0], s[8 * sx + 1]); pw.y = cvtpk(s[8 * sx + 2], s[8 * sx + 3]); pw.z = cvtpk(s[8 * sx + 4], s[8 * sx + 5]); pw.w = cvtpk(s[8 * sx + 6], s[8 * sx + 7]);
            const bf16x8 pf = __builtin_bit_cast(bf16x8, pw);
#pragma unroll
            for (int dt = 0; dt < 2; ++dt) {
                const s16x4 va = __builtin_bit_cast(s16x4, __builtin_amdgcn_ds_read_tr16_b64_v4i16((LAS v4i16_t*)(vl + vrd + dt * 2048 + (16 * sx) * 64)));
                const s16x4 vb = __builtin_bit_cast(s16x4, __builtin_amdgcn_ds_read_tr16_b64_v4i16((LAS v4i16_t*)(vl + vrd + dt * 2048 + (16 * sx + 8) * 64)));
                const bf16x8 vf = {va[0], va[1], va[2], va[3], vb[0], vb[1], vb[2], vb[3]};
                if (dt == 0) o0 = __builtin_amdgcn_mfma_f32_32x32x16_bf16(vf, pf, o0, 0, 0, 0); else o1 = __builtin_amdgcn_mfma_f32_32x32x16_bf16(vf, pf, o1, 0, 0, 0);
            }
        }
    }
}
__device__ __forceinline__ void attn_phase(const Ctx& F) {
    const bf16* QKV = (const bf16*)(F.ws + WS_R1 + R1_Z); bf16* Y = (bf16*)(F.ws + WS_HB);
    LAS unsigned char* kl = F.lds + F.wave * 8704;
    LAS unsigned char* vl = kl + 4608;
    LAS unsigned char* sto = F.lds + ATT_STO; LAS f32x2* stm = (LAS f32x2*)(F.lds + ATT_STM);
    const int lane = F.lane, r = lane & 31, h = lane >> 5;
    for (int bu = F.blk; bu < 512; bu += F.G) {
        const int w = bu & 3, hd = (bu >> 2) & 15, b = bu >> 6; const size_t rb = (size_t)b * SEQ;
        const bf16* kbase = QKV + rb * NQKV + 1024 + hd * 64 + (lane & 7) * 8;
#pragma nounroll
        for (int sub = 0; sub < 2; ++sub) {
            const int r16 = 2 * F.wave + sub, tl = 16 * r + r16, qtok = w * 512 + tl;
            bf16x8 qf[4];
            { const bf16* qp = QKV + (rb + qtok) * NQKV + hd * 64 + 8 * h;
#pragma unroll
              for (int kk = 0; kk < 4; ++kk) qf[kk] = *(const bf16x8*)(qp + 16 * kk); }
            f32x16 o0, o1;
#pragma unroll
            for (int i = 0; i < 16; ++i) { o0[i] = 0.f; o1[i] = 0.f; }
            float mrun = -1e30f, lrun = 0.f;
            attn_run<0, 13>(kbase, kl, vl, lane, w, r16, 0, qtok, qf, o0, o1, mrun, lrun);
#pragma unroll
            for (int g = 0; g < 4; ++g) {
                v2u w0; w0.x = cvtpk(o0[4 * g], o0[4 * g + 1]); w0.y = cvtpk(o0[4 * g + 2], o0[4 * g + 3]); *(LAS v2u*)(sto + tl * 128 + (8 * g + 4 * h) * 2) = w0;
                v2u w1; w1.x = cvtpk(o1[4 * g], o1[4 * g + 1]); w1.y = cvtpk(o1[4 * g + 2], o1[4 * g + 3]); *(LAS v2u*)(sto + tl * 128 + (32 + 8 * g + 4 * h) * 2) = w1; }
            if (h == 0) stm[tl] = (f32x2){mrun, lrun};
        }
        __syncthreads();
#pragma nounroll
        for (int sub = 0; sub < 2; ++sub) {
            const int g32 = 2 * F.wave + sub, tl = 32 * g32 + r, qt0 = w * 512 + 32 * g32, qtok = qt0 + r;
            bf16x8 qf[4];
            { const bf16* qp = QKV + (rb + qtok) * NQKV + hd * 64 + 8 * h;
#pragma unroll
              for (int kk = 0; kk < 4; ++kk) qf[kk] = *(const bf16x8*)(qp + 16 * kk); }
            f32x16 o0, o1;
#pragma unroll
            for (int g = 0; g < 4; ++g) { const v2u w0 = *(const LAS v2u*)(sto + tl * 128 + (8 * g + 4 * h) * 2), w1 = *(const LAS v2u*)(sto + tl * 128 + (32 + 8 * g + 4 * h) * 2);
                o0[4 * g] = bflo(w0.x); o0[4 * g + 1] = bfhi(w0.x); o0[4 * g + 2] = bflo(w0.y); o0[4 * g + 3] = bfhi(w0.y);
                o1[4 * g] = bflo(w1.x); o1[4 * g + 1] = bfhi(w1.x); o1[4 * g + 2] = bflo(w1.y); o1[4 * g + 3] = bfhi(w1.y); }
            const f32x2 ml = stm[tl]; float mrun = ml.x, lrun = ml.y;
            attn_run<1, 5>(kbase, kl, vl, lane, w, 0, qt0, qtok, qf, o0, o1, mrun, lrun);
            const float inv = 1.0f / lrun;
            bf16* yp = Y + (rb + qtok) * D + hd * 64 + 4 * h;
#pragma unroll
            for (int g = 0; g < 4; ++g) {
                v2u w0; w0.x = cvtpk(o0[4 * g] * inv, o0[4 * g + 1] * inv); w0.y = cvtpk(o0[4 * g + 2] * inv, o0[4 * g + 3] * inv); *(v2u*)(yp + 8 * g) = w0;
                v2u w1; w1.x = cvtpk(o1[4 * g] * inv, o1[4 * g + 1] * inv); w1.y = cvtpk(o1[4 * g + 2] * inv, o1[4 * g + 3] * inv); *(v2u*)(yp + 32 + 8 * g) = w1; }
        }
        __syncthreads();
    }
}
#ifndef REP_P0
#define REP_P0 1
#endif
#ifndef REP_G1
#define REP_G1 1
#endif
#ifndef REP_MIX
#define REP_MIX 1
#endif
#ifndef REP_ATT
#define REP_ATT 1
#endif
#ifndef REP_G2
#define REP_G2 1
#endif
#ifndef REP_DISP
#define REP_DISP 1
#endif
#ifndef REP_GU
#define REP_GU 1
#endif
#ifndef REP_DN
#define REP_DN 1
#endif
#define REPEAT(n) _Pragma("unroll") for (int rep_ = 0; rep_ < (n); ++rep_)
#ifndef EN_P0
#define EN_P0 1
#endif
#ifndef EN_N1
#define EN_N1 1
#endif
#ifndef EN_G1E
#define EN_G1E 1
#endif
#ifndef EN_G1O
#define EN_G1O 1
#endif
#ifndef EN_MIXA
#define EN_MIXA 1
#endif
#ifndef EN_MIXB
#define EN_MIXB 1
#endif
#ifndef EN_ATT
#define EN_ATT 1
#endif
#ifndef EN_G2
#define EN_G2 1
#endif
#ifndef EN_N2
#define EN_N2 1
#endif
#ifndef EN_DISP
#define EN_DISP 1
#endif
#ifndef EN_GU
#define EN_GU 1
#endif
#ifndef EN_DN
#define EN_DN 1
#endif
#ifndef EN_FIN
#define EN_FIN 1
#endif

struct Args { const void* in[25]; float* out; unsigned char* ws; int ph_lo, ph_hi; };
constexpr int NPHASE = 2 + 10 * DEPTH;

__global__ void __launch_bounds__(NTHR, 2) fwd(Args args) {
    extern __shared__ __attribute__((aligned(16))) unsigned char lds[];
    Ctx F;
    F.lds0 = (LAS unsigned char*)lds; F.lds = F.lds0; F.MISC = (volatile LAS unsigned*)(F.lds + MISC_OFF);
    F.tid = threadIdx.x; F.lane = F.tid & 63; F.wave = __builtin_amdgcn_readfirstlane(F.tid >> 6);
    F.G = gridDim.x; F.blk = blockIdx.x; launder(F);
    for (int u = F.tid; u < 256; u += NTHR) ((LAS unsigned*)(F.lds + MISC_OFF))[u] = 0u;
    __syncthreads();
#if MK_ONE_LAUNCH
    XcdBarrier bar = xcd_barrier_post(F.ctl + CW_BAR, F.MISC + 8);
#ifndef REP_BAR
#define REP_BAR 1
#endif
#define GRID_BAR() do { _Pragma("unroll") for (int rb_ = 0; rb_ < REP_BAR; ++rb_) xcd_barrier(bar); } while (0)
#else
#define GRID_BAR() do { } while (0)
#endif
#define IN(k) (launder(F) && F.lo <= (k) && (k) < F.hi)
#ifndef PROBE_TMASK
#define PROBE_TMASK 0
#endif
    unsigned long long t_prev = 0ull, t_acc = 0ull; int t_cls = -1;
#define TCLS(c) do { if (PROBE_TMASK) { const unsigned long long now_ = wall_clock64(); if (t_cls >= 0 && ((PROBE_TMASK >> t_cls) & 1)) t_acc += now_ - t_prev; t_prev = now_; t_cls = (c); } } while (0)
#define SEAM(k) do { if (IN(k) && IN((k) + 1)) GRID_BAR(); } while (0)
#define WSP (F.ws)
#define MOD ((const float*)(F.ws + WS_MOD))
#define X ((float*)(F.ws + WS_X))
#define HB ((bf16*)(F.ws + WS_HB))
#define R1Z ((bf16*)(F.ws + WS_R1 + R1_Z))
#define DELTA ((bf16*)(F.ws + WS_R1 + R1_DELTA))
#define XS ((bf16*)(F.ws + WS_R1 + R1_XS))
#define ACT ((bf16*)(F.ws + WS_R1 + R1_ACT))
#define YW ((bf16*)(F.ws + WS_R1 + R1_YW))

    TCLS(0);
    if (EN_P0 && IN(0)) { REPEAT(REP_P0) p0_prologue(F); } SEAM(0);

    for (int l = 0; l < DEPTH; ++l) {
        const int base = 1 + 10 * l, jl = l >> 1; const bool even = (l & 1) == 0;
#define modl (MOD + (size_t)l * 8 * 6144)
#define gcnt (F.ctl + CW_CNT + 1024 * l)
        TCLS(1);
        if (EN_N1 && IN(base + 0)) {
            const float* gv = (const float*)F.in[5] + (size_t)l * D;
            if (l == 0) norm_phase<0, false, false, false>(F, (const float*)F.in[0], nullptr, nullptr, nullptr, gv, modl + 0, modl + 1024, HB, nullptr, nullptr);
            else norm_phase<2, false, false, false>(F, X, nullptr, YW, MOD + (size_t)(l - 1) * 8 * 6144 + 5120, gv, modl + 0, modl + 1024, HB, nullptr, nullptr);
        }
        SEAM(base + 0);
        TCLS(2);
        if (IN(base + 1)) REPEAT(REP_G1) {
            if (!EN_G1E && even) {} else if (even) { pg8::StaticOrder S; S.init(HB, (const bf16*)(WSP + WS_WIN) + (size_t)jl * IN_AB * D, T, IN_AB, D, F.G, F.blk);
                pg8::EpiStore E{R1Z, IN_AB};
                pg8::gemm_phase<pg8::EpiStore, pg8::StaticOrder, true, true>(F.lds, D, S, E, F.tid); }
            else if (EN_G1O) { pg8::StaticOrder S; S.init(HB, (const bf16*)(WSP + WS_WQKV) + (size_t)jl * NQKV * D, T, NQKV, D, F.G, F.blk);
                pg8::EpiQKV E{R1Z, (const float*)(WSP + WS_ROT)};
                pg8::gemm_phase<pg8::EpiQKV, pg8::StaticOrder, true, true>(F.lds, D, S, E, F.tid); }
        }
        SEAM(base + 1);
        TCLS(even ? 3 : 6);
        if (IN(base + 2)) { if (even) { if (EN_MIXA) REPEAT(REP_MIX) mix_phase<false>(F, jl); } else { if (EN_ATT) REPEAT(REP_ATT) attn_phase(F); } }
        SEAM(base + 2);
        TCLS(4);
        if (IN(base + 3)) { if (even) carry_phase(F); }
        if (even) SEAM(base + 3);
        TCLS(5);
        if (EN_MIXB && IN(base + 4)) { if (even) REPEAT(REP_MIX) mix_phase<true>(F, jl); }
        if (even) SEAM(base + 4);
        TCLS(7);
        if (EN_G2 && IN(base + 5)) REPEAT(REP_G2) {
            pg8::StaticOrder S; S.init(HB, even ? (const bf16*)(WSP + WS_WOUT) + (size_t)jl * D * D : (const bf16*)(WSP + WS_WO) + (size_t)jl * D * D, T, D, D, F.G, F.blk);
            pg8::EpiX E{l == 0 ? (const float*)F.in[0] : (const float*)X, X, l == 0 ? (const bf16*)nullptr : (const bf16*)YW, modl + 2048, MOD + (size_t)(l > 0 ? l - 1 : 0) * 8 * 6144 + 5120};
            pg8::gemm_phase<pg8::EpiX, pg8::StaticOrder, true, true>(F.lds, D, S, E, F.tid);
        }
        SEAM(base + 5);
        TCLS(8);
        if (EN_N2 && IN(base + 6)) norm_phase<0, true, false, false>(F, X, nullptr, nullptr, nullptr, (const float*)F.in[6] + (size_t)l * D, modl + 3072, modl + 4096, HB, nullptr, gcnt);
        SEAM(base + 6);
        TCLS(9);
        if (EN_GU && IN(base + 8)) REPEAT(REP_GU) {
            compute_tpre(F, gcnt);
            { volatile LAS unsigned* TOK = (volatile LAS unsigned*)(F.lds + ENT_OFF);
              const int* list = (const int*)(WSP + WS_LIST); const float* topw = (const float*)(WSP + WS_TOPW); int* sloti = (int*)(WSP + WS_SLOTI); float* slotw = (float*)(WSP + WS_SLOTW);
              const int total = (int)F.MISC[32] * 4;
              for (int ui = 0; ui < 4; ++ui) { const int L = ui * F.G + F.blk; if (L >= total) break;
                  if (F.tid < 256) { const int pt = L >> 2; int e = 0;
#pragma unroll
                      for (int j = 1; j < 16; ++j) e += (pt >= (int)F.MISC[16 + j]) ? 1 : 0;
                      const int pos = (pt - (int)F.MISC[16 + e]) * 256 + F.tid, cnt = (int)F.MISC[40 + e];
                      const int info = (pos < cnt) ? list[(size_t)e * T + pos] : -1;
                      TOK[ui * 256 + F.tid] = info >= 0 ? (unsigned)(info >> 1) : 0u;
                      if ((L & 3) == 0) { sloti[pt * 256 + F.tid] = info; slotw[pt * 256 + F.tid] = info >= 0 ? topw[info] : 0.f; } } }
              __syncthreads(); }
            pg8::MoeGatherOrder S; S.A = (const char*)HB; S.Bt = (const char*)((const bf16*)(WSP + WS_WGU) + (size_t)l * NE * 1024 * 1024); S.tstep = (size_t)256 * 1024 * 2; S.estride = (size_t)1024 * 1024 * 2; S.G = F.G; S.c = F.blk;
            S.tp = F.MISC + 16; S.tok = (const volatile LAS unsigned*)(F.lds + ENT_OFF); S.rowbytes = 2048u;
            pg8::EpiGU E{ACT};
            pg8::gemm_phase<pg8::EpiGU, pg8::MoeGatherOrder, true, true>(F.lds, 1024, S, E, F.tid);
            if (l + 1 < DEPTH) { const int total = (int)F.MISC[32] * 4, rem = total % F.G, nid = rem ? F.G - rem : F.G, rank = rem ? F.blk - rem : F.blk;
                if (rank >= 0) convert_expert_items(F, l + 1, rank * NWAVES + F.wave, nid * NWAVES, 0, 2 * 16 * 256); }
        }
        SEAM(base + 8);
        TCLS(10);
        if (EN_DN && IN(base + 9)) REPEAT(REP_DN) {
            compute_tpre(F, gcnt);
            pg8::MoeOrder S; S.A = (const char*)ACT; S.Bt = (const char*)((const bf16*)(WSP + WS_WDN) + (size_t)l * NE * 1024 * 512); S.tstep = (size_t)256 * 512 * 2; S.estride = (size_t)1024 * 512 * 2; S.G = F.G; S.c = F.blk;
            S.tp = F.MISC + 16;
            pg8::EpiDN E{YW, (const int*)(WSP + WS_SLOTI), (const float*)(WSP + WS_SLOTW)};
            pg8::gemm_phase<pg8::EpiDN, pg8::MoeOrder, true, true>(F.lds, 512, S, E, F.tid);
            if (l + 1 < DEPTH) { const int total = (int)F.MISC[32] * 4, rem = total % F.G, nid = rem ? F.G - rem : F.G, rank = rem ? F.blk - rem : F.blk;
                if (rank >= 0) convert_expert_items(F, l + 1, rank * NWAVES + F.wave, nid * NWAVES, 2 * 16 * 256, 3 * 16 * 256); }
        }
        SEAM(base + 9);
    }
    TCLS(11);
    if (EN_FIN && IN(NPHASE - 1)) norm_phase<2, false, true>(F, X, nullptr, YW, MOD + (size_t)3 * 8 * 6144 + 5120, (const float*)F.in[7], nullptr, nullptr, nullptr, args.out, nullptr);
    TCLS(12);
    if (PROBE_TMASK) { if (blockIdx.x == 0 && threadIdx.x == 0) { const unsigned long long s0 = wall_clock64(); while (wall_clock64() - s0 < 8ull * t_acc) __builtin_amdgcn_s_sleep(8); } }
#undef IN
#undef SEAM
#undef WSP
#undef MOD
#undef X
#undef HB
#undef R1Z
#undef DELTA
#undef XS
#undef ACT
#undef YW
#undef modl
#undef gcnt
}

extern "C" void kernel_launch(void* const* d_in, const int* in_sizes, int n_in, void* d_out, int out_size, void* d_ws, size_t ws_size, hipStream_t stream) {
    static int grid = 0;
    if (grid == 0) {
        if (n_in != 25 || in_sizes[0] != T * D || out_size != T * D || ws_size < WS_END) { fprintf(stderr, "kernel_launch: unexpected shapes / workspace (n_in %d, ws %zu); nothing launched\n", n_in, ws_size); grid = -1; return; }
        int dev = 0, cus = 0, per_cu = 0;
        if (hipGetDevice(&dev) != hipSuccess || hipDeviceGetAttribute(&cus, hipDeviceAttributeMultiprocessorCount, dev) != hipSuccess) { grid = -1; return; }
        if (hipFuncSetAttribute((const void*)fwd, hipFuncAttributeMaxDynamicSharedMemorySize, LDS_BYTES) != hipSuccess) { fprintf(stderr, "kernel_launch: hipFuncSetAttribute failed\n"); grid = -1; return; }
        if (hipOccupancyMaxActiveBlocksPerMultiprocessor(&per_cu, (const void*)fwd, NTHR, LDS_BYTES) != hipSuccess || per_cu < 1) { fprintf(stderr, "kernel_launch: occupancy query reports %d\n", per_cu); }
        (void)hipGetLastError();
        grid = cus;
    }
    if (grid < 0) return;
    if (hipMemsetAsync((char*)d_ws + WS_CTL, 0, CTL_ZERO_BYTES, stream) != hipSuccess) return;
    Args a{};
    for (int i = 0; i < 25; ++i) a.in[i] = d_in[i];
    a.out = (float*)d_out; a.ws = (unsigned char*)d_ws;
#if MK_ONE_LAUNCH
    a.ph_lo = 0; a.ph_hi = NPHASE;
    hipLaunchKernelGGL(fwd, dim3(grid), dim3(NTHR), LDS_BYTES, stream, a);
#else
    for (int p = 0; p < NPHASE; ++p) {
        if (p >= 1 && p < NPHASE - 1) { const int l = (p - 1) / 10, s = (p - 1) % 10; if (s == 7 || ((l & 1) == 1 && (s == 3 || s == 4))) continue; }
        a.ph_lo = p; a.ph_hi = p + 1;
        hipLaunchKernelGGL(fwd, dim3(grid), dim3(NTHR), LDS_BYTES, stream, a);
    }
#endif
}
```
